# Optimizing an MI355X kernel written in HIP

```python
import math
import jax, jax.numpy as jnp
from jax import lax
import numpy as np

D_MODEL = 1024
BATCH = 4
SEQ = 4096
DEPTH = 2
DEC_BATCH = 32
DEC_SEQ = 64
PAST_LEN = 2048

CHUNK = 64
D_HEAD = 64
H_FOX = (3 * D_MODEL // 8) // D_HEAD
H_SB = (3 * D_MODEL // 8) // D_HEAD
H_SGU = D_MODEL // D_HEAD - H_FOX - H_SB
W_FOX = H_FOX * D_HEAD
W_SB = H_SB * D_HEAD
W_SGU = H_SGU * D_HEAD
D_MIX = W_FOX + W_SGU + W_SB
D_IN = 3 * W_FOX + H_FOX + 2 * W_SGU + 3 * W_SB
SGU_CHUNK = 128
Q_BLOCK = 128
D_FF = 4 * D_MODEL
ALPHA = (2 * DEPTH) ** 0.25
BETA = (8 * DEPTH) ** -0.25
FORGET_BIAS = 2.0
LN_EPS = 1e-5
RMS_EPS = 1e-6
NEG_INF = -1e30

kernel_name = "hybrid_fox_sgu_stickbreak_stream_encoder"


def _split_points():
    sizes = [W_FOX, W_FOX, W_FOX, H_FOX, W_SGU, W_SGU, W_SB, W_SB, W_SB]
    return np.cumsum(sizes)[:-1].tolist()


def layer_norm(x, g, b):
    xf = x.astype(jnp.float32)
    mu = jnp.mean(xf, axis=-1, keepdims=True)
    var = jnp.mean(jnp.square(xf - mu), axis=-1, keepdims=True)
    return ((xf - mu) * lax.rsqrt(var + LN_EPS) * g + b).astype(x.dtype)


def in_proj(x, w_in, b_f):
    B, T, _ = x.shape
    z = jnp.einsum('btd,de->bte', x, w_in)
    q_f, k_f, v_f, f_lg, u_g, v_g, q_s, k_s, v_s = jnp.split(z, _split_points(), axis=-1)
    heads = lambda a, h: a.reshape(B, T, h, D_HEAD)
    log_f = jax.nn.log_sigmoid((f_lg + b_f).astype(jnp.float32))
    return (heads(q_f, H_FOX), heads(k_f, H_FOX), heads(v_f, H_FOX), log_f,
            u_g, v_g, heads(q_s, H_SB), heads(k_s, H_SB), heads(v_s, H_SB))


def fox_block(q, c_q, qpos, k, v, c_k):
    kpos = jnp.arange(k.shape[1])
    s = jnp.einsum('bqhd,bkhd->bhqk', q, k).astype(jnp.float32) / math.sqrt(D_HEAD)
    s = s + jnp.transpose(c_q, (0, 2, 1))[..., :, None] - jnp.transpose(c_k, (0, 2, 1))[..., None, :]
    mask = kpos[None, :] <= qpos[:, None]
    p = jax.nn.softmax(jnp.where(mask, s, NEG_INF), axis=-1)
    return jnp.einsum('bhqk,bkhd->bqhd', p.astype(v.dtype), v)


def sb_block(q, qpos, k, v):
    kpos = jnp.arange(k.shape[1])
    z = jnp.einsum('bqhd,bkhd->bhqk', q, k).astype(jnp.float32) / math.sqrt(D_HEAD)
    mask = kpos[None, :] < qpos[:, None]
    log_rem = jnp.where(mask, jax.nn.log_sigmoid(-z), 0.0)
    after = lax.cumsum(log_rem, axis=3, reverse=True) - log_rem
    a = jnp.where(mask, jnp.exp(jax.nn.log_sigmoid(z) + after), 0.0)
    return jnp.einsum('bhqk,bkhd->bqhd', a.astype(v.dtype), v)


def sgu_gate(u_g, v_g, g_v, b_v):
    u = jax.nn.gelu(u_g)
    v = layer_norm(jax.nn.gelu(v_g), g_v, b_v)
    return u, v


def sgu_mix(u, v, w_s, b_s):
    B, T, _ = v.shape
    L = min(T, SGU_CHUNK)
    n = T // L
    w = jnp.tril(w_s[:, :L, :L])
    vb = v.reshape(B, n, L, H_SGU, D_HEAD)
    s = jnp.einsum('gij,bnjgc->bnigc', w, vb) + b_s[:, :L].T[None, None, :, :, None]
    return u * s.reshape(B, T, W_SGU)


def merge_heads(o_fox, o_sgu, o_sb, g_mix, w_out):
    B, T = o_sgu.shape[:2]
    o = jnp.concatenate([o_fox.reshape(B, T, W_FOX), o_sgu, o_sb.reshape(B, T, W_SB)], axis=-1)
    oh = o.reshape(B, T, D_MIX // D_HEAD, D_HEAD).astype(jnp.float32)
    oh = oh * lax.rsqrt(jnp.mean(oh * oh, axis=-1, keepdims=True) + RMS_EPS)
    o = (oh.reshape(B, T, D_MIX) * g_mix).astype(o_sgu.dtype)
    return jnp.einsum('bte,ed->btd', o, w_out)


def sq_relu_mlp(x, w_up, w_down):
    h = jnp.square(jax.nn.relu(jnp.einsum('btd,df->btf', x, w_up)))
    return jnp.einsum('btf,fd->btd', h, w_down)


def prompt_attention(q_f, k_f, v_f, c, q_s, k_s, v_s):
    B, T = q_f.shape[:2]
    nb = T // Q_BLOCK

    def blk(i):
        start = i * Q_BLOCK
        qpos = start + jnp.arange(Q_BLOCK)
        qf = lax.dynamic_slice_in_dim(q_f, start, Q_BLOCK, axis=1)
        cq = lax.dynamic_slice_in_dim(c, start, Q_BLOCK, axis=1)
        qs = lax.dynamic_slice_in_dim(q_s, start, Q_BLOCK, axis=1)
        return fox_block(qf, cq, qpos, k_f, v_f, c), sb_block(qs, qpos, k_s, v_s)

    o_f, o_s = lax.map(blk, jnp.arange(nb))
    o_f = jnp.transpose(o_f, (1, 0, 2, 3, 4)).reshape(B, T, H_FOX, D_HEAD)
    o_s = jnp.transpose(o_s, (1, 0, 2, 3, 4)).reshape(B, T, H_SB, D_HEAD)
    return o_f, o_s


def setup_inputs(seed: int = 0) -> dict:
    key = jax.random.key(seed)
    ks = jax.random.split(key, 24)
    nrm = lambda k, shape: jax.random.normal(k, shape, jnp.float32)
    return {
        "x_prompt": nrm(ks[0], (BATCH, SEQ, D_MODEL)),
        "x_sample": nrm(ks[1], (DEC_BATCH, DEC_SEQ, D_MODEL)),
        "cache_fox_k": nrm(ks[2], (DEPTH, DEC_BATCH, PAST_LEN, H_FOX, D_HEAD)),
        "cache_fox_v": nrm(ks[3], (DEPTH, DEC_BATCH, PAST_LEN, H_FOX, D_HEAD)),
        "cache_fox_logf": jax.nn.log_sigmoid(FORGET_BIAS + nrm(ks[4], (DEPTH, DEC_BATCH, PAST_LEN, H_FOX))),
        "cache_sb_k": nrm(ks[5], (DEPTH, DEC_BATCH, PAST_LEN, H_SB, D_HEAD)),
        "cache_sb_v": nrm(ks[6], (DEPTH, DEC_BATCH, PAST_LEN, H_SB, D_HEAD)),
        "w_in": nrm(ks[7], (DEPTH, D_MODEL, D_IN)) * D_MODEL ** -0.5,
        "b_f": FORGET_BIAS + 0.1 * nrm(ks[8], (DEPTH, H_FOX)),
        "g_v": 1.0 + 0.1 * nrm(ks[9], (DEPTH, W_SGU)),
        "b_v": 0.02 * nrm(ks[10], (DEPTH, W_SGU)),
        "w_s": nrm(ks[11], (DEPTH, H_SGU, SGU_CHUNK, SGU_CHUNK)) * SGU_CHUNK ** -0.5,
        "b_s": 1.0 + 0.1 * nrm(ks[12], (DEPTH, H_SGU, SGU_CHUNK)),
        "g_mix": 1.0 + 0.1 * nrm(ks[13], (DEPTH, D_MIX)),
        "w_out": nrm(ks[14], (DEPTH, D_MIX, D_MODEL)) * (D_MIX ** -0.5 * BETA),
        "ln1_g": 1.0 + 0.1 * nrm(ks[15], (DEPTH, D_MODEL)),
        "ln1_b": 0.02 * nrm(ks[16], (DEPTH, D_MODEL)),
        "w_up": nrm(ks[17], (DEPTH, D_MODEL, D_FF)) * D_MODEL ** -0.5,
        "w_down": nrm(ks[18], (DEPTH, D_FF, D_MODEL)) * (D_FF ** -0.5 * BETA),
        "ln2_g": 1.0 + 0.1 * nrm(ks[19], (DEPTH, D_MODEL)),
        "ln2_b": 0.02 * nrm(ks[20], (DEPTH, D_MODEL)),
    }


def reference(x_prompt, x_sample, cache_fox_k, cache_fox_v, cache_fox_logf, cache_sb_k, cache_sb_v,
              w_in, b_f, g_v, b_v, w_s, b_s, g_mix, w_out, ln1_g, ln1_b, w_up, w_down, ln2_g, ln2_b):
    assert x_sample.shape[1] <= CHUNK
    xp, xs = x_prompt, x_sample
    p_fk, p_fv, p_fl, p_sk, p_sv = [], [], [], [], []
    s_fk, s_fv, s_fl, s_sk, s_sv, s_gv = [], [], [], [], [], []
    for l in range(DEPTH):
        q_f, k_f, v_f, log_f, u_g, v_g, q_s, k_s, v_s = in_proj(xp, w_in[l], b_f[l])
        c = lax.cumsum(log_f, axis=1)
        o_f, o_s = prompt_attention(q_f, k_f, v_f, c, q_s, k_s, v_s)
        u, v = sgu_gate(u_g, v_g, g_v[l], b_v[l])
        o_g = sgu_mix(u, v, w_s[l], b_s[l])
        mix = merge_heads(o_f, o_g, o_s, g_mix[l], w_out[l])
        xp = layer_norm(ALPHA * xp + mix, ln1_g[l], ln1_b[l])
        xp = layer_norm(ALPHA * xp + sq_relu_mlp(xp, w_up[l], w_down[l]), ln2_g[l], ln2_b[l])
        p_fk.append(k_f); p_fv.append(v_f); p_fl.append(log_f); p_sk.append(k_s); p_sv.append(v_s)

        q_f, k_f, v_f, log_f, u_g, v_g, q_s, k_s, v_s = in_proj(xs, w_in[l], b_f[l])
        past = cache_fox_k.shape[2]
        qpos = past + jnp.arange(xs.shape[1])
        kf_all = jnp.concatenate([cache_fox_k[l], k_f], axis=1)
        vf_all = jnp.concatenate([cache_fox_v[l], v_f], axis=1)
        c_all = lax.cumsum(jnp.concatenate([cache_fox_logf[l].astype(jnp.float32), log_f], axis=1), axis=1)
        o_f = fox_block(q_f, c_all[:, past:], qpos, kf_all, vf_all, c_all)
        ks_all = jnp.concatenate([cache_sb_k[l], k_s], axis=1)
        vs_all = jnp.concatenate([cache_sb_v[l], v_s], axis=1)
        o_s = sb_block(q_s, qpos, ks_all, vs_all)
        u, v = sgu_gate(u_g, v_g, g_v[l], b_v[l])
        o_g = sgu_mix(u, v, w_s[l], b_s[l])
        mix = merge_heads(o_f, o_g, o_s, g_mix[l], w_out[l])
        xs = layer_norm(ALPHA * xs + mix, ln1_g[l], ln1_b[l])
        xs = layer_norm(ALPHA * xs + sq_relu_mlp(xs, w_up[l], w_down[l]), ln2_g[l], ln2_b[l])
        s_fk.append(k_f); s_fv.append(v_f); s_fl.append(log_f); s_sk.append(k_s); s_sv.append(v_s)
        s_gv.append(v)

    return (xp, xs,
            jnp.stack(p_fk), jnp.stack(p_fv), jnp.stack(p_fl), jnp.stack(p_sk), jnp.stack(p_sv),
            jnp.stack(s_fk), jnp.stack(s_fv), jnp.stack(s_fl), jnp.stack(s_sk), jnp.stack(s_sv),
            jnp.stack(s_gv))
```

```cpp
#include <hip/hip_runtime.h>
#include <hip/hip_cooperative_groups.h>
#include <cstdio>
#include <cstdint>
namespace cg = cooperative_groups;

#ifndef MK_MODE
#define MK_MODE 1
#endif

#define DI __device__ __forceinline__
typedef unsigned short bfraw;
typedef __attribute__((ext_vector_type(8))) short bf16x8;
typedef __attribute__((ext_vector_type(4))) short s16x4;
typedef __attribute__((ext_vector_type(4))) float f32x4;
typedef __attribute__((ext_vector_type(16))) float f32x16;
typedef __attribute__((ext_vector_type(2))) __bf16 bf2_t;
typedef __attribute__((ext_vector_type(2))) float f2_t;
#define LAS __attribute__((address_space(3)))

DI unsigned pack2(float a, float b) { f2_t x = {a, b}; bf2_t y = __builtin_convertvector(x, bf2_t); return __builtin_bit_cast(unsigned, y); }
DI float bf2f(bfraw v) { return __uint_as_float(((unsigned)v) << 16); }
DI int fresh_tid() { int t = threadIdx.x & 255; asm volatile("" : "+v"(t)); return t; }
DI int half_id() { return __builtin_amdgcn_readfirstlane((int)(threadIdx.x >> 8)); }
DI int vblock() { return (int)blockIdx.x * 2 + half_id(); }
DI int vgrid() { return (int)gridDim.x * 2; }
DI float ex2(float x) { return __builtin_amdgcn_exp2f(x); }
DI float lg2(float x) { return __builtin_amdgcn_logf(x); }

constexpr int D = 1024, TP = 16384, TS = 2048, TT = TP + TS, SEQ = 4096, DECB = 32, DECS = 64, PAST = 2048;
constexpr int NIN = 3072, DFF = 4096, DEPTH = 2, QKVW = 2304, DIN = 2822;
constexpr float ALPHA = 1.41421356237309515f;
constexpr float LOG2E = 1.44269504088896341f;
constexpr float LN2 = 0.69314718055994531f;
constexpr float SB_EXIT = -160.f;
constexpr float FOX_EXIT = -160.f;
constexpr int KMAX_WORD = 12288;

constexpr size_t O_YP = 0;
constexpr size_t O_YS = O_YP + (size_t)TP * D;
constexpr size_t O_PFK = O_YS + (size_t)TS * D;
constexpr size_t O_PFV = O_PFK + (size_t)DEPTH * TP * 384;
constexpr size_t O_PFL = O_PFV + (size_t)DEPTH * TP * 384;
constexpr size_t O_PSK = O_PFL + (size_t)DEPTH * TP * 6;
constexpr size_t O_PSV = O_PSK + (size_t)DEPTH * TP * 384;
constexpr size_t O_SFK = O_PSV + (size_t)DEPTH * TP * 384;
constexpr size_t O_SFV = O_SFK + (size_t)DEPTH * TS * 384;
constexpr size_t O_SFL = O_SFV + (size_t)DEPTH * TS * 384;
constexpr size_t O_SSK = O_SFL + (size_t)DEPTH * TS * 6;
constexpr size_t O_SSV = O_SSK + (size_t)DEPTH * TS * 384;
constexpr size_t O_SGV = O_SSV + (size_t)DEPTH * TS * 384;
constexpr size_t O_END = O_SGV + (size_t)DEPTH * TS * 256;

constexpr size_t WS_CTL = 0;
constexpr size_t CTL_BYTES = 65536;
constexpr size_t WS_WIN = WS_CTL + CTL_BYTES;
constexpr size_t WS_WOUT = WS_WIN + (size_t)DEPTH * NIN * D * 2;
constexpr size_t WS_WUP = WS_WOUT + (size_t)DEPTH * D * D * 2;
constexpr size_t WS_WDN = WS_WUP + (size_t)DEPTH * DFF * D * 2;
constexpr size_t WS_XB = WS_WDN + (size_t)DEPTH * D * DFF * 2;
constexpr size_t WS_X32 = WS_XB + (size_t)TT * D * 2;
constexpr size_t WS_Y = WS_X32 + (size_t)TT * D * 4;
constexpr size_t WS_QKV = WS_Y + (size_t)TT * D * 4;
constexpr size_t WS_U = WS_QKV + (size_t)TT * QKVW * 2;
constexpr size_t WS_VG = WS_U + (size_t)TT * 256 * 2;
constexpr size_t WS_LOGF = WS_VG + (size_t)TT * 256 * 4;
constexpr size_t WS_C = WS_LOGF + (size_t)TT * 8 * 4;
constexpr size_t WS_CC = WS_C + (size_t)TT * 8 * 4;
constexpr size_t WS_O = WS_CC + (size_t)DECB * PAST * 8 * 4;
constexpr size_t WS_H = WS_O + (size_t)TT * D * 2;
constexpr size_t WS_END = WS_H + (size_t)TT * DFF * 2;

constexpr int LDS_DATA = 64;
constexpr int ABUF = 128 * 144;
constexpr int HALF_LDS = 69632;
constexpr int LDS_BYTES = LDS_DATA + 2 * HALF_LDS;
constexpr int NPHASE = 1 + 8 * DEPTH;
constexpr int QCTR_WORD = 8192;

struct Params {
  const float *x_prompt, *x_sample, *cfk, *cfv, *cfl, *csk, *csv, *w_in, *b_f, *g_v, *b_v, *w_s, *b_s, *g_mix, *w_out,
      *ln1_g, *ln1_b, *w_up, *w_down, *ln2_g, *ln2_b;
  float* out;
  unsigned char* ws;
  int ph_lo, ph_hi, coop, pad;
};

#define XB_TMO      128
#define XB_XCNT(j)  (256  + 64 * (j))
#define XB_XSUB(j)  (1280 + 64 * (j))
#define XB_XGEN(j)  (2304 + 64 * (j))
#define XB_TOP      3328
#define XB_TOPGEN   3392
#define XCD_BAR_WORDS 3456
#define XB_SPIN_CAP (1u << 22)
DI unsigned xb_ld(unsigned* p) { return __hip_atomic_load(p, __ATOMIC_RELAXED, __HIP_MEMORY_SCOPE_AGENT); }
DI unsigned xb_add(unsigned* p, unsigned v) { return __hip_atomic_fetch_add(p, v, __ATOMIC_RELAXED, __HIP_MEMORY_SCOPE_AGENT); }
DI unsigned xb_xcc_id() { return (unsigned)__builtin_amdgcn_s_getreg((3 << 11) | 20) & 0xFu; }
#define XB_SPIN(cond, bar) do { unsigned _sp = 0; while (cond) { __builtin_amdgcn_s_sleep(1); \
    if ((++_sp & 255u) == 0u) { if (xb_ld(&(bar)[XB_TMO])) break; if (_sp > XB_SPIN_CAP) { atomicAdd(&(bar)[XB_TMO], 1u); break; } } } } while (0)
struct XcdBarrier { unsigned* bar; unsigned x; volatile LAS unsigned* st; };
DI XcdBarrier xcd_barrier_post(unsigned* bar, volatile LAS unsigned* st) {
  XcdBarrier b; b.bar = bar; b.x = xb_xcc_id(); b.st = st;
  if (threadIdx.x == 0) (void)xb_add(&bar[XB_XCNT(b.x)], 1u);
  return b;
}
DI void xcd_barrier_complete(unsigned* bar, unsigned x, unsigned& nloc, unsigned& nx) {
  const unsigned G = gridDim.x * gridDim.y * gridDim.z;
  unsigned sum, cnt, mine, sp = 0u;
  for (;;) {
    sum = 0u; cnt = 0u; mine = 0u;
#pragma unroll
    for (unsigned j = 0; j < 16; ++j) { const unsigned c = xb_ld(&bar[XB_XCNT(j)]); sum += c; cnt += (c > 0u) ? 1u : 0u; mine = (j == x) ? c : mine; }
    if (sum == G) break;
    __builtin_amdgcn_s_sleep(1);
    if ((++sp & 255u) == 0u) { if (xb_ld(&bar[XB_TMO])) break; if (sp > XB_SPIN_CAP) { atomicAdd(&bar[XB_TMO], 1u); break; } }
  }
  nloc = mine > 0u ? mine : 1u; nx = cnt > 0u ? cnt : 1u;
}
DI void xcd_barrier(const XcdBarrier& b) {
  asm volatile("s_waitcnt vmcnt(0)" ::: "memory");
  __syncthreads();
  if (threadIdx.x == 0) {
    unsigned* bar = b.bar;
    __builtin_amdgcn_s_waitcnt(0);
    unsigned nloc = b.st[0], nx = b.st[1];
    if (nloc == 0u) { xcd_barrier_complete(bar, b.x, nloc, nx); b.st[0] = nloc; b.st[1] = nx; }
    const unsigned old = xb_add(&bar[XB_XSUB(b.x)], 1u);
    const unsigned gen = old / nloc;
    if (old + 1u == (gen + 1u) * nloc) {
      __builtin_amdgcn_fence(__ATOMIC_RELEASE, "agent");
      asm volatile("s_waitcnt vmcnt(0)" ::: "memory");
      const unsigned og = xb_add(&bar[XB_TOP], 1u);
      const unsigned tg = og / nx;
      if (og + 1u == (tg + 1u) * nx) xb_add(&bar[XB_TOPGEN], 1u);
      else XB_SPIN(xb_ld(&bar[XB_TOPGEN]) == tg, bar);
      __builtin_amdgcn_fence(__ATOMIC_ACQUIRE, "agent");
      xb_add(&bar[XB_XGEN(b.x)], 1u);
      asm volatile("s_waitcnt vmcnt(0)" ::: "memory");
    } else {
      XB_SPIN(xb_ld(&bar[XB_XGEN(b.x)]) == gen, bar);
      __builtin_amdgcn_fence(__ATOMIC_ACQUIRE, "agent");
      asm volatile("s_waitcnt vmcnt(0)" ::: "memory");
    }
  }
  __syncthreads();
}

DI float gelu_tanh(float x) {
  const float y = 0.7978845608028654f * (x + 0.044715f * x * x * x);
  const float t = 1.f - 2.f / (1.f + __expf(2.f * y));
  return 0.5f * x * (1.f + t);
}
DI float log_sigmoid(float x) { return fminf(x, 0.f) - LN2 * lg2(1.f + ex2(-fabsf(x) * LOG2E)); }
DI float wave_sum(float v) {
#pragma unroll
  for (int o = 32; o > 0; o >>= 1) v += __shfl_xor(v, o);
  return v;
}

DI int win_map(int np) { return np < 1152 ? np : (np < 2304 ? np + 518 : (np < 2816 ? np - 1146 : (np < 2822 ? np - 1664 : -1))); }

__device__ void prep_transpose(const float* __restrict__ src, int srcN, int K, int k0, int n0, bfraw* __restrict__ dst, bool winmap, float* lds) {
  const int tid = fresh_tid(), nn = tid & 63, kr = tid >> 6;
  const int np = n0 + nn;
  const int n = winmap ? win_map(np) : np;
#pragma unroll
  for (int it = 0; it < 16; ++it) {
    const int kk = it * 4 + kr;
    const float v = (n >= 0) ? src[(size_t)(k0 + kk) * srcN + n] : 0.f;
    lds[kk * 65 + nn] = v;
  }
  __syncthreads();
#pragma unroll
  for (int j = 0; j < 2; ++j) {
    const int c = tid + 256 * j, n2 = c >> 3, kc = c & 7;
    const float* s = lds + (kc * 8) * 65 + n2;
    uint4 o;
    o.x = pack2(s[0], s[65]); o.y = pack2(s[130], s[195]); o.z = pack2(s[260], s[325]); o.w = pack2(s[390], s[455]);
    *(uint4*)(dst + (size_t)(n0 + n2) * K + k0 + kc * 8) = o;
  }
  __syncthreads();
}

__device__ void phase_prep(const Params& p, unsigned char* lds) {
  bfraw* WinT = (bfraw*)(p.ws + WS_WIN); bfraw* WoutT = (bfraw*)(p.ws + WS_WOUT);
  bfraw* WupT = (bfraw*)(p.ws + WS_WUP); bfraw* WdnT = (bfraw*)(p.ws + WS_WDN);
  bfraw* XB = (bfraw*)(p.ws + WS_XB);
  constexpr int PER_L = 768 + 256 + 1024 + 1024, NW = DEPTH * PER_L, NX = TT / 16;
  for (int it0 = blockIdx.x * 2; it0 < NW + NX; it0 += vgrid()) {
    const int it = min(it0 + half_id(), NW + NX - 1);
    if (it < NW) {
      const int l = it / PER_L; int r = it % PER_L;
      if (r < 768) prep_transpose(p.w_in + (size_t)l * D * DIN, DIN, D, (r & 15) * 64, (r >> 4) * 64, WinT + (size_t)l * NIN * D, true, (float*)lds);
      else if (r < 1024) { r -= 768; prep_transpose(p.w_out + (size_t)l * D * D, D, D, (r & 15) * 64, (r >> 4) * 64, WoutT + (size_t)l * D * D, false, (float*)lds); }
      else if (r < 2048) { r -= 1024; prep_transpose(p.w_up + (size_t)l * D * DFF, DFF, D, (r & 15) * 64, (r >> 4) * 64, WupT + (size_t)l * DFF * D, false, (float*)lds); }
      else { r -= 2048; prep_transpose(p.w_down + (size_t)l * DFF * D, D, DFF, (r & 63) * 64, (r >> 6) * 64, WdnT + (size_t)l * D * DFF, false, (float*)lds); }
    } else {
      const int tid0 = fresh_tid();
      const int row0 = (it - NW) * 16;
      const float* src = row0 < TP ? p.x_prompt + (size_t)row0 * D : p.x_sample + (size_t)(row0 - TP) * D;
      bfraw* dst = XB + (size_t)row0 * D;
#pragma unroll 4
      for (int i = 0; i < 16; ++i) {
        const int idx = (tid0 + 256 * i) * 4;
        const float4 v = *(const float4*)(src + idx);
        uint2 o; o.x = pack2(v.x, v.y); o.y = pack2(v.z, v.w);
        *(uint2*)(dst + idx) = o;
      }
    }
  }
}

enum { EPI_INPROJ = 0, EPI_RESID = 1, EPI_UP = 2, EPI_RESID_IN = 3 };

template <int EPI, int MI, int NI>
DI void gemm_epilogue(const Params& p, int layer, f32x16 (&acc)[MI][NI], int m0, int rbase, int nc0, int r32, int h, bool from_input) {
  if (EPI == EPI_INPROJ) {
    bfraw* QKV = (bfraw*)(p.ws + WS_QKV);
    if (nc0 < QKVW) {
      const int which = nc0 / 384;
      const float scale = (which == 0 || which == 3) ? 0.125f : 1.f;
      const int colin = nc0 - which * 384;
      const size_t offp = which == 1 ? O_PFK : which == 2 ? O_PFV : which == 4 ? O_PSK : O_PSV;
      const size_t offs = which == 1 ? O_SFK : which == 2 ? O_SFV : which == 4 ? O_SSK : O_SSV;
      const bool has_out = (which == 1 || which == 2 || which == 4 || which == 5);
      float* outP = p.out + offp + (size_t)layer * TP * 384 + colin + r32;
      float* outS = p.out + offs + ((size_t)layer * TS * 384 - (size_t)TP * 384) + colin + r32;
#pragma unroll
      for (int mi = 0; mi < MI; ++mi)
#pragma unroll
        for (int ni = 0; ni < NI; ++ni)
#pragma unroll
          for (int i = 0; i < 16; ++i) {
            const int row = m0 + rbase + mi * 32 + (i & 3) + 8 * (i >> 2) + 4 * h;
            const float v = acc[mi][ni][i];
            QKV[(size_t)row * QKVW + nc0 + ni * 32 + r32] = (bfraw)(pack2(v * scale, 0.f) & 0xffffu);
            if (has_out) { float* ob = row < TP ? outP : outS; ob[(size_t)row * 384 + ni * 32] = v; }
          }
    } else if (nc0 < 2560) {
      bfraw* U = (bfraw*)(p.ws + WS_U);
#pragma unroll
      for (int mi = 0; mi < MI; ++mi)
#pragma unroll
        for (int ni = 0; ni < NI; ++ni)
#pragma unroll
          for (int i = 0; i < 16; ++i) {
            const int rl = rbase + mi * 32 + (i & 3) + 8 * (i >> 2) + 4 * h;
            const int col = ni * 32 + r32;
            U[(size_t)(m0 + rl) * 256 + (nc0 - 2304) + col] = (bfraw)(pack2(gelu_tanh(acc[mi][ni][i]), 0.f) & 0xffffu);
          }
    } else if (nc0 < 2816) {
      float* VG = (float*)(p.ws + WS_VG);
#pragma unroll
      for (int mi = 0; mi < MI; ++mi)
#pragma unroll
        for (int ni = 0; ni < NI; ++ni)
#pragma unroll
          for (int i = 0; i < 16; ++i) {
            const int rl = rbase + mi * 32 + (i & 3) + 8 * (i >> 2) + 4 * h;
            const int col = ni * 32 + r32;
            VG[(size_t)(m0 + rl) * 256 + (nc0 - 2560) + col] = gelu_tanh(acc[mi][ni][i]);
          }
    } else if (nc0 == 2816) {
      if (r32 < 6) {
        float* LOGF = (float*)(p.ws + WS_LOGF);
        float* outP = p.out + O_PFL + (size_t)layer * TP * 6 + r32;
        float* outS = p.out + O_SFL + ((size_t)layer * TS * 6 - (size_t)TP * 6) + r32;
        const float bias = p.b_f[layer * 6 + r32];
#pragma unroll
        for (int mi = 0; mi < MI; ++mi)
#pragma unroll
          for (int i = 0; i < 16; ++i) {
            const int row = m0 + rbase + mi * 32 + (i & 3) + 8 * (i >> 2) + 4 * h;
            const float lf = log_sigmoid(acc[mi][0][i] + bias);
            LOGF[(size_t)row * 8 + r32] = lf;
            float* ob = row < TP ? outP : outS;
            ob[(size_t)row * 6] = lf;
          }
      }
    }
  } else if (EPI == EPI_RESID_IN) {
    unsigned char* Yb = p.ws + WS_Y;
    const float* xp = p.x_prompt + nc0 + r32;
    const float* xs = p.x_sample - (size_t)TP * D + nc0 + r32;
    const unsigned o0 = (unsigned)(((m0 + rbase + 4 * h) * D + nc0 + r32) * 4);
#pragma unroll
    for (int mi = 0; mi < MI; ++mi) {
      float xr[NI][16];
#pragma unroll
      for (int ni = 0; ni < NI; ++ni)
#pragma unroll
        for (int i = 0; i < 16; ++i) {
          const int row = m0 + rbase + 4 * h + mi * 32 + (i & 3) + 8 * (i >> 2);
          xr[ni][i] = (row < TP ? xp : xs)[(size_t)row * D + ni * 32];
        }
#pragma unroll
      for (int ni = 0; ni < NI; ++ni)
#pragma unroll
        for (int i = 0; i < 16; ++i)
          *(float*)(Yb + (o0 + (unsigned)(((mi * 32 + (i & 3) + 8 * (i >> 2)) * D + ni * 32) * 4))) = ALPHA * xr[ni][i] + acc[mi][ni][i];
    }
  } else if (EPI == EPI_RESID) {
    unsigned char* Yb = p.ws + WS_Y;
    const unsigned char* Xb = p.ws + WS_X32;
    const unsigned o0 = (unsigned)(((m0 + rbase + 4 * h) * D + nc0 + r32) * 4);
#pragma unroll
    for (int mi = 0; mi < MI; ++mi) {
      float xr[NI][16];
#pragma unroll
      for (int ni = 0; ni < NI; ++ni)
#pragma unroll
        for (int i = 0; i < 16; ++i)
          xr[ni][i] = *(const float*)(Xb + (o0 + (unsigned)(((mi * 32 + (i & 3) + 8 * (i >> 2)) * D + ni * 32) * 4)));
#pragma unroll
      for (int ni = 0; ni < NI; ++ni)
#pragma unroll
        for (int i = 0; i < 16; ++i)
          *(float*)(Yb + (o0 + (unsigned)(((mi * 32 + (i & 3) + 8 * (i >> 2)) * D + ni * 32) * 4))) = ALPHA * xr[ni][i] + acc[mi][ni][i];
    }
  } else {
    bfraw* H = (bfraw*)(p.ws + WS_H);
#pragma unroll
    for (int mi = 0; mi < MI; ++mi)
#pragma unroll
      for (int ni = 0; ni < NI; ++ni)
#pragma unroll
        for (int i = 0; i < 16; ++i) {
          const int rl = rbase + mi * 32 + (i & 3) + 8 * (i >> 2) + 4 * h;
          const int col = nc0 + ni * 32 + r32;
          const float v = fmaxf(acc[mi][ni][i], 0.f);
          H[(size_t)(m0 + rl) * DFF + col] = (bfraw)(pack2(v * v, 0.f) & 0xffffu);
        }
  }
}

template <int EPI, int MI, int NI>
__device__ void gemm_tile8(const Params& p, int layer, const bfraw* __restrict__ A, const bfraw* __restrict__ Bt, int K, int m0, int n0, unsigned char* ring, bool from_input) {
  constexpr int WGM = NI == 2 ? 2 : 1, WGN = 8 / WGM;
  constexpr int BM = WGM * MI * 32;
  constexpr int STAGE = (BM + 256) * 128;
  constexpr int NAI = BM / 8;
  constexpr int NA = (NAI + 7) / 8;
  int tid = threadIdx.x; asm volatile("" : "+v"(tid));
  const int lane = tid & 63, wid = tid >> 6, wm = wid / WGN, wn = wid % WGN;
  const int r32 = lane & 31, h = lane >> 5;
  f32x16 acc[MI][NI];
#pragma unroll
  for (int a = 0; a < MI; ++a)
#pragma unroll
    for (int b = 0; b < NI; ++b)
#pragma unroll
      for (int i = 0; i < 16; ++i) acc[a][b][i] = 0.f;
  const int dc = (lane & 7) ^ (((wid & 1) * 4 + (lane >> 4)) & 7);
  const unsigned loff = (unsigned)(((wid * 8 + (lane >> 3)) * K + dc * 8) * 2);
  const unsigned char* ab = (const unsigned char*)(A + (size_t)m0 * K);
  const unsigned char* bb = (const unsigned char*)(Bt + (size_t)n0 * K);
  unsigned char* dl = ring + wid * 1024 + lane * 16;
#define ISSUE8(kt_, st_) do { \
    _Pragma("unroll") for (int j = 0; j < NA; ++j) { \
      if (NAI % 8 == 0 || j < NA - 1 || wid < NAI % 8) \
        __builtin_amdgcn_global_load_lds((const unsigned*)(ab + ((size_t)j * 64 * K + (kt_) * 64) * 2 + loff), (unsigned*)(dl + (st_) * STAGE + j * 8192), 16, 0, 0); } \
    _Pragma("unroll") for (int j = 0; j < 4; ++j) \
      __builtin_amdgcn_global_load_lds((const unsigned*)(bb + ((size_t)j * 64 * K + (kt_) * 64) * 2 + loff), (unsigned*)(dl + (st_) * STAGE + BM * 128 + j * 8192), 16, 0, 0); \
  } while (0)
  const int key = (r32 >> 1) & 7;
  const unsigned char* afr = ring + (wm * (MI * 32) + r32) * 128;
  const unsigned char* bfr = ring + BM * 128 + (wn * (NI * 32) + r32) * 128;
  const int nk = K >> 6;
  asm volatile("s_waitcnt vmcnt(0)" ::: "memory");
  __builtin_amdgcn_s_barrier();
  asm volatile("" ::: "memory");
  ISSUE8(0, 0);
  int st = 0;
  for (int kt = 0; kt < nk; ++kt) {
    asm volatile("s_waitcnt vmcnt(0)" ::: "memory");
    __builtin_amdgcn_s_barrier();
    asm volatile("" ::: "memory");
    if (kt + 1 < nk) ISSUE8(kt + 1, st ^ 1);
    const unsigned char* as = afr + st * STAGE;
    const unsigned char* bs = bfr + st * STAGE;
#pragma unroll
    for (int ks = 0; ks < 4; ++ks) {
      const int o = ((ks * 2 + h) ^ key) * 16;
      bf16x8 af[MI], bq[NI];
#pragma unroll
      for (int mi = 0; mi < MI; ++mi) af[mi] = *(const bf16x8*)(as + mi * 4096 + o);
#pragma unroll
      for (int ni = 0; ni < NI; ++ni) bq[ni] = *(const bf16x8*)(bs + ni * 4096 + o);
#pragma unroll
      for (int mi = 0; mi < MI; ++mi)
#pragma unroll
        for (int ni = 0; ni < NI; ++ni)
          acc[mi][ni] = __builtin_amdgcn_mfma_f32_32x32x16_bf16(af[mi], bq[ni], acc[mi][ni], 0, 0, 0);
    }
    st ^= 1;
  }
#undef ISSUE8
  gemm_epilogue<EPI, MI, NI>(p, layer, acc, m0, wm * (MI * 32), n0 + wn * (NI * 32), r32, h, from_input);
}

template <int EPI, int MI, int NI>
__device__ void phase_gemm8(const Params& p, int layer, const bfraw* A, const bfraw* Bt, int N, int K, unsigned char* ring, bool from_input = false) {
  constexpr int BM = (NI == 2 ? 2 : 1) * MI * 32;
  const int ntn = N / 256, ntiles = (TT / BM) * ntn;
  for (int t = blockIdx.x; t < ntiles; t += gridDim.x) {
    const int tm = t / ntn, tn = t % ntn;
    gemm_tile8<EPI, MI, NI>(p, layer, A, Bt, K, tm * BM, tn * 256, ring, from_input);
  }
  __syncthreads();
}

__device__ void phase_ln(const Params& p, const float* __restrict__ gam, const float* __restrict__ bet, bool last) {
  const float* Y = (const float*)(p.ws + WS_Y);
  float* X32 = (float*)(p.ws + WS_X32);
  bfraw* XB = (bfraw*)(p.ws + WS_XB);
  const int tid_ = fresh_tid(); const int lane = tid_ & 63, wid = tid_ >> 6;
  for (int row = vblock() * 4 + wid; row < TT; row += vgrid() * 4) {
    const float* y = Y + (size_t)row * D;
    float4 v[4];
#pragma unroll
    for (int j = 0; j < 4; ++j) v[j] = *(const float4*)(y + lane * 4 + 256 * j);
    float s = 0.f;
#pragma unroll
    for (int j = 0; j < 4; ++j) s += v[j].x + v[j].y + v[j].z + v[j].w;
    const float mu = wave_sum(s) * (1.f / D);
    float q = 0.f;
#pragma unroll
    for (int j = 0; j < 4; ++j) { v[j].x -= mu; v[j].y -= mu; v[j].z -= mu; v[j].w -= mu; q += v[j].x * v[j].x + v[j].y * v[j].y + v[j].z * v[j].z + v[j].w * v[j].w; }
    const float rstd = rsqrtf(wave_sum(q) * (1.f / D) + 1e-5f);
#pragma unroll
    for (int j = 0; j < 4; ++j) {
      const int c = lane * 4 + 256 * j;
      const float4 g = *(const float4*)(gam + c), b = *(const float4*)(bet + c);
      float4 o;
      o.x = v[j].x * rstd * g.x + b.x; o.y = v[j].y * rstd * g.y + b.y; o.z = v[j].z * rstd * g.z + b.z; o.w = v[j].w * rstd * g.w + b.w;
      if (last) {
        *(float4*)(p.out + (size_t)row * D + c) = o;
      } else {
        *(float4*)(X32 + (size_t)row * D + c) = o;
        uint2 ob; ob.x = pack2(o.x, o.y); ob.y = pack2(o.z, o.w);
        *(uint2*)(XB + (size_t)row * D + c) = ob;
      }
    }
  }
}

DI float wave_incl_scan(float v, int lane) {
#pragma unroll
  for (int o = 1; o < 64; o <<= 1) { const float t = __shfl_up(v, o); if (lane >= o) v += t; }
  return v;
}
__device__ void phase_scan(const Params& p, int layer, unsigned char* lds) {
  const float* LOGF = (const float*)(p.ws + WS_LOGF);
  float* C = (float*)(p.ws + WS_C);
  float* CC = (float*)(p.ws + WS_CC);
  float* red = (float*)lds;
  const int tid = fresh_tid(), lane = tid & 63, wid = tid >> 6;
  {
    const bfraw* QKV = (const bfraw*)(p.ws + WS_QKV);
    unsigned* kmx = (unsigned*)(p.ws + WS_CTL) + KMAX_WORD + 64 * layer;
    for (int it = vblock(); it < 24 * 16; it += vgrid()) {
      const int bh = it >> 4, b = bh / 6, h = bh % 6, pos = (it & 15) * 256 + tid;
      const uint4* kp = (const uint4*)(QKV + (size_t)(b * SEQ + pos) * QKVW + 384 + h * 64);
      float ss = 0.f;
#pragma unroll
      for (int i = 0; i < 8; ++i) {
        const uint4 u = kp[i];
        const unsigned w[4] = {u.x, u.y, u.z, u.w};
#pragma unroll
        for (int k = 0; k < 4; ++k) { const float a = __uint_as_float(w[k] << 16), c = __uint_as_float(w[k] & 0xffff0000u); ss += a * a + c * c; }
      }
#pragma unroll
      for (int o = 32; o > 0; o >>= 1) ss = fmaxf(ss, __shfl_xor(ss, o));
      if (lane == 0) atomicMax(&kmx[bh], __float_as_uint(ss));
    }
  }
  for (int seq0 = blockIdx.x * 2; seq0 < 24 + 192; seq0 += vgrid()) {
    const int seq = min(seq0 + half_id(), 24 + 192 - 1);
    const bool pr = seq < 24;
    const int s = pr ? seq : seq - 24, b = s / 6, h = s % 6;
    float v[16];
    if (pr) {
      const float* base = LOGF + ((size_t)b * SEQ + tid * 16) * 8 + h;
#pragma unroll
      for (int i = 0; i < 16; ++i) v[i] = base[i * 8];
    } else {
      const float* base = p.cfl + (((size_t)layer * DECB + b) * PAST + tid * 8) * 6 + h;
#pragma unroll
      for (int i = 0; i < 8; ++i) v[i] = base[i * 6];
#pragma unroll
      for (int i = 8; i < 16; ++i) v[i] = 0.f;
    }
#pragma unroll
    for (int i = 1; i < 16; ++i) v[i] += v[i - 1];
    const float tot = v[15];
    const float inc = wave_incl_scan(tot, lane);
    if (lane == 63) red[wid] = inc;
    __syncthreads();
    const float r0 = red[0], r1 = red[1], r2 = red[2], r3 = red[3];
    float off = inc - tot;
    off += (wid > 0 ? r0 : 0.f) + (wid > 1 ? r1 : 0.f) + (wid > 2 ? r2 : 0.f);
    if (pr) {
      float* dst = C + ((size_t)b * SEQ + tid * 16) * 8 + h;
#pragma unroll
      for (int i = 0; i < 16; ++i) dst[i * 8] = off + v[i];
    } else {
      float* dst = CC + ((size_t)b * PAST + tid * 8) * 8 + h;
#pragma unroll
      for (int i = 0; i < 8; ++i) dst[i * 8] = off + v[i];
      if (wid == 0) {
        const size_t idx = ((size_t)TP + b * DECS + lane) * 8 + h;
        C[idx] = ((r0 + r1) + (r2 + r3)) + wave_incl_scan(LOGF[idx], lane);
      }
    }
    __syncthreads();
  }
}

__device__ void attn_item(const Params& p, int layer, int type, bool sample, int b, int h, int qb, unsigned char* lds, volatile LAS int* flg) {
  const bfraw* QKV = (const bfraw*)(p.ws + WS_QKV);
  const float* C = (const float*)(p.ws + WS_C);
  const float* CC = (const float*)(p.ws + WS_CC);
  bfraw* O = (bfraw*)(p.ws + WS_O);
  const int tid = fresh_tid(), lane = tid & 63, wid = tid >> 6, l15 = lane & 15, g = lane >> 4;
  const int qrow0 = sample ? TP + b * DECS : b * SEQ + qb * 64;
  const int ntiles = sample ? 33 : qb + 1;
  const int qoff = type ? 1152 : 0, koff = qoff + 384, voff = qoff + 768, hc = h * 64;
  const int qrow = qrow0 + wid * 16 + l15;
  const bfraw* qp = QKV + (size_t)qrow * QKVW + qoff + hc + g * 8;
  const bf16x8 q0 = *(const bf16x8*)qp, q1 = *(const bf16x8*)(qp + 32);
  float cq2 = 0.f;
  if (type == 0) cq2 = C[(size_t)qrow * 8 + h] * LOG2E;
  const bool fexit = (type == 0) && !sample;
  float bqk = 0.f, cnext = 0.f;
  if (fexit) {
    float qs = 0.f;
#pragma unroll
    for (int i = 0; i < 8; ++i) { const float a = bf2f((bfraw)q0[i]), c = bf2f((bfraw)q1[i]); qs += a * a + c * c; }
    qs += __shfl_xor(qs, 16); qs += __shfl_xor(qs, 32);
    const float kmax2 = __uint_as_float(((const unsigned*)(p.ws + WS_CTL))[KMAX_WORD + 64 * layer + b * 6 + h]);
    bqk = sqrtf(qs * kmax2) * (LOG2E * 1.01f) + 1.f;
  }
  const float* kcache = type ? p.csk : p.cfk;
  const float* vcache = type ? p.csv : p.cfv;

  float4 st[8]; float stc = 0.f;
  const int key_l = tid >> 3, dc = tid & 7;
  unsigned char* kd = lds + key_l * 144 + dc * 16;
  unsigned char* vd = kd + 9216;
  float* ckl = (float*)(lds + 18432);

#define ATTN_PREFETCH(t_)                                                                                         \
  do {                                                                                                            \
    const int tt_ = (t_);                                                                                         \
    if (!(sample && tt_ < 32)) {                                                                                  \
      const int krow = sample ? TP + b * DECS : b * SEQ + tt_ * 64;                                               \
      const bfraw* kp = QKV + (size_t)(krow + key_l) * QKVW + hc + dc * 8;                                        \
      st[0] = *(const float4*)(kp + koff); st[1] = *(const float4*)(kp + koff + 32 * QKVW);                       \
      st[2] = *(const float4*)(kp + voff); st[3] = *(const float4*)(kp + voff + 32 * QKVW);                       \
      if (type == 0 && tid < 64) stc = C[(size_t)(krow + tid) * 8 + h];                                           \
    } else {                                                                                                      \
      const size_t off = ((((size_t)layer * DECB + b) * PAST + tt_ * 64 + key_l) * 6 + h) * 64 + dc * 8;          \
      const float* kc = kcache + off; const float* vc = vcache + off;                                             \
      st[0] = *(const float4*)kc; st[1] = *(const float4*)(kc + 4);                                               \
      st[2] = *(const float4*)(kc + 32 * 384); st[3] = *(const float4*)(kc + 32 * 384 + 4);                       \
      st[4] = *(const float4*)vc; st[5] = *(const float4*)(vc + 4);                                               \
      st[6] = *(const float4*)(vc + 32 * 384); st[7] = *(const float4*)(vc + 32 * 384 + 4);                       \
      if (type == 0 && tid < 64) stc = CC[((size_t)b * PAST + tt_ * 64 + tid) * 8 + h];                           \
    }                                                                                                             \
  } while (0)

  f32x4 oacc[4];
#pragma unroll
  for (int i = 0; i < 4; ++i) oacc[i] = (f32x4){0.f, 0.f, 0.f, 0.f};
  float m = -1e30f, lsum = 0.f, R = 0.f;
  const int ql = wid * 16 + l15;
  const int i16 = l15, qq = i16 >> 2, pp = i16 & 3;
  const unsigned char* vtr = lds + 9216 + (4 * g + qq) * 144 + pp * 8;

  ATTN_PREFETCH(ntiles - 1);
  for (int t = ntiles - 1; t >= 0; --t) {
    if (!(sample && t < 32)) {
      *(float4*)kd = st[0]; *(float4*)(kd + 32 * 144) = st[1]; *(float4*)vd = st[2]; *(float4*)(vd + 32 * 144) = st[3];
    } else {
      uint4 a;
      a.x = pack2(st[0].x, st[0].y); a.y = pack2(st[0].z, st[0].w); a.z = pack2(st[1].x, st[1].y); a.w = pack2(st[1].z, st[1].w); *(uint4*)kd = a;
      a.x = pack2(st[2].x, st[2].y); a.y = pack2(st[2].z, st[2].w); a.z = pack2(st[3].x, st[3].y); a.w = pack2(st[3].z, st[3].w); *(uint4*)(kd + 32 * 144) = a;
      a.x = pack2(st[4].x, st[4].y); a.y = pack2(st[4].z, st[4].w); a.z = pack2(st[5].x, st[5].y); a.w = pack2(st[5].z, st[5].w); *(uint4*)vd = a;
      a.x = pack2(st[6].x, st[6].y); a.y = pack2(st[6].z, st[6].w); a.z = pack2(st[7].x, st[7].y); a.w = pack2(st[7].z, st[7].w); *(uint4*)(vd + 32 * 144) = a;
    }
    if (type == 0 && tid < 64) ckl[tid] = stc * LOG2E;
    __syncthreads();
    if (t > 0) ATTN_PREFETCH(t - 1);
    if (fexit && t > 0) cnext = C[(size_t)(b * SEQ + (t - 1) * 64 + 63) * 8 + h];
    const bool diag = (t == ntiles - 1);

    f32x4 s[4];
#pragma unroll
    for (int kb = 0; kb < 4; ++kb) {
      const unsigned char* ka = lds + (kb * 16 + l15) * 144 + g * 16;
      const bf16x8 a0 = *(const bf16x8*)ka, a1 = *(const bf16x8*)(ka + 64);
      f32x4 z = (f32x4){0.f, 0.f, 0.f, 0.f};
      z = __builtin_amdgcn_mfma_f32_16x16x32_bf16(a0, q0, z, 0, 0, 0);
      s[kb] = __builtin_amdgcn_mfma_f32_16x16x32_bf16(a1, q1, z, 0, 0, 0);
    }
    unsigned pk[8];
    if (type == 0) {
      float mx = -1e30f;
#pragma unroll
      for (int kb = 0; kb < 4; ++kb) {
        const f32x4 ck = *(const f32x4*)(ckl + kb * 16 + 4 * g);
#pragma unroll
        for (int j = 0; j < 4; ++j) {
          float x = s[kb][j] * LOG2E + cq2 - ck[j];
          if (diag && (kb * 16 + 4 * g + j > ql)) x = -1e30f;
          s[kb][j] = x; mx = fmaxf(mx, x);
        }
      }
      mx = fmaxf(mx, __shfl_xor(mx, 16)); mx = fmaxf(mx, __shfl_xor(mx, 32));
      const float mnew = fmaxf(m, mx);
      const float alpha = ex2(m - mnew);
      m = mnew;
      float ps = 0.f;
#pragma unroll
      for (int kb = 0; kb < 4; ++kb) {
        const float p0 = ex2(s[kb][0] - mnew), p1 = ex2(s[kb][1] - mnew), p2 = ex2(s[kb][2] - mnew), p3 = ex2(s[kb][3] - mnew);
        ps += (p0 + p1) + (p2 + p3);
        pk[kb * 2] = pack2(p0, p1); pk[kb * 2 + 1] = pack2(p2, p3);
      }
      lsum = lsum * alpha + ps;
#pragma unroll
      for (int db = 0; db < 4; ++db) oacc[db] *= alpha;
    } else {
      float lr[4][4];
#pragma unroll
      for (int kb = 0; kb < 4; ++kb)
#pragma unroll
        for (int j = 0; j < 4; ++j) {
          const float z2 = s[kb][j] * LOG2E;
          const float e = ex2(-fabsf(z2));
          float l = -(fmaxf(z2, 0.f) + lg2(1.f + e));
          if (diag && !(kb * 16 + 4 * g + j < ql)) l = 0.f;
          s[kb][j] = z2; lr[kb][j] = l;
        }
#pragma unroll
      for (int kb = 3; kb >= 0; --kb) {
        const float G = (lr[kb][0] + lr[kb][1]) + (lr[kb][2] + lr[kb][3]);
        const float a = __shfl_xor(G, 16), bb = __shfl_xor(G, 32), c = __shfl_xor(G, 48);
        const float tot = (G + a) + (bb + c);
        const float gt = ((g == 0 || g == 2) ? a : 0.f) + ((g < 2) ? (bb + c) : 0.f);
        const float a3 = R + gt, a2 = a3 + lr[kb][3], a1 = a2 + lr[kb][2], a0 = a1 + lr[kb][1];
        float p0 = ex2(s[kb][0] + lr[kb][0] + a0), p1 = ex2(s[kb][1] + lr[kb][1] + a1);
        float p2 = ex2(s[kb][2] + lr[kb][2] + a2), p3 = ex2(s[kb][3] + lr[kb][3] + a3);
        if (diag) {
          const int k0 = kb * 16 + 4 * g;
          if (!(k0 < ql)) p0 = 0.f;
          if (!(k0 + 1 < ql)) p1 = 0.f;
          if (!(k0 + 2 < ql)) p2 = 0.f;
          if (!(k0 + 3 < ql)) p3 = 0.f;
        }
        pk[kb * 2] = pack2(p0, p1); pk[kb * 2 + 1] = pack2(p2, p3);
        R += tot;
      }
      const int alldone = __all(R < SB_EXIT) ? 1 : 0;
      if (lane == 0) flg[half_id() * 4 + wid] = alldone;
    }
    if (fexit) {
      const int done = (t > 0 && __all(bqk + cq2 - cnext * LOG2E - m < FOX_EXIT)) ? 1 : 0;
      if (lane == 0) flg[half_id() * 4 + wid] = done;
    }
#pragma unroll
    for (int kk = 0; kk < 2; ++kk) {
      const uint4 pu = {pk[kk * 4], pk[kk * 4 + 1], pk[kk * 4 + 2], pk[kk * 4 + 3]};
      const bf16x8 pf = __builtin_bit_cast(bf16x8, pu);
#pragma unroll
      for (int db = 0; db < 4; ++db) {
        const unsigned char* va = vtr + (32 * kk) * 144 + db * 32;
        const s16x4 lo = __builtin_amdgcn_ds_read_tr16_b64_v4i16((LAS s16x4*)(va));
        const s16x4 hi = __builtin_amdgcn_ds_read_tr16_b64_v4i16((LAS s16x4*)(va + 16 * 144));
        const bf16x8 vf = __builtin_shufflevector(lo, hi, 0, 1, 2, 3, 4, 5, 6, 7);
        oacc[db] = __builtin_amdgcn_mfma_f32_16x16x32_bf16(vf, pf, oacc[db], 0, 0, 0);
      }
    }
    __syncthreads();
    if (type == 1 || fexit) { if (flg[0] & flg[1] & flg[2] & flg[3] & flg[4] & flg[5] & flg[6] & flg[7]) break; }
  }
#undef ATTN_PREFETCH
  if (type == 0) {
    lsum += __shfl_xor(lsum, 16); lsum += __shfl_xor(lsum, 32);
    const float inv = 1.f / lsum;
#pragma unroll
    for (int db = 0; db < 4; ++db) oacc[db] *= inv;
  }
  float ss = 0.f;
#pragma unroll
  for (int db = 0; db < 4; ++db)
#pragma unroll
    for (int j = 0; j < 4; ++j) ss += oacc[db][j] * oacc[db][j];
  ss += __shfl_xor(ss, 16); ss += __shfl_xor(ss, 32);
  const float rs = rsqrtf(ss * (1.f / 64.f) + 1e-6f);
  const int hoff = type ? 640 + hc : hc;
#pragma unroll
  for (int db = 0; db < 4; ++db) {
    const int d0 = 16 * db + 4 * g;
    const float4 gm = *(const float4*)(p.g_mix + layer * D + hoff + d0);
    uint2 o;
    o.x = pack2(oacc[db][0] * rs * gm.x, oacc[db][1] * rs * gm.y);
    o.y = pack2(oacc[db][2] * rs * gm.z, oacc[db][3] * rs * gm.w);
    *(uint2*)(O + (size_t)qrow * D + hoff + d0) = o;
  }
}

__device__ void sgu_item(const Params& p, int layer, bool sample, int ci, int g, unsigned char* lds) {
  const float* VG = (const float*)(p.ws + WS_VG);
  const bfraw* U = (const bfraw*)(p.ws + WS_U);
  bfraw* O = (bfraw*)(p.ws + WS_O);
  constexpr int LROW = 272;
  unsigned char* Wl = lds;
  unsigned char* Vt = lds + 128 * LROW;
  const int tid = fresh_tid(), lane = tid & 63, wid = tid >> 6;
  const int r0 = sample ? TP + ci * DECS : ci * 128;
  const int L = sample ? 64 : 128;
  {
    const float4 gv = *(const float4*)(p.g_v + layer * 256 + lane * 4), bv = *(const float4*)(p.b_v + layer * 256 + lane * 4);
    for (int i = wid; i < L; i += 4) {
      float4 v = *(const float4*)(VG + (size_t)(r0 + i) * 256 + lane * 4);
      const float mu = wave_sum(v.x + v.y + v.z + v.w) * (1.f / 256.f);
      v.x -= mu; v.y -= mu; v.z -= mu; v.w -= mu;
      const float rstd = rsqrtf(wave_sum(v.x * v.x + v.y * v.y + v.z * v.z + v.w * v.w) * (1.f / 256.f) + 1e-5f);
      float4 o;
      o.x = v.x * rstd * gv.x + bv.x; o.y = v.y * rstd * gv.y + bv.y; o.z = v.z * rstd * gv.z + bv.z; o.w = v.w * rstd * gv.w + bv.w;
      if ((lane >> 4) == g) {
        const unsigned lo = pack2(o.x, o.y), hi = pack2(o.z, o.w);
        unsigned char* vp = Vt + ((lane & 15) * 4) * LROW + i * 2;
        *(bfraw*)(vp) = (bfraw)(lo & 0xffffu); *(bfraw*)(vp + LROW) = (bfraw)(lo >> 16);
        *(bfraw*)(vp + 2 * LROW) = (bfraw)(hi & 0xffffu); *(bfraw*)(vp + 3 * LROW) = (bfraw)(hi >> 16);
        if (sample) *(float4*)(p.out + O_SGV + ((size_t)layer * TS + (r0 - TP) + i) * 256 + lane * 4) = o;
      }
    }
    const float* wg = p.w_s + ((size_t)layer * 4 + g) * 128 * 128;
#pragma unroll 4
    for (int k = 0; k < 16; ++k) {
      const int idx = tid + 256 * k, row = idx >> 5, c4 = (idx & 31) * 4;
      if (row < L) {
        const float4 w = *(const float4*)(wg + row * 128 + c4);
        uint2 o;
        o.x = pack2(c4 <= row ? w.x : 0.f, c4 + 1 <= row ? w.y : 0.f);
        o.y = pack2(c4 + 2 <= row ? w.z : 0.f, c4 + 3 <= row ? w.w : 0.f);
        *(uint2*)(Wl + row * LROW + c4 * 2) = o;
      }
    }
  }
  __syncthreads();
  if (wid * 32 < L) {
    const int r32 = lane & 31, h = lane >> 5;
    f32x16 acc[2];
#pragma unroll
    for (int ni = 0; ni < 2; ++ni)
#pragma unroll
      for (int i = 0; i < 16; ++i) acc[ni][i] = 0.f;
    const unsigned char* ap = Wl + (wid * 32 + r32) * LROW + h * 16;
    const unsigned char* bp = Vt + r32 * LROW + h * 16;
    const int nks = min(L / 16, 2 * (wid + 1));
    for (int ks = 0; ks < nks; ++ks) {
      const bf16x8 a = *(const bf16x8*)(ap + ks * 32);
      const bf16x8 b0 = *(const bf16x8*)(bp + ks * 32), b1 = *(const bf16x8*)(bp + 32 * LROW + ks * 32);
      acc[0] = __builtin_amdgcn_mfma_f32_32x32x16_bf16(a, b0, acc[0], 0, 0, 0);
      acc[1] = __builtin_amdgcn_mfma_f32_32x32x16_bf16(a, b1, acc[1], 0, 0, 0);
    }
    const float* bsp = p.b_s + ((size_t)layer * 4 + g) * 128 + wid * 32 + 4 * h;
    const float* gm = p.g_mix + layer * D + 384 + g * 64 + r32;
    const float gm0 = gm[0], gm1 = gm[32];
    const size_t rowb = (size_t)(r0 + wid * 32 + 4 * h);
#pragma unroll
    for (int i = 0; i < 16; ++i) {
      const int rl = (i & 3) + 8 * (i >> 2);
      const float bs = bsp[rl];
      const bfraw* up = U + (rowb + rl) * 256 + g * 64 + r32;
      const float o0 = bf2f(up[0]) * (acc[0][i] + bs), o1 = bf2f(up[32]) * (acc[1][i] + bs);
      float ss = o0 * o0 + o1 * o1;
      ss += __shfl_xor(ss, 1); ss += __shfl_xor(ss, 2); ss += __shfl_xor(ss, 4); ss += __shfl_xor(ss, 8); ss += __shfl_xor(ss, 16);
      const float rs = rsqrtf(ss * (1.f / 64.f) + 1e-6f);
      bfraw* op = O + (rowb + rl) * D + 384 + g * 64 + r32;
      op[0] = (bfraw)(pack2(o0 * rs * gm0, 0.f) & 0xffffu);
      op[32] = (bfraw)(pack2(o1 * rs * gm1, 0.f) & 0xffffu);
    }
  }
  __syncthreads();
}

__device__ void phase_mix(const Params& p, int layer, unsigned char* lds, volatile LAS int* slot) {
  unsigned* ctr = (unsigned*)(p.ws + WS_CTL) + QCTR_WORD + 64 * layer;
  volatile LAS int* flg = slot + 4;
  constexpr int N_SAMPLE = 384, N_PROMPT = 3072, N_SGU = 640, N_ALL = N_SAMPLE + N_PROMPT + N_SGU;
  for (;;) {
    if (threadIdx.x == 0) *slot = (int)atomicAdd(ctr, 1u);
    __syncthreads();
    const int item = *slot * 2 + half_id();
    __syncthreads();
    if (item >= N_ALL) break;
    if (item < N_SAMPLE) {
      const int type = item < 192 ? 1 : 0, r = item % 192;
      attn_item(p, layer, type, true, r / 6, r % 6, 0, lds, flg);
    } else if (item < N_SAMPLE + N_PROMPT) {
      const int r = item - N_SAMPLE, qb = 63 - r / 48, rr = r % 48, type = rr < 24 ? 1 : 0, bh = rr % 24;
      attn_item(p, layer, type, false, bh / 6, bh % 6, qb, lds, flg);
    } else {
      int r = item - N_SAMPLE - N_PROMPT;
      if (r < 512) sgu_item(p, layer, false, r >> 2, r & 3, lds);
      else { r -= 512; sgu_item(p, layer, true, r >> 2, r & 3, lds); }
    }
  }
}

__device__ void run_phase(const Params& p, int ph, unsigned char* lds, unsigned char* ring, volatile LAS int* slot) {
  const bfraw* XB = (const bfraw*)(p.ws + WS_XB);
  if (ph == 0) { phase_prep(p, lds); return; }
  const int layer = (ph - 1) >> 3, sub = (ph - 1) & 7;
  switch (sub) {
    case 0: phase_gemm8<EPI_INPROJ, 9, 1>(p, layer, XB, (const bfraw*)(p.ws + WS_WIN) + (size_t)layer * NIN * D, NIN, D, ring); break;
    case 1: phase_scan(p, layer, lds); break;
    case 2: phase_mix(p, layer, lds, slot); break;
    case 3: if (layer == 0) phase_gemm8<EPI_RESID_IN, 9, 1>(p, layer, (const bfraw*)(p.ws + WS_O), (const bfraw*)(p.ws + WS_WOUT) + (size_t)layer * D * D, D, D, ring);
            else phase_gemm8<EPI_RESID, 9, 1>(p, layer, (const bfraw*)(p.ws + WS_O), (const bfraw*)(p.ws + WS_WOUT) + (size_t)layer * D * D, D, D, ring);
            break;
    case 4: phase_ln(p, p.ln1_g + layer * D, p.ln1_b + layer * D, false); break;
    case 5: phase_gemm8<EPI_UP, 9, 1>(p, layer, XB, (const bfraw*)(p.ws + WS_WUP) + (size_t)layer * DFF * D, DFF, D, ring); break;
    case 6: phase_gemm8<EPI_RESID, 9, 1>(p, layer, (const bfraw*)(p.ws + WS_H), (const bfraw*)(p.ws + WS_WDN) + (size_t)layer * D * DFF, D, DFF, ring); break;
    default: phase_ln(p, p.ln2_g + layer * D, p.ln2_b + layer * D, layer == DEPTH - 1); break;
  }
}

__global__ void __launch_bounds__(512, 2) fwd_kernel(Params p) {
  extern __shared__ __attribute__((aligned(16))) unsigned char smem[];
  unsigned char* lds = smem + LDS_DATA + half_id() * HALF_LDS;
  volatile LAS unsigned* st = (volatile LAS unsigned*)smem;
  volatile LAS int* slot = (volatile LAS int*)(smem + 16);
  if (threadIdx.x == 0) { st[0] = 0u; st[1] = 0u; st[2] = 0u; st[3] = 0u; }
  __syncthreads();
  XcdBarrier xb;
  xb.bar = (unsigned*)(p.ws + WS_CTL); xb.x = 0; xb.st = st;
  if (p.coop) xb = xcd_barrier_post((unsigned*)(p.ws + WS_CTL), st);
  for (int ph = p.ph_lo; ph < p.ph_hi; ++ph) {
    if (ph > p.ph_lo) {
      if (p.pad) cg::this_grid().sync();
      xcd_barrier(xb);
    }
    run_phase(p, ph, lds, smem + LDS_DATA, slot);
  }
}

extern "C" void kernel_launch(void* const* d_in, const int* in_sizes, int n_in, void* d_out, int out_size, void* d_ws, size_t ws_size,
                              hipStream_t stream) {
  static int grid = 0;
  if (grid == 0) {
    if (n_in != 21 || (size_t)out_size != O_END || ws_size < WS_END) {
      fprintf(stderr, "kernel_launch: unexpected shapes: n_in %d out %d (want %zu) ws %zu (want >= %zu)\n", n_in, out_size, (size_t)O_END, ws_size, (size_t)WS_END);
      grid = -1; return;
    }
    int dev = 0, cus = 0, per_cu = 0;
    hipGetDevice(&dev);
    hipDeviceGetAttribute(&cus, hipDeviceAttributeMultiprocessorCount, dev);
    if (hipFuncSetAttribute((const void*)fwd_kernel, hipFuncAttributeMaxDynamicSharedMemorySize, LDS_BYTES) != hipSuccess) {
      fprintf(stderr, "kernel_launch: hipFuncSetAttribute failed\n"); grid = -1; return;
    }
    hipOccupancyMaxActiveBlocksPerMultiprocessor(&per_cu, (const void*)fwd_kernel, 512, LDS_BYTES);
    if (per_cu < 1) { fprintf(stderr, "kernel_launch: occupancy query says %d\n", per_cu); per_cu = 1; }
    if (per_cu > 1) per_cu = 1;
    grid = cus * per_cu;
  }
  if (grid < 0) return;
  hipMemsetAsync((char*)d_ws + WS_CTL, 0, CTL_BYTES, stream);
  Params p{};
  const float** f = (const float**)&p;
  for (int i = 0; i < 21; ++i) f[i] = (const float*)d_in[i];
  p.out = (float*)d_out; p.ws = (unsigned char*)d_ws;
#if MK_MODE == 0
  for (int ph = 0; ph < NPHASE; ++ph) {
    p.ph_lo = ph; p.ph_hi = ph + 1; p.coop = 0; p.pad = 0;
    hipLaunchKernelGGL(fwd_kernel, dim3(grid), dim3(512), LDS_BYTES, stream, p);
  }
#else
  p.ph_lo = 0; p.ph_hi = NPHASE; p.coop = 1; p.pad = 0;
  void* args[] = {&p};
  hipError_t e = hipLaunchCooperativeKernel((const void*)fwd_kernel, dim3(grid), dim3(512), args, LDS_BYTES, stream);
  if (e != hipSuccess) fprintf(stderr, "cooperative launch failed: %s (grid %d)\n", hipGetErrorString(e), grid);
#endif
}
```

```cpp
#include <hip/hip_runtime.h>
#include <hip/hip_cooperative_groups.h>
#include <cstdio>
#include <cstdint>
namespace cg = cooperative_groups;

#ifndef MK_MODE
#define MK_MODE 1
#endif

#define DI __device__ __forceinline__
typedef unsigned short bfraw;
typedef __attribute__((ext_vector_type(8))) short bf16x8;
typedef __attribute__((ext_vector_type(4))) short s16x4;
typedef __attribute__((ext_vector_type(4))) float f32x4;
typedef __attribute__((ext_vector_type(16))) float f32x16;
typedef __attribute__((ext_vector_type(2))) __bf16 bf2_t;
typedef __attribute__((ext_vector_type(2))) float f2_t;
#define LAS __attribute__((address_space(3)))

DI unsigned pack2(float a, float b) { f2_t x = {a, b}; bf2_t y = __builtin_convertvector(x, bf2_t); return __builtin_bit_cast(unsigned, y); }
DI float bf2f(bfraw v) { return __uint_as_float(((unsigned)v) << 16); }
DI int fresh_tid() { int t = threadIdx.x & 255; asm volatile("" : "+v"(t)); return t; }
DI int half_id() { return __builtin_amdgcn_readfirstlane((int)(threadIdx.x >> 8)); }
DI int vblock() { return (int)blockIdx.x * 2 + half_id(); }
DI int vgrid() { return (int)gridDim.x * 2; }
DI float ex2(float x) { return __builtin_amdgcn_exp2f(x); }
DI float lg2(float x) { return __builtin_amdgcn_logf(x); }

constexpr int D = 1024, TP = 16384, TS = 2048, TT = TP + TS, SEQ = 4096, DECB = 32, DECS = 64, PAST = 2048;
constexpr int NIN = 3072, DFF = 4096, DEPTH = 2, QKVW = 2304, DIN = 2822;
constexpr float ALPHA = 1.41421356237309515f;
constexpr float LOG2E = 1.44269504088896341f;
constexpr float LN2 = 0.69314718055994531f;
constexpr float SB_EXIT = -160.f;
constexpr float FOX_EXIT = -160.f;
constexpr int KMAX_WORD = 12288;

constexpr size_t O_YP = 0;
constexpr size_t O_YS = O_YP + (size_t)TP * D;
constexpr size_t O_PFK = O_YS + (size_t)TS * D;
constexpr size_t O_PFV = O_PFK + (size_t)DEPTH * TP * 384;
constexpr size_t O_PFL = O_PFV + (size_t)DEPTH * TP * 384;
constexpr size_t O_PSK = O_PFL + (size_t)DEPTH * TP * 6;
constexpr size_t O_PSV = O_PSK + (size_t)DEPTH * TP * 384;
constexpr size_t O_SFK = O_PSV + (size_t)DEPTH * TP * 384;
constexpr size_t O_SFV = O_SFK + (size_t)DEPTH * TS * 384;
constexpr size_t O_SFL = O_SFV + (size_t)DEPTH * TS * 384;
constexpr size_t O_SSK = O_SFL + (size_t)DEPTH * TS * 6;
constexpr size_t O_SSV = O_SSK + (size_t)DEPTH * TS * 384;
constexpr size_t O_SGV = O_SSV + (size_t)DEPTH * TS * 384;
constexpr size_t O_END = O_SGV + (size_t)DEPTH * TS * 256;

constexpr size_t WS_CTL = 0;
constexpr size_t CTL_BYTES = 65536;
constexpr size_t WS_WIN = WS_CTL + CTL_BYTES;
constexpr size_t WS_WOUT = WS_WIN + (size_t)DEPTH * NIN * D * 2;
constexpr size_t WS_WUP = WS_WOUT + (size_t)DEPTH * D * D * 2;
constexpr size_t WS_WDN = WS_WUP + (size_t)DEPTH * DFF * D * 2;
constexpr size_t WS_XB = WS_WDN + (size_t)DEPTH * D * DFF * 2;
constexpr size_t WS_X32 = WS_XB + (size_t)TT * D * 2;
constexpr size_t WS_Y = WS_X32 + (size_t)TT * D * 4;
constexpr size_t WS_QKV = WS_Y + (size_t)TT * D * 4;
constexpr size_t WS_U = WS_QKV + (size_t)TT * QKVW * 2;
constexpr size_t WS_VG = WS_U + (size_t)TT * 256 * 2;
constexpr size_t WS_LOGF = WS_VG + (size_t)TT * 256 * 4;
constexpr size_t WS_C = WS_LOGF + (size_t)TT * 8 * 4;
constexpr size_t WS_CC = WS_C + (size_t)TT * 8 * 4;
constexpr size_t WS_O = WS_CC + (size_t)DECB * PAST * 8 * 4;
constexpr size_t WS_H = WS_O + (size_t)TT * D * 2;
constexpr size_t WS_END = WS_H + (size_t)TT * DFF * 2;

constexpr int LDS_DATA = 64;
constexpr int ABUF = 128 * 144;
constexpr int HALF_LDS = 69632;
constexpr int LDS_BYTES = LDS_DATA + 2 * HALF_LDS;
constexpr int NPHASE = 1 + 8 * DEPTH;
constexpr int QCTR_WORD = 8192;

struct Params {
  const float *x_prompt, *x_sample, *cfk, *cfv, *cfl, *csk, *csv, *w_in, *b_f, *g_v, *b_v, *w_s, *b_s, *g_mix, *w_out,
      *ln1_g, *ln1_b, *w_up, *w_down, *ln2_g, *ln2_b;
  float* out;
  unsigned char* ws;
  int ph_lo, ph_hi, coop, pad;
};

#define XB_TMO      128
#define XB_XCNT(j)  (256  + 64 * (j))
#define XB_XSUB(j)  (1280 + 64 * (j))
#define XB_XGEN(j)  (2304 + 64 * (j))
#define XB_TOP      3328
#define XB_TOPGEN   3392
#define XCD_BAR_WORDS 3456
#define XB_SPIN_CAP (1u << 22)
DI unsigned xb_ld(unsigned* p) { return __hip_atomic_load(p, __ATOMIC_RELAXED, __HIP_MEMORY_SCOPE_AGENT); }
DI unsigned xb_add(unsigned* p, unsigned v) { return __hip_atomic_fetch_add(p, v, __ATOMIC_RELAXED, __HIP_MEMORY_SCOPE_AGENT); }
DI unsigned xb_xcc_id() { return (unsigned)__builtin_amdgcn_s_getreg((3 << 11) | 20) & 0xFu; }
#define XB_SPIN(cond, bar) do { unsigned _sp = 0; while (cond) { __builtin_amdgcn_s_sleep(1); \
    if ((++_sp & 255u) == 0u) { if (xb_ld(&(bar)[XB_TMO])) break; if (_sp > XB_SPIN_CAP) { atomicAdd(&(bar)[XB_TMO], 1u); break; } } } } while (0)
struct XcdBarrier { unsigned* bar; unsigned x; volatile LAS unsigned* st; };
DI XcdBarrier xcd_barrier_post(unsigned* bar, volatile LAS unsigned* st) {
  XcdBarrier b; b.bar = bar; b.x = xb_xcc_id(); b.st = st;
  if (threadIdx.x == 0) (void)xb_add(&bar[XB_XCNT(b.x)], 1u);
  return b;
}
DI void xcd_barrier_complete(unsigned* bar, unsigned x, unsigned& nloc, unsigned& nx) {
  const unsigned G = gridDim.x * gridDim.y * gridDim.z;
  unsigned sum, cnt, mine, sp = 0u;
  for (;;) {
    sum = 0u; cnt = 0u; mine = 0u;
#pragma unroll
    for (unsigned j = 0; j < 16; ++j) { const unsigned c = xb_ld(&bar[XB_XCNT(j)]); sum += c; cnt += (c > 0u) ? 1u : 0u; mine = (j == x) ? c : mine; }
    if (sum == G) break;
    __builtin_amdgcn_s_sleep(1);
    if ((++sp & 255u) == 0u) { if (xb_ld(&bar[XB_TMO])) break; if (sp > XB_SPIN_CAP) { atomicAdd(&bar[XB_TMO], 1u); break; } }
  }
  nloc = mine > 0u ? mine : 1u; nx = cnt > 0u ? cnt : 1u;
}
DI void xcd_barrier(const XcdBarrier& b) {
  asm volatile("s_waitcnt vmcnt(0)" ::: "memory");
  __syncthreads();
  if (threadIdx.x == 0) {
    unsigned* bar = b.bar;
    __builtin_amdgcn_s_waitcnt(0);
    unsigned nloc = b.st[0], nx = b.st[1];
    if (nloc == 0u) { xcd_barrier_complete(bar, b.x, nloc, nx); b.st[0] = nloc; b.st[1] = nx; }
    const unsigned old = xb_add(&bar[XB_XSUB(b.x)], 1u);
    const unsigned gen = old / nloc;
    if (old + 1u == (gen + 1u) * nloc) {
      __builtin_amdgcn_fence(__ATOMIC_RELEASE, "agent");
      asm volatile("s_waitcnt vmcnt(0)" ::: "memory");
      const unsigned og = xb_add(&bar[XB_TOP], 1u);
      const unsigned tg = og / nx;
      if (og + 1u == (tg + 1u) * nx) xb_add(&bar[XB_TOPGEN], 1u);
      else XB_SPIN(xb_ld(&bar[XB_TOPGEN]) == tg, bar);
      __builtin_amdgcn_fence(__ATOMIC_ACQUIRE, "agent");
      xb_add(&bar[XB_XGEN(b.x)], 1u);
      asm volatile("s_waitcnt vmcnt(0)" ::: "memory");
    } else {
      XB_SPIN(xb_ld(&bar[XB_XGEN(b.x)]) == gen, bar);
      __builtin_amdgcn_fence(__ATOMIC_ACQUIRE, "agent");
      asm volatile("s_waitcnt vmcnt(0)" ::: "memory");
    }
  }
  __syncthreads();
}

DI float gelu_tanh(float x) {
  const float y = 0.7978845608028654f * (x + 0.044715f * x * x * x);
  const float t = 1.f - 2.f / (1.f + __expf(2.f * y));
  return 0.5f * x * (1.f + t);
}
DI float log_sigmoid(float x) { return fminf(x, 0.f) - LN2 * lg2(1.f + ex2(-fabsf(x) * LOG2E)); }
DI float wave_sum(float v) {
#pragma unroll
  for (int o = 32; o > 0; o >>= 1) v += __shfl_xor(v, o);
  return v;
}

DI int win_map(int np) { return np < 1152 ? np : (np < 2304 ? np + 518 : (np < 2816 ? np - 1146 : (np < 2822 ? np - 1664 : -1))); }

__device__ void prep_transpose(const float* __restrict__ src, int srcN, int K, int k0, int n0, bfraw* __restrict__ dst, bool winmap, float* lds) {
  const int tid = fresh_tid(), nn = tid & 63, kr = tid >> 6;
  const int np = n0 + nn;
  const int n = winmap ? win_map(np) : np;
#pragma unroll
  for (int it = 0; it < 16; ++it) {
    const int kk = it * 4 + kr;
    const float v = (n >= 0) ? src[(size_t)(k0 + kk) * srcN + n] : 0.f;
    lds[kk * 65 + nn] = v;
  }
  __syncthreads();
#pragma unroll
  for (int j = 0; j < 2; ++j) {
    const int c = tid + 256 * j, n2 = c >> 3, kc = c & 7;
    const float* s = lds + (kc * 8) * 65 + n2;
    uint4 o;
    o.x = pack2(s[0], s[65]); o.y = pack2(s[130], s[195]); o.z = pack2(s[260], s[325]); o.w = pack2(s[390], s[455]);
    *(uint4*)(dst + (size_t)(n0 + n2) * K + k0 + kc * 8) = o;
  }
  __syncthreads();
}

__device__ void phase_prep(const Params& p, unsigned char* lds) {
  bfraw* WinT = (bfraw*)(p.ws + WS_WIN); bfraw* WoutT = (bfraw*)(p.ws + WS_WOUT);
  bfraw* WupT = (bfraw*)(p.ws + WS_WUP); bfraw* WdnT = (bfraw*)(p.ws + WS_WDN);
  bfraw* XB = (bfraw*)(p.ws + WS_XB);
  constexpr int PER_L = 768 + 256 + 1024 + 1024, NW = DEPTH * PER_L, NX = TT / 16;
  for (int it0 = blockIdx.x * 2; it0 < NW + NX; it0 += vgrid()) {
    const int it = min(it0 + half_id(), NW + NX - 1);
    if (it < NW) {
      const int l = it / PER_L; int r = it % PER_L;
      if (r < 768) prep_transpose(p.w_in + (size_t)l * D * DIN, DIN, D, (r & 15) * 64, (r >> 4) * 64, WinT + (size_t)l * NIN * D, true, (float*)lds);
      else if (r < 1024) { r -= 768; prep_transpose(p.w_out + (size_t)l * D * D, D, D, (r & 15) * 64, (r >> 4) * 64, WoutT + (size_t)l * D * D, false, (float*)lds); }
      else if (r < 2048) { r -= 1024; prep_transpose(p.w_up + (size_t)l * D * DFF, DFF, D, (r & 15) * 64, (r >> 4) * 64, WupT + (size_t)l * DFF * D, false, (float*)lds); }
      else { r -= 2048; prep_transpose(p.w_down + (size_t)l * DFF * D, D, DFF, (r & 63) * 64, (r >> 6) * 64, WdnT + (size_t)l * D * DFF, false, (float*)lds); }
    } else {
      const int tid0 = fresh_tid();
      const int row0 = (it - NW) * 16;
      const float* src = row0 < TP ? p.x_prompt + (size_t)row0 * D : p.x_sample + (size_t)(row0 - TP) * D;
      bfraw* dst = XB + (size_t)row0 * D;
#pragma unroll 4
      for (int i = 0; i < 16; ++i) {
        const int idx = (tid0 + 256 * i) * 4;
        const float4 v = *(const float4*)(src + idx);
        uint2 o; o.x = pack2(v.x, v.y); o.y = pack2(v.z, v.w);
        *(uint2*)(dst + idx) = o;
      }
    }
  }
}

enum { EPI_INPROJ = 0, EPI_RESID = 1, EPI_UP = 2, EPI_RESID_IN = 3 };

template <int EPI, int MI, int NI>
DI void gemm_epilogue(const Params& p, int layer, f32x16 (&acc)[MI][NI], int m0, int rbase, int nc0, int r32, int h, bool from_input) {
  if (EPI == EPI_INPROJ) {
    bfraw* QKV = (bfraw*)(p.ws + WS_QKV);
    if (nc0 < QKVW) {
      const int which = nc0 / 384;
      const float scale = (which == 0 || which == 3) ? 0.125f : 1.f;
      const int colin = nc0 - which * 384;
      const size_t offp = which == 1 ? O_PFK : which == 2 ? O_PFV : which == 4 ? O_PSK : O_PSV;
      const size_t offs = which == 1 ? O_SFK : which == 2 ? O_SFV : which == 4 ? O_SSK : O_SSV;
      const bool has_out = (which == 1 || which == 2 || which == 4 || which == 5);
      float* outP = p.out + offp + (size_t)layer * TP * 384 + colin + r32;
      float* outS = p.out + offs + ((size_t)layer * TS * 384 - (size_t)TP * 384) + colin + r32;
#pragma unroll
      for (int mi = 0; mi < MI; ++mi)
#pragma unroll
        for (int ni = 0; ni < NI; ++ni)
#pragma unroll
          for (int i = 0; i < 16; ++i) {
            const int row = m0 + rbase + mi * 32 + (i & 3) + 8 * (i >> 2) + 4 * h;
            const float v = acc[mi][ni][i];
            QKV[(size_t)row * QKVW + nc0 + ni * 32 + r32] = (bfraw)(pack2(v * scale, 0.f) & 0xffffu);
            if (has_out) { float* ob = row < TP ? outP : outS; ob[(size_t)row * 384 + ni * 32] = v; }
          }
    } else if (nc0 < 2560) {
      bfraw* U = (bfraw*)(p.ws + WS_U);
#pragma unroll
      for (int mi = 0; mi < MI; ++mi)
#pragma unroll
        for (int ni = 0; ni < NI; ++ni)
#pragma unroll
          for (int i = 0; i < 16; ++i) {
            const int rl = rbase + mi * 32 + (i & 3) + 8 * (i >> 2) + 4 * h;
            const int col = ni * 32 + r32;
            U[(size_t)(m0 + rl) * 256 + (nc0 - 2304) + col] = (bfraw)(pack2(gelu_tanh(acc[mi][ni][i]), 0.f) & 0xffffu);
          }
    } else if (nc0 < 2816) {
      float* VG = (float*)(p.ws + WS_VG);
#pragma unroll
      for (int mi = 0; mi < MI; ++mi)
#pragma unroll
        for (int ni = 0; ni < NI; ++ni)
#pragma unroll
          for (int i = 0; i < 16; ++i) {
            const int rl = rbase + mi * 32 + (i & 3) + 8 * (i >> 2) + 4 * h;
            const int col = ni * 32 + r32;
            VG[(size_t)(m0 + rl) * 256 + (nc0 - 2560) + col] = gelu_tanh(acc[mi][ni][i]);
          }
    } else if (nc0 == 2816) {
      if (r32 < 6) {
        float* LOGF = (float*)(p.ws + WS_LOGF);
        float* outP = p.out + O_PFL + (size_t)layer * TP * 6 + r32;
        float* outS = p.out + O_SFL + ((size_t)layer * TS * 6 - (size_t)TP * 6) + r32;
        const float bias = p.b_f[layer * 6 + r32];
#pragma unroll
        for (int mi = 0; mi < MI; ++mi)
#pragma unroll
          for (int i = 0; i < 16; ++i) {
            const int row = m0 + rbase + mi * 32 + (i & 3) + 8 * (i >> 2) + 4 * h;
            const float lf = log_sigmoid(acc[mi][0][i] + bias);
            LOGF[(size_t)row * 8 + r32] = lf;
            float* ob = row < TP ? outP : outS;
            ob[(size_t)row * 6] = lf;
          }
      }
    }
  } else if (EPI == EPI_RESID_IN) {
    unsigned char* Yb = p.ws + WS_Y;
    const float* xp = p.x_prompt + nc0 + r32;
    const float* xs = p.x_sample - (size_t)TP * D + nc0 + r32;
    const unsigned o0 = (unsigned)(((m0 + rbase + 4 * h) * D + nc0 + r32) * 4);
#pragma unroll
    for (int mi = 0; mi < MI; ++mi) {
      float xr[NI][16];
#pragma unroll
      for (int ni = 0; ni < NI; ++ni)
#pragma unroll
        for (int i = 0; i < 16; ++i) {
          const int row = m0 + rbase + 4 * h + mi * 32 + (i & 3) + 8 * (i >> 2);
          xr[ni][i] = (row < TP ? xp : xs)[(size_t)row * D + ni * 32];
        }
#pragma unroll
      for (int ni = 0; ni < NI; ++ni)
#pragma unroll
        for (int i = 0; i < 16; ++i)
          *(float*)(Yb + (o0 + (unsigned)(((mi * 32 + (i & 3) + 8 * (i >> 2)) * D + ni * 32) * 4))) = ALPHA * xr[ni][i] + acc[mi][ni][i];
    }
  } else if (EPI == EPI_RESID) {
    unsigned char* Yb = p.ws + WS_Y;
    const unsigned char* Xb = p.ws + WS_X32;
    const unsigned o0 = (unsigned)(((m0 + rbase + 4 * h) * D + nc0 + r32) * 4);
#pragma unroll
    for (int mi = 0; mi < MI; ++mi) {
      float xr[NI][16];
#pragma unroll
      for (int ni = 0; ni < NI; ++ni)
#pragma unroll
        for (int i = 0; i < 16; ++i)
          xr[ni][i] = *(const float*)(Xb + (o0 + (unsigned)(((mi * 32 + (i & 3) + 8 * (i >> 2)) * D + ni * 32) * 4)));
#pragma unroll
      for (int ni = 0; ni < NI; ++ni)
#pragma unroll
        for (int i = 0; i < 16; ++i)
          *(float*)(Yb + (o0 + (unsigned)(((mi * 32 + (i & 3) + 8 * (i >> 2)) * D + ni * 32) * 4))) = ALPHA * xr[ni][i] + acc[mi][ni][i];
    }
  } else {
    bfraw* H = (bfraw*)(p.ws + WS_H);
#pragma unroll
    for (int mi = 0; mi < MI; ++mi)
#pragma unroll
      for (int ni = 0; ni < NI; ++ni)
#pragma unroll
        for (int i = 0; i < 16; ++i) {
          const int rl = rbase + mi * 32 + (i & 3) + 8 * (i >> 2) + 4 * h;
          const int col = nc0 + ni * 32 + r32;
          const float v = fmaxf(acc[mi][ni][i], 0.f);
          H[(size_t)(m0 + rl) * DFF + col] = (bfraw)(pack2(v * v, 0.f) & 0xffffu);
        }
  }
}

template <int EPI, int MI, int NI>
__device__ void gemm_tile8(const Params& p, int layer, const bfraw* __restrict__ A, const bfraw* __restrict__ Bt, int K, int m0, int n0, unsigned char* ring, bool from_input) {
  constexpr int WGM = NI == 2 ? 2 : 1, WGN = 8 / WGM;
  constexpr int BM = WGM * MI * 32;
  constexpr int STAGE = (BM + 256) * 128;
  constexpr int NAI = BM / 8;
  constexpr int NA = (NAI + 7) / 8;
  int tid = threadIdx.x; asm volatile("" : "+v"(tid));
  const int lane = tid & 63, wid = tid >> 6, wm = wid / WGN, wn = wid % WGN;
  const int r32 = lane & 31, h = lane >> 5;
  f32x16 acc[MI][NI];
#pragma unroll
  for (int a = 0; a < MI; ++a)
#pragma unroll
    for (int b = 0; b < NI; ++b)
#pragma unroll
      for (int i = 0; i < 16; ++i) acc[a][b][i] = 0.f;
  const int dc = (lane & 7) ^ (((wid & 1) * 4 + (lane >> 4)) & 7);
  const unsigned loff = (unsigned)(((wid * 8 + (lane >> 3)) * K + dc * 8) * 2);
  const unsigned char* ab = (const unsigned char*)(A + (size_t)m0 * K);
  const unsigned char* bb = (const unsigned char*)(Bt + (size_t)n0 * K);
  unsigned char* dl = ring + wid * 1024 + lane * 16;
#define ISSUE8A(kt_, st_) do { \
    _Pragma("unroll") for (int j = 0; j < NA; ++j) { \
      if (NAI % 8 == 0 || j < NA - 1 || wid < NAI % 8) \
        __builtin_amdgcn_global_load_lds((const unsigned*)(ab + ((size_t)j * 64 * K + (kt_) * 64) * 2 + loff), (unsigned*)(dl + (st_) * STAGE + j * 8192), 16, 0, 0); } \
  } while (0)
#define ISSUE8B(kt_, st_) do { \
    _Pragma("unroll") for (int j = 0; j < 4; ++j) \
      __builtin_amdgcn_global_load_lds((const unsigned*)(bb + ((size_t)j * 64 * K + (kt_) * 64) * 2 + loff), (unsigned*)(dl + (st_) * STAGE + BM * 128 + j * 8192), 16, 0, 0); \
  } while (0)
#define ISSUE8(kt_, st_) do { ISSUE8A(kt_, st_); ISSUE8B(kt_, st_); } while (0)
  const int key = (r32 >> 1) & 7;
  const unsigned char* afr = ring + (wm * (MI * 32) + r32) * 128;
  const unsigned char* bfr = ring + BM * 128 + (wn * (NI * 32) + r32) * 128;
  const int nk = K >> 6;
  asm volatile("s_waitcnt vmcnt(0)" ::: "memory");
  __builtin_amdgcn_s_barrier();
  asm volatile("" ::: "memory");
  ISSUE8(0, 0);
  int st = 0;
  for (int kt = 0; kt < nk; ++kt) {
    asm volatile("s_waitcnt vmcnt(0)" ::: "memory");
    __builtin_amdgcn_s_barrier();
    asm volatile("" ::: "memory");
    if (kt + 1 < nk) ISSUE8A(kt + 1, st ^ 1);
    const unsigned char* as = afr + st * STAGE;
    const unsigned char* bs = bfr + st * STAGE;
#pragma unroll
    for (int ks = 0; ks < 4; ++ks) {
      if (ks == 2 && kt + 1 < nk) ISSUE8B(kt + 1, st ^ 1);
      const int o = ((ks * 2 + h) ^ key) * 16;
      bf16x8 af[MI], bq[NI];
#pragma unroll
      for (int mi = 0; mi < MI; ++mi) af[mi] = *(const bf16x8*)(as + mi * 4096 + o);
#pragma unroll
      for (int ni = 0; ni < NI; ++ni) bq[ni] = *(const bf16x8*)(bs + ni * 4096 + o);
#pragma unroll
      for (int mi = 0; mi < MI; ++mi)
#pragma unroll
        for (int ni = 0; ni < NI; ++ni)
          acc[mi][ni] = __builtin_amdgcn_mfma_f32_32x32x16_bf16(af[mi], bq[ni], acc[mi][ni], 0, 0, 0);
    }
    st ^= 1;
  }
#undef ISSUE8
#undef ISSUE8A
#undef ISSUE8B
  gemm_epilogue<EPI, MI, NI>(p, layer, acc, m0, wm * (MI * 32), n0 + wn * (NI * 32), r32, h, from_input);
}

template <int EPI, int MI, int NI>
__device__ void phase_gemm8(const Params& p, int layer, const bfraw* A, const bfraw* Bt, int N, int K, unsigned char* ring, bool from_input = false) {
  constexpr int BM = (NI == 2 ? 2 : 1) * MI * 32;
  const int ntn = N / 256, ntiles = (TT / BM) * ntn;
  for (int t = blockIdx.x; t < ntiles; t += gridDim.x) {
    const int tm = t / ntn, tn = t % ntn;
    gemm_tile8<EPI, MI, NI>(p, layer, A, Bt, K, tm * BM, tn * 256, ring, from_input);
  }
  __syncthreads();
}

__device__ void phase_ln(const Params& p, const float* __restrict__ gam, const float* __restrict__ bet, bool last) {
  const float* Y = (const float*)(p.ws + WS_Y);
  float* X32 = (float*)(p.ws + WS_X32);
  bfraw* XB = (bfraw*)(p.ws + WS_XB);
  const int tid_ = fresh_tid(); const int lane = tid_ & 63, wid = tid_ >> 6;
  for (int row = vblock() * 4 + wid; row < TT; row += vgrid() * 4) {
    const float* y = Y + (size_t)row * D;
    float4 v[4];
#pragma unroll
    for (int j = 0; j < 4; ++j) v[j] = *(const float4*)(y + lane * 4 + 256 * j);
    float s = 0.f;
#pragma unroll
    for (int j = 0; j < 4; ++j) s += v[j].x + v[j].y + v[j].z + v[j].w;
    const float mu = wave_sum(s) * (1.f / D);
    float q = 0.f;
#pragma unroll
    for (int j = 0; j < 4; ++j) { v[j].x -= mu; v[j].y -= mu; v[j].z -= mu; v[j].w -= mu; q += v[j].x * v[j].x + v[j].y * v[j].y + v[j].z * v[j].z + v[j].w * v[j].w; }
    const float rstd = rsqrtf(wave_sum(q) * (1.f / D) + 1e-5f);
#pragma unroll
    for (int j = 0; j < 4; ++j) {
      const int c = lane * 4 + 256 * j;
      const float4 g = *(const float4*)(gam + c), b = *(const float4*)(bet + c);
      float4 o;
      o.x = v[j].x * rstd * g.x + b.x; o.y = v[j].y * rstd * g.y + b.y; o.z = v[j].z * rstd * g.z + b.z; o.w = v[j].w * rstd * g.w + b.w;
      if (last) {
        *(float4*)(p.out + (size_t)row * D + c) = o;
      } else {
        *(float4*)(X32 + (size_t)row * D + c) = o;
        uint2 ob; ob.x = pack2(o.x, o.y); ob.y = pack2(o.z, o.w);
        *(uint2*)(XB + (size_t)row * D + c) = ob;
      }
    }
  }
}

DI float wave_incl_scan(float v, int lane) {
#pragma unroll
  for (int o = 1; o < 64; o <<= 1) { const float t = __shfl_up(v, o); if (lane >= o) v += t; }
  return v;
}
__device__ void phase_scan(const Params& p, int layer, unsigned char* lds) {
  const float* LOGF = (const float*)(p.ws + WS_LOGF);
  float* C = (float*)(p.ws + WS_C);
  float* CC = (float*)(p.ws + WS_CC);
  float* red = (float*)lds;
  const int tid = fresh_tid(), lane = tid & 63, wid = tid >> 6;
  {
    const bfraw* QKV = (const bfraw*)(p.ws + WS_QKV);
    unsigned* kmx = (unsigned*)(p.ws + WS_CTL) + KMAX_WORD + 64 * layer;
    for (int it = vblock(); it < 24 * 16; it += vgrid()) {
      const int bh = it >> 4, b = bh / 6, h = bh % 6, pos = (it & 15) * 256 + tid;
      const uint4* kp = (const uint4*)(QKV + (size_t)(b * SEQ + pos) * QKVW + 384 + h * 64);
      float ss = 0.f;
#pragma unroll
      for (int i = 0; i < 8; ++i) {
        const uint4 u = kp[i];
        const unsigned w[4] = {u.x, u.y, u.z, u.w};
#pragma unroll
        for (int k = 0; k < 4; ++k) { const float a = __uint_as_float(w[k] << 16), c = __uint_as_float(w[k] & 0xffff0000u); ss += a * a + c * c; }
      }
#pragma unroll
      for (int o = 32; o > 0; o >>= 1) ss = fmaxf(ss, __shfl_xor(ss, o));
      if (lane == 0) atomicMax(&kmx[bh], __float_as_uint(ss));
    }
  }
  for (int seq0 = blockIdx.x * 2; seq0 < 24 + 192; seq0 += vgrid()) {
    const int seq = min(seq0 + half_id(), 24 + 192 - 1);
    const bool pr = seq < 24;
    const int s = pr ? seq : seq - 24, b = s / 6, h = s % 6;
    float v[16];
    if (pr) {
      const float* base = LOGF + ((size_t)b * SEQ + tid * 16) * 8 + h;
#pragma unroll
      for (int i = 0; i < 16; ++i) v[i] = base[i * 8];
    } else {
      const float* base = p.cfl + (((size_t)layer * DECB + b) * PAST + tid * 8) * 6 + h;
#pragma unroll
      for (int i = 0; i < 8; ++i) v[i] = base[i * 6];
#pragma unroll
      for (int i = 8; i < 16; ++i) v[i] = 0.f;
    }
#pragma unroll
    for (int i = 1; i < 16; ++i) v[i] += v[i - 1];
    const float tot = v[15];
    const float inc = wave_incl_scan(tot, lane);
    if (lane == 63) red[wid] = inc;
    __syncthreads();
    const float r0 = red[0], r1 = red[1], r2 = red[2], r3 = red[3];
    float off = inc - tot;
    off += (wid > 0 ? r0 : 0.f) + (wid > 1 ? r1 : 0.f) + (wid > 2 ? r2 : 0.f);
    if (pr) {
      float* dst = C + ((size_t)b * SEQ + tid * 16) * 8 + h;
#pragma unroll
      for (int i = 0; i < 16; ++i) dst[i * 8] = off + v[i];
    } else {
      float* dst = CC + ((size_t)b * PAST + tid * 8) * 8 + h;
#pragma unroll
      for (int i = 0; i < 8; ++i) dst[i * 8] = off + v[i];
      if (wid == 0) {
        const size_t idx = ((size_t)TP + b * DECS + lane) * 8 + h;
        C[idx] = ((r0 + r1) + (r2 + r3)) + wave_incl_scan(LOGF[idx], lane);
      }
    }
    __syncthreads();
  }
}

__device__ void attn_item(const Params& p, int layer, int type, bool sample, int b, int h, int qb, unsigned char* lds, volatile LAS int* flg) {
  const bfraw* QKV = (const bfraw*)(p.ws + WS_QKV);
  const float* C = (const float*)(p.ws + WS_C);
  const float* CC = (const float*)(p.ws + WS_CC);
  bfraw* O = (bfraw*)(p.ws + WS_O);
  const int tid = fresh_tid(), lane = tid & 63, wid = tid >> 6, l15 = lane & 15, g = lane >> 4;
  const int qrow0 = sample ? TP + b * DECS : b * SEQ + qb * 64;
  const int ntiles = sample ? 33 : qb + 1;
  const int qoff = type ? 1152 : 0, koff = qoff + 384, voff = qoff + 768, hc = h * 64;
  const int qrow = qrow0 + wid * 16 + l15;
  const bfraw* qp = QKV + (size_t)qrow * QKVW + qoff + hc + g * 8;
  const bf16x8 q0 = *(const bf16x8*)qp, q1 = *(const bf16x8*)(qp + 32);
  float cq2 = 0.f;
  if (type == 0) cq2 = C[(size_t)qrow * 8 + h] * LOG2E;
  const bool fexit = (type == 0) && !sample;
  float bqk = 0.f, cnext = 0.f;
  if (fexit) {
    float qs = 0.f;
#pragma unroll
    for (int i = 0; i < 8; ++i) { const float a = bf2f((bfraw)q0[i]), c = bf2f((bfraw)q1[i]); qs += a * a + c * c; }
    qs += __shfl_xor(qs, 16); qs += __shfl_xor(qs, 32);
    const float kmax2 = __uint_as_float(((const unsigned*)(p.ws + WS_CTL))[KMAX_WORD + 64 * layer + b * 6 + h]);
    bqk = sqrtf(qs * kmax2) * (LOG2E * 1.01f) + 1.f;
  }
  const float* kcache = type ? p.csk : p.cfk;
  const float* vcache = type ? p.csv : p.cfv;

  float4 st[8]; float stc = 0.f;
  const int key_l = tid >> 3, dc = tid & 7;
  unsigned char* kd = lds + key_l * 144 + dc * 16;
  unsigned char* vd = kd + 9216;
  float* ckl = (float*)(lds + 18432);

#define ATTN_PREFETCH(t_)                                                                                         \
  do {                                                                                                            \
    const int tt_ = (t_);                                                                                         \
    if (!(sample && tt_ < 32)) {                                                                                  \
      const int krow = sample ? TP + b * DECS : b * SEQ + tt_ * 64;                                               \
      const bfraw* kp = QKV + (size_t)(krow + key_l) * QKVW + hc + dc * 8;                                        \
      st[0] = *(const float4*)(kp + koff); st[1] = *(const float4*)(kp + koff + 32 * QKVW);                       \
      st[2] = *(const float4*)(kp + voff); st[3] = *(const float4*)(kp + voff + 32 * QKVW);                       \
      if (type == 0 && tid < 64) stc = C[(size_t)(krow + tid) * 8 + h];                                           \
    } else {                                                                                                      \
      const size_t off = ((((size_t)layer * DECB + b) * PAST + tt_ * 64 + key_l) * 6 + h) * 64 + dc * 8;          \
      const float* kc = kcache + off; const float* vc = vcache + off;                                             \
      st[0] = *(const float4*)kc; st[1] = *(const float4*)(kc + 4);                                               \
      st[2] = *(const float4*)(kc + 32 * 384); st[3] = *(const float4*)(kc + 32 * 384 + 4);                       \
      st[4] = *(const float4*)vc; st[5] = *(const float4*)(vc + 4);                                               \
      st[6] = *(const float4*)(vc + 32 * 384); st[7] = *(const float4*)(vc + 32 * 384 + 4);                       \
      if (type == 0 && tid < 64) stc = CC[((size_t)b * PAST + tt_ * 64 + tid) * 8 + h];                           \
    }                                                                                                             \
  } while (0)

  f32x4 oacc[4];
#pragma unroll
  for (int i = 0; i < 4; ++i) oacc[i] = (f32x4){0.f, 0.f, 0.f, 0.f};
  float m = -1e30f, lsum = 0.f, R = 0.f;
  const int ql = wid * 16 + l15;
  const int i16 = l15, qq = i16 >> 2, pp = i16 & 3;
  const unsigned char* vtr = lds + 9216 + (4 * g + qq) * 144 + pp * 8;

  ATTN_PREFETCH(ntiles - 1);
  for (int t = ntiles - 1; t >= 0; --t) {
    if (!(sample && t < 32)) {
      *(float4*)kd = st[0]; *(float4*)(kd + 32 * 144) = st[1]; *(float4*)vd = st[2]; *(float4*)(vd + 32 * 144) = st[3];
    } else {
      uint4 a;
      a.x = pack2(st[0].x, st[0].y); a.y = pack2(st[0].z, st[0].w); a.z = pack2(st[1].x, st[1].y); a.w = pack2(st[1].z, st[1].w); *(uint4*)kd = a;
      a.x = pack2(st[2].x, st[2].y); a.y = pack2(st[2].z, st[2].w); a.z = pack2(st[3].x, st[3].y); a.w = pack2(st[3].z, st[3].w); *(uint4*)(kd + 32 * 144) = a;
      a.x = pack2(st[4].x, st[4].y); a.y = pack2(st[4].z, st[4].w); a.z = pack2(st[5].x, st[5].y); a.w = pack2(st[5].z, st[5].w); *(uint4*)vd = a;
      a.x = pack2(st[6].x, st[6].y); a.y = pack2(st[6].z, st[6].w); a.z = pack2(st[7].x, st[7].y); a.w = pack2(st[7].z, st[7].w); *(uint4*)(vd + 32 * 144) = a;
    }
    if (type == 0 && tid < 64) ckl[tid] = stc * LOG2E;
    __syncthreads();
    if (t > 0) ATTN_PREFETCH(t - 1);
    if (fexit && t > 0) cnext = C[(size_t)(b * SEQ + (t - 1) * 64 + 63) * 8 + h];
    const bool diag = (t == ntiles - 1);

    f32x4 s[4];
#pragma unroll
    for (int kb = 0; kb < 4; ++kb) {
      const unsigned char* ka = lds + (kb * 16 + l15) * 144 + g * 16;
      const bf16x8 a0 = *(const bf16x8*)ka, a1 = *(const bf16x8*)(ka + 64);
      f32x4 z = (f32x4){0.f, 0.f, 0.f, 0.f};
      z = __builtin_amdgcn_mfma_f32_16x16x32_bf16(a0, q0, z, 0, 0, 0);
      s[kb] = __builtin_amdgcn_mfma_f32_16x16x32_bf16(a1, q1, z, 0, 0, 0);
    }
    unsigned pk[8];
    if (type == 0) {
      float mx = -1e30f;
#pragma unroll
      for (int kb = 0; kb < 4; ++kb) {
        const f32x4 ck = *(const f32x4*)(ckl + kb * 16 + 4 * g);
#pragma unroll
        for (int j = 0; j < 4; ++j) {
          float x = s[kb][j] * LOG2E + cq2 - ck[j];
          if (diag && (kb * 16 + 4 * g + j > ql)) x = -1e30f;
          s[kb][j] = x; mx = fmaxf(mx, x);
        }
      }
      mx = fmaxf(mx, __shfl_xor(mx, 16)); mx = fmaxf(mx, __shfl_xor(mx, 32));
      const float mnew = fmaxf(m, mx);
      const float alpha = ex2(m - mnew);
      m = mnew;
      float ps = 0.f;
#pragma unroll
      for (int kb = 0; kb < 4; ++kb) {
        const float p0 = ex2(s[kb][0] - mnew), p1 = ex2(s[kb][1] - mnew), p2 = ex2(s[kb][2] - mnew), p3 = ex2(s[kb][3] - mnew);
        ps += (p0 + p1) + (p2 + p3);
        pk[kb * 2] = pack2(p0, p1); pk[kb * 2 + 1] = pack2(p2, p3);
      }
      lsum = lsum * alpha + ps;
#pragma unroll
      for (int db = 0; db < 4; ++db) oacc[db] *= alpha;
    } else {
      float lr[4][4];
#pragma unroll
      for (int kb = 0; kb < 4; ++kb)
#pragma unroll
        for (int j = 0; j < 4; ++j) {
          const float z2 = s[kb][j] * LOG2E;
          const float e = ex2(-fabsf(z2));
          float l = -(fmaxf(z2, 0.f) + lg2(1.f + e));
          if (diag && !(kb * 16 + 4 * g + j < ql)) l = 0.f;
          s[kb][j] = z2; lr[kb][j] = l;
        }
#pragma unroll
      for (int kb = 3; kb >= 0; --kb) {
        const float G = (lr[kb][0] + lr[kb][1]) + (lr[kb][2] + lr[kb][3]);
        const float a = __shfl_xor(G, 16), bb = __shfl_xor(G, 32), c = __shfl_xor(G, 48);
        const float tot = (G + a) + (bb + c);
        const float gt = ((g == 0 || g == 2) ? a : 0.f) + ((g < 2) ? (bb + c) : 0.f);
        const float a3 = R + gt, a2 = a3 + lr[kb][3], a1 = a2 + lr[kb][2], a0 = a1 + lr[kb][1];
        float p0 = ex2(s[kb][0] + lr[kb][0] + a0), p1 = ex2(s[kb][1] + lr[kb][1] + a1);
        float p2 = ex2(s[kb][2] + lr[kb][2] + a2), p3 = ex2(s[kb][3] + lr[kb][3] + a3);
        if (diag) {
          const int k0 = kb * 16 + 4 * g;
          if (!(k0 < ql)) p0 = 0.f;
          if (!(k0 + 1 < ql)) p1 = 0.f;
          if (!(k0 + 2 < ql)) p2 = 0.f;
          if (!(k0 + 3 < ql)) p3 = 0.f;
        }
        pk[kb * 2] = pack2(p0, p1); pk[kb * 2 + 1] = pack2(p2, p3);
        R += tot;
      }
      const int alldone = __all(R < SB_EXIT) ? 1 : 0;
      if (lane == 0) flg[half_id() * 4 + wid] = alldone;
    }
    if (fexit) {
      const int done = (t > 0 && __all(bqk + cq2 - cnext * LOG2E - m < FOX_EXIT)) ? 1 : 0;
      if (lane == 0) flg[half_id() * 4 + wid] = done;
    }
#pragma unroll
    for (int kk = 0; kk < 2; ++kk) {
      const uint4 pu = {pk[kk * 4], pk[kk * 4 + 1], pk[kk * 4 + 2], pk[kk * 4 + 3]};
      const bf16x8 pf = __builtin_bit_cast(bf16x8, pu);
#pragma unroll
      for (int db = 0; db < 4; ++db) {
        const unsigned char* va = vtr + (32 * kk) * 144 + db * 32;
        const s16x4 lo = __builtin_amdgcn_ds_read_tr16_b64_v4i16((LAS s16x4*)(va));
        const s16x4 hi = __builtin_amdgcn_ds_read_tr16_b64_v4i16((LAS s16x4*)(va + 16 * 144));
        const bf16x8 vf = __builtin_shufflevector(lo, hi, 0, 1, 2, 3, 4, 5, 6, 7);
        oacc[db] = __builtin_amdgcn_mfma_f32_16x16x32_bf16(vf, pf, oacc[db], 0, 0, 0);
      }
    }
    __syncthreads();
    if (type == 1 || fexit) { if (flg[0] & flg[1] & flg[2] & flg[3] & flg[4] & flg[5] & flg[6] & flg[7]) break; }
  }
#undef ATTN_PREFETCH
  if (type == 0) {
    lsum += __shfl_xor(lsum, 16); lsum += __shfl_xor(lsum, 32);
    const float inv = 1.f / lsum;
#pragma unroll
    for (int db = 0; db < 4; ++db) oacc[db] *= inv;
  }
  float ss = 0.f;
#pragma unroll
  for (int db = 0; db < 4; ++db)
#pragma unroll
    for (int j = 0; j < 4; ++j) ss += oacc[db][j] * oacc[db][j];
  ss += __shfl_xor(ss, 16); ss += __shfl_xor(ss, 32);
  const float rs = rsqrtf(ss * (1.f / 64.f) + 1e-6f);
  const int hoff = type ? 640 + hc : hc;
#pragma unroll
  for (int db = 0; db < 4; ++db) {
    const int d0 = 16 * db + 4 * g;
    const float4 gm = *(const float4*)(p.g_mix + layer * D + hoff + d0);
    uint2 o;
    o.x = pack2(oacc[db][0] * rs * gm.x, oacc[db][1] * rs * gm.y);
    o.y = pack2(oacc[db][2] * rs * gm.z, oacc[db][3] * rs * gm.w);
    *(uint2*)(O + (size_t)qrow * D + hoff + d0) = o;
  }
}

__device__ void sgu_item(const Params& p, int layer, bool sample, int ci, int g, unsigned char* lds) {
  const float* VG = (const float*)(p.ws + WS_VG);
  const bfraw* U = (const bfraw*)(p.ws + WS_U);
  bfraw* O = (bfraw*)(p.ws + WS_O);
  constexpr int LROW = 272;
  unsigned char* Wl = lds;
  unsigned char* Vt = lds + 128 * LROW;
  const int tid = fresh_tid(), lane = tid & 63, wid = tid >> 6;
  const int r0 = sample ? TP + ci * DECS : ci * 128;
  const int L = sample ? 64 : 128;
  {
    const float4 gv = *(const float4*)(p.g_v + layer * 256 + lane * 4), bv = *(const float4*)(p.b_v + layer * 256 + lane * 4);
    for (int i = wid; i < L; i += 4) {
      float4 v = *(const float4*)(VG + (size_t)(r0 + i) * 256 + lane * 4);
      const float mu = wave_sum(v.x + v.y + v.z + v.w) * (1.f / 256.f);
      v.x -= mu; v.y -= mu; v.z -= mu; v.w -= mu;
      const float rstd = rsqrtf(wave_sum(v.x * v.x + v.y * v.y + v.z * v.z + v.w * v.w) * (1.f / 256.f) + 1e-5f);
      float4 o;
      o.x = v.x * rstd * gv.x + bv.x; o.y = v.y * rstd * gv.y + bv.y; o.z = v.z * rstd * gv.z + bv.z; o.w = v.w * rstd * gv.w + bv.w;
      if ((lane >> 4) == g) {
        const unsigned lo = pack2(o.x, o.y), hi = pack2(o.z, o.w);
        unsigned char* vp = Vt + ((lane & 15) * 4) * LROW + i * 2;
        *(bfraw*)(vp) = (bfraw)(lo & 0xffffu); *(bfraw*)(vp + LROW) = (bfraw)(lo >> 16);
        *(bfraw*)(vp + 2 * LROW) = (bfraw)(hi & 0xffffu); *(bfraw*)(vp + 3 * LROW) = (bfraw)(hi >> 16);
        if (sample) *(float4*)(p.out + O_SGV + ((size_t)layer * TS + (r0 - TP) + i) * 256 + lane * 4) = o;
      }
    }
    const float* wg = p.w_s + ((size_t)layer * 4 + g) * 128 * 128;
#pragma unroll 4
    for (int k = 0; k < 16; ++k) {
      const int idx = tid + 256 * k, row = idx >> 5, c4 = (idx & 31) * 4;
      if (row < L) {
        const float4 w = *(const float4*)(wg + row * 128 + c4);
        uint2 o;
        o.x = pack2(c4 <= row ? w.x : 0.f, c4 + 1 <= row ? w.y : 0.f);
        o.y = pack2(c4 + 2 <= row ? w.z : 0.f, c4 + 3 <= row ? w.w : 0.f);
        *(uint2*)(Wl + row * LROW + c4 * 2) = o;
      }
    }
  }
  __syncthreads();
  if (wid * 32 < L) {
    const int r32 = lane & 31, h = lane >> 5;
    f32x16 acc[2];
#pragma unroll
    for (int ni = 0; ni < 2; ++ni)
#pragma unroll
      for (int i = 0; i < 16; ++i) acc[ni][i] = 0.f;
    const unsigned char* ap = Wl + (wid * 32 + r32) * LROW + h * 16;
    const unsigned char* bp = Vt + r32 * LROW + h * 16;
    const int nks = min(L / 16, 2 * (wid + 1));
    for (int ks = 0; ks < nks; ++ks) {
      const bf16x8 a = *(const bf16x8*)(ap + ks * 32);
      const bf16x8 b0 = *(const bf16x8*)(bp + ks * 32), b1 = *(const bf16x8*)(bp + 32 * LROW + ks * 32);
      acc[0] = __builtin_amdgcn_mfma_f32_32x32x16_bf16(a, b0, acc[0], 0, 0, 0);
      acc[1] = __builtin_amdgcn_mfma_f32_32x32x16_bf16(a, b1, acc[1], 0, 0, 0);
    }
    const float* bsp = p.b_s + ((size_t)layer * 4 + g) * 128 + wid * 32 + 4 * h;
    const float* gm = p.g_mix + layer * D + 384 + g * 64 + r32;
    const float gm0 = gm[0], gm1 = gm[32];
    const size_t rowb = (size_t)(r0 + wid * 32 + 4 * h);
#pragma unroll
    for (int i = 0; i < 16; ++i) {
      const int rl = (i & 3) + 8 * (i >> 2);
      const float bs = bsp[rl];
      const bfraw* up = U + (rowb + rl) * 256 + g * 64 + r32;
      const float o0 = bf2f(up[0]) * (acc[0][i] + bs), o1 = bf2f(up[32]) * (acc[1][i] + bs);
      float ss = o0 * o0 + o1 * o1;
      ss += __shfl_xor(ss, 1); ss += __shfl_xor(ss, 2); ss += __shfl_xor(ss, 4); ss += __shfl_xor(ss, 8); ss += __shfl_xor(ss, 16);
      const float rs = rsqrtf(ss * (1.f / 64.f) + 1e-6f);
      bfraw* op = O + (rowb + rl) * D + 384 + g * 64 + r32;
      op[0] = (bfraw)(pack2(o0 * rs * gm0, 0.f) & 0xffffu);
      op[32] = (bfraw)(pack2(o1 * rs * gm1, 0.f) & 0xffffu);
    }
  }
  __syncthreads();
}

__device__ void phase_mix(const Params& p, int layer, unsigned char* lds, volatile LAS int* slot) {
  unsigned* ctr = (unsigned*)(p.ws + WS_CTL) + QCTR_WORD + 64 * layer;
  volatile LAS int* flg = slot + 4;
  constexpr int N_SAMPLE = 384, N_PROMPT = 3072, N_SGU = 640, N_ALL = N_SAMPLE + N_PROMPT + N_SGU;
  for (;;) {
    if (threadIdx.x == 0) *slot = (int)atomicAdd(ctr, 1u);
    __syncthreads();
    const int item = *slot * 2 + half_id();
    __syncthreads();
    if (item >= N_ALL) break;
    if (item < N_SAMPLE) {
      const int type = item < 192 ? 1 : 0, r = item % 192;
      attn_item(p, layer, type, true, r / 6, r % 6, 0, lds, flg);
    } else if (item < N_SAMPLE + N_PROMPT) {
      const int r = item - N_SAMPLE, qb = 63 - r / 48, rr = r % 48, type = rr < 24 ? 1 : 0, bh = rr % 24;
      attn_item(p, layer, type, false, bh / 6, bh % 6, qb, lds, flg);
    } else {
      int r = item - N_SAMPLE - N_PROMPT;
      if (r < 512) sgu_item(p, layer, false, r >> 2, r & 3, lds);
      else { r -= 512; sgu_item(p, layer, true, r >> 2, r & 3, lds); }
    }
  }
}

__device__ void run_phase(const Params& p, int ph, unsigned char* lds, unsigned char* ring, volatile LAS int* slot) {
  const bfraw* XB = (const bfraw*)(p.ws + WS_XB);
  if (ph == 0) { phase_prep(p, lds); return; }
  const int layer = (ph - 1) >> 3, sub = (ph - 1) & 7;
  switch (sub) {
    case 0: phase_gemm8<EPI_INPROJ, 9, 1>(p, layer, XB, (const bfraw*)(p.ws + WS_WIN) + (size_t)layer * NIN * D, NIN, D, ring); break;
    case 1: phase_scan(p, layer, lds); break;
    case 2: phase_mix(p, layer, lds, slot); break;
    case 3: if (layer == 0) phase_gemm8<EPI_RESID_IN, 9, 1>(p, layer, (const bfraw*)(p.ws + WS_O), (const bfraw*)(p.ws + WS_WOUT) + (size_t)layer * D * D, D, D, ring);
            else phase_gemm8<EPI_RESID, 9, 1>(p, layer, (const bfraw*)(p.ws + WS_O), (const bfraw*)(p.ws + WS_WOUT) + (size_t)layer * D * D, D, D, ring);
            break;
    case 4: phase_ln(p, p.ln1_g + layer * D, p.ln1_b + layer * D, false); break;
    case 5: phase_gemm8<EPI_UP, 9, 1>(p, layer, XB, (const bfraw*)(p.ws + WS_WUP) + (size_t)layer * DFF * D, DFF, D, ring); break;
    case 6: phase_gemm8<EPI_RESID, 9, 1>(p, layer, (const bfraw*)(p.ws + WS_H), (const bfraw*)(p.ws + WS_WDN) + (size_t)layer * D * DFF, D, DFF, ring); break;
    default: phase_ln(p, p.ln2_g + layer * D, p.ln2_b + layer * D, layer == DEPTH - 1); break;
  }
}

__global__ void __launch_bounds__(512, 2) fwd_kernel(Params p) {
  extern __shared__ __attribute__((aligned(16))) unsigned char smem[];
  unsigned char* lds = smem + LDS_DATA + half_id() * HALF_LDS;
  volatile LAS unsigned* st = (volatile LAS unsigned*)smem;
  volatile LAS int* slot = (volatile LAS int*)(smem + 16);
  if (threadIdx.x == 0) { st[0] = 0u; st[1] = 0u; st[2] = 0u; st[3] = 0u; }
  __syncthreads();
  XcdBarrier xb;
  xb.bar = (unsigned*)(p.ws + WS_CTL); xb.x = 0; xb.st = st;
  if (p.coop) xb = xcd_barrier_post((unsigned*)(p.ws + WS_CTL), st);
  for (int ph = p.ph_lo; ph < p.ph_hi; ++ph) {
    if (ph > p.ph_lo) {
      if (p.pad) cg::this_grid().sync();
      xcd_barrier(xb);
    }
    run_phase(p, ph, lds, smem + LDS_DATA, slot);
  }
}

extern "C" void kernel_launch(void* const* d_in, const int* in_sizes, int n_in, void* d_out, int out_size, void* d_ws, size_t ws_size,
                              hipStream_t stream) {
  static int grid = 0;
  if (grid == 0) {
    if (n_in != 21 || (size_t)out_size != O_END || ws_size < WS_END) {
      fprintf(stderr, "kernel_launch: unexpected shapes: n_in %d out %d (want %zu) ws %zu (want >= %zu)\n", n_in, out_size, (size_t)O_END, ws_size, (size_t)WS_END);
      grid = -1; return;
    }
    int dev = 0, cus = 0, per_cu = 0;
    hipGetDevice(&dev);
    hipDeviceGetAttribute(&cus, hipDeviceAttributeMultiprocessorCount, dev);
    if (hipFuncSetAttribute((const void*)fwd_kernel, hipFuncAttributeMaxDynamicSharedMemorySize, LDS_BYTES) != hipSuccess) {
      fprintf(stderr, "kernel_launch: hipFuncSetAttribute failed\n"); grid = -1; return;
    }
    hipOccupancyMaxActiveBlocksPerMultiprocessor(&per_cu, (const void*)fwd_kernel, 512, LDS_BYTES);
    if (per_cu < 1) { fprintf(stderr, "kernel_launch: occupancy query says %d\n", per_cu); per_cu = 1; }
    if (per_cu > 1) per_cu = 1;
    grid = cus * per_cu;
  }
  if (grid < 0) return;
  hipMemsetAsync((char*)d_ws + WS_CTL, 0, CTL_BYTES, stream);
  Params p{};
  const float** f = (const float**)&p;
  for (int i = 0; i < 21; ++i) f[i] = (const float*)d_in[i];
  p.out = (float*)d_out; p.ws = (unsigned char*)d_ws;
#if MK_MODE == 0
  for (int ph = 0; ph < NPHASE; ++ph) {
    p.ph_lo = ph; p.ph_hi = ph + 1; p.coop = 0; p.pad = 0;
    hipLaunchKernelGGL(fwd_kernel, dim3(grid), dim3(512), LDS_BYTES, stream, p);
  }
#else
  p.ph_lo = 0; p.ph_hi = NPHASE; p.coop = 1; p.pad = 0;
  void* args[] = {&p};
  hipError_t e = hipLaunchCooperativeKernel((const void*)fwd_kernel, dim3(grid), dim3(512), args, LDS_BYTES, stream);
  if (e != hipSuccess) fprintf(stderr, "cooperative launch failed: %s (grid %d)\n", hipGetErrorString(e), grid);
#endif
}
```

```cpp
#include <hip/hip_runtime.h>
#include <hip/hip_cooperative_groups.h>
#include <cstdio>
#include <cstdint>
namespace cg = cooperative_groups;

#ifndef MK_MODE
#define MK_MODE 1
#endif

#define DI __device__ __forceinline__
typedef unsigned short bfraw;
typedef __attribute__((ext_vector_type(8))) short bf16x8;
typedef __attribute__((ext_vector_type(4))) short s16x4;
typedef __attribute__((ext_vector_type(4))) float f32x4;
typedef __attribute__((ext_vector_type(16))) float f32x16;
typedef __attribute__((ext_vector_type(2))) __bf16 bf2_t;
typedef __attribute__((ext_vector_type(2))) float f2_t;
#define LAS __attribute__((address_space(3)))

DI unsigned pack2(float a, float b) { f2_t x = {a, b}; bf2_t y = __builtin_convertvector(x, bf2_t); return __builtin_bit_cast(unsigned, y); }
DI float bf2f(bfraw v) { return __uint_as_float(((unsigned)v) << 16); }
DI int fresh_tid() { int t = threadIdx.x & 255; asm volatile("" : "+v"(t)); return t; }
DI int half_id() { return __builtin_amdgcn_readfirstlane((int)(threadIdx.x >> 8)); }
DI int vblock() { return (int)blockIdx.x * 2 + half_id(); }
DI int vgrid() { return (int)gridDim.x * 2; }
DI float ex2(float x) { return __builtin_amdgcn_exp2f(x); }
DI float lg2(float x) { return __builtin_amdgcn_logf(x); }

constexpr int D = 1024, TP = 16384, TS = 2048, TT = TP + TS, SEQ = 4096, DECB = 32, DECS = 64, PAST = 2048;
constexpr int NIN = 3072, DFF = 4096, DEPTH = 2, QKVW = 2304, DIN = 2822;
constexpr float ALPHA = 1.41421356237309515f;
constexpr float LOG2E = 1.44269504088896341f;
constexpr float LN2 = 0.69314718055994531f;
constexpr float SB_EXIT = -160.f;
constexpr float FOX_EXIT = -160.f;
constexpr int KMAX_WORD = 12288;

constexpr size_t O_YP = 0;
constexpr size_t O_YS = O_YP + (size_t)TP * D;
constexpr size_t O_PFK = O_YS + (size_t)TS * D;
constexpr size_t O_PFV = O_PFK + (size_t)DEPTH * TP * 384;
constexpr size_t O_PFL = O_PFV + (size_t)DEPTH * TP * 384;
constexpr size_t O_PSK = O_PFL + (size_t)DEPTH * TP * 6;
constexpr size_t O_PSV = O_PSK + (size_t)DEPTH * TP * 384;
constexpr size_t O_SFK = O_PSV + (size_t)DEPTH * TP * 384;
constexpr size_t O_SFV = O_SFK + (size_t)DEPTH * TS * 384;
constexpr size_t O_SFL = O_SFV + (size_t)DEPTH * TS * 384;
constexpr size_t O_SSK = O_SFL + (size_t)DEPTH * TS * 6;
constexpr size_t O_SSV = O_SSK + (size_t)DEPTH * TS * 384;
constexpr size_t O_SGV = O_SSV + (size_t)DEPTH * TS * 384;
constexpr size_t O_END = O_SGV + (size_t)DEPTH * TS * 256;

constexpr size_t WS_CTL = 0;
constexpr size_t CTL_BYTES = 65536;
constexpr size_t WS_WIN = WS_CTL + CTL_BYTES;
constexpr size_t WS_WOUT = WS_WIN + (size_t)DEPTH * NIN * D * 2;
constexpr size_t WS_WUP = WS_WOUT + (size_t)DEPTH * D * D * 2;
constexpr size_t WS_WDN = WS_WUP + (size_t)DEPTH * DFF * D * 2;
constexpr size_t WS_XB = WS_WDN + (size_t)DEPTH * D * DFF * 2;
constexpr size_t WS_X32 = WS_XB + (size_t)TT * D * 2;
constexpr size_t WS_Y = WS_X32 + (size_t)TT * D * 4;
constexpr size_t WS_QKV = WS_Y + (size_t)TT * D * 4;
constexpr size_t WS_U = WS_QKV + (size_t)TT * QKVW * 2;
constexpr size_t WS_VG = WS_U + (size_t)TT * 256 * 2;
constexpr size_t WS_LOGF = WS_VG + (size_t)TT * 256 * 4;
constexpr size_t WS_C = WS_LOGF + (size_t)TT * 8 * 4;
constexpr size_t WS_CC = WS_C + (size_t)TT * 8 * 4;
constexpr size_t WS_O = WS_CC + (size_t)DECB * PAST * 8 * 4;
constexpr size_t WS_H = WS_O + (size_t)TT * D * 2;
constexpr size_t WS_END = WS_H + (size_t)TT * DFF * 2;

constexpr int LDS_DATA = 64;
constexpr int ABUF = 128 * 144;
constexpr int HALF_LDS = 69632;
constexpr int LDS_BYTES = LDS_DATA + 2 * HALF_LDS;
constexpr int NPHASE = 1 + 8 * DEPTH;
constexpr int QCTR_WORD = 8192;

struct Params {
  const float *x_prompt, *x_sample, *cfk, *cfv, *cfl, *csk, *csv, *w_in, *b_f, *g_v, *b_v, *w_s, *b_s, *g_mix, *w_out,
      *ln1_g, *ln1_b, *w_up, *w_down, *ln2_g, *ln2_b;
  float* out;
  unsigned char* ws;
  int ph_lo, ph_hi, coop, pad;
};

#define XB_TMO      128
#define XB_XCNT(j)  (256  + 64 * (j))
#define XB_XSUB(j)  (1280 + 64 * (j))
#define XB_XGEN(j)  (2304 + 64 * (j))
#define XB_TOP      3328
#define XB_TOPGEN   3392
#define XCD_BAR_WORDS 3456
#define XB_SPIN_CAP (1u << 22)
DI unsigned xb_ld(unsigned* p) { return __hip_atomic_load(p, __ATOMIC_RELAXED, __HIP_MEMORY_SCOPE_AGENT); }
DI unsigned xb_add(unsigned* p, unsigned v) { return __hip_atomic_fetch_add(p, v, __ATOMIC_RELAXED, __HIP_MEMORY_SCOPE_AGENT); }
DI unsigned xb_xcc_id() { return (unsigned)__builtin_amdgcn_s_getreg((3 << 11) | 20) & 0xFu; }
#define XB_SPIN(cond, bar) do { unsigned _sp = 0; while (cond) { __builtin_amdgcn_s_sleep(1); \
    if ((++_sp & 255u) == 0u) { if (xb_ld(&(bar)[XB_TMO])) break; if (_sp > XB_SPIN_CAP) { atomicAdd(&(bar)[XB_TMO], 1u); break; } } } } while (0)
struct XcdBarrier { unsigned* bar; unsigned x; volatile LAS unsigned* st; };
DI XcdBarrier xcd_barrier_post(unsigned* bar, volatile LAS unsigned* st) {
  XcdBarrier b; b.bar = bar; b.x = xb_xcc_id(); b.st = st;
  if (threadIdx.x == 0) (void)xb_add(&bar[XB_XCNT(b.x)], 1u);
  return b;
}
DI void xcd_barrier_complete(unsigned* bar, unsigned x, unsigned& nloc, unsigned& nx) {
  const unsigned G = gridDim.x * gridDim.y * gridDim.z;
  unsigned sum, cnt, mine, sp = 0u;
  for (;;) {
    sum = 0u; cnt = 0u; mine = 0u;
#pragma unroll
    for (unsigned j = 0; j < 16; ++j) { const unsigned c = xb_ld(&bar[XB_XCNT(j)]); sum += c; cnt += (c > 0u) ? 1u : 0u; mine = (j == x) ? c : mine; }
    if (sum == G) break;
    __builtin_amdgcn_s_sleep(1);
    if ((++sp & 255u) == 0u) { if (xb_ld(&bar[XB_TMO])) break; if (sp > XB_SPIN_CAP) { atomicAdd(&bar[XB_TMO], 1u); break; } }
  }
  nloc = mine > 0u ? mine : 1u; nx = cnt > 0u ? cnt : 1u;
}
DI void xcd_barrier(const XcdBarrier& b) {
  asm volatile("s_waitcnt vmcnt(0)" ::: "memory");
  __syncthreads();
  if (threadIdx.x == 0) {
    unsigned* bar = b.bar;
    __builtin_amdgcn_s_waitcnt(0);
    unsigned nloc = b.st[0], nx = b.st[1];
    if (nloc == 0u) { xcd_barrier_complete(bar, b.x, nloc, nx); b.st[0] = nloc; b.st[1] = nx; }
    const unsigned old = xb_add(&bar[XB_XSUB(b.x)], 1u);
    const unsigned gen = old / nloc;
    if (old + 1u == (gen + 1u) * nloc) {
      __builtin_amdgcn_fence(__ATOMIC_RELEASE, "agent");
      asm volatile("s_waitcnt vmcnt(0)" ::: "memory");
      const unsigned og = xb_add(&bar[XB_TOP], 1u);
      const unsigned tg = og / nx;
      if (og + 1u == (tg + 1u) * nx) xb_add(&bar[XB_TOPGEN], 1u);
      else XB_SPIN(xb_ld(&bar[XB_TOPGEN]) == tg, bar);
      __builtin_amdgcn_fence(__ATOMIC_ACQUIRE, "agent");
      xb_add(&bar[XB_XGEN(b.x)], 1u);
      asm volatile("s_waitcnt vmcnt(0)" ::: "memory");
    } else {
      XB_SPIN(xb_ld(&bar[XB_XGEN(b.x)]) == gen, bar);
      __builtin_amdgcn_fence(__ATOMIC_ACQUIRE, "agent");
      asm volatile("s_waitcnt vmcnt(0)" ::: "memory");
    }
  }
  __syncthreads();
}

DI float gelu_tanh(float x) {
  const float y = 0.7978845608028654f * (x + 0.044715f * x * x * x);
  const float t = 1.f - 2.f / (1.f + __expf(2.f * y));
  return 0.5f * x * (1.f + t);
}
DI float log_sigmoid(float x) { return fminf(x, 0.f) - LN2 * lg2(1.f + ex2(-fabsf(x) * LOG2E)); }
DI float wave_sum(float v) {
#pragma unroll
  for (int o = 32; o > 0; o >>= 1) v += __shfl_xor(v, o);
  return v;
}

DI int win_map(int np) { return np < 1152 ? np : (np < 2304 ? np + 518 : (np < 2816 ? np - 1146 : (np < 2822 ? np - 1664 : -1))); }

__device__ void prep_transpose(const float* __restrict__ src, int srcN, int K, int k0, int n0, bfraw* __restrict__ dst, bool winmap, float* lds) {
  const int tid = fresh_tid(), nn = tid & 63, kr = tid >> 6;
  const int np = n0 + nn;
  const int n = winmap ? win_map(np) : np;
#pragma unroll
  for (int it = 0; it < 16; ++it) {
    const int kk = it * 4 + kr;
    const float v = (n >= 0) ? src[(size_t)(k0 + kk) * srcN + n] : 0.f;
    lds[kk * 65 + nn] = v;
  }
  __syncthreads();
#pragma unroll
  for (int j = 0; j < 2; ++j) {
    const int c = tid + 256 * j, n2 = c >> 3, kc = c & 7;
    const float* s = lds + (kc * 8) * 65 + n2;
    uint4 o;
    o.x = pack2(s[0], s[65]); o.y = pack2(s[130], s[195]); o.z = pack2(s[260], s[325]); o.w = pack2(s[390], s[455]);
    *(uint4*)(dst + (size_t)(n0 + n2) * K + k0 + kc * 8) = o;
  }
  __syncthreads();
}

__device__ void phase_prep(const Params& p, unsigned char* lds) {
  bfraw* WinT = (bfraw*)(p.ws + WS_WIN); bfraw* WoutT = (bfraw*)(p.ws + WS_WOUT);
  bfraw* WupT = (bfraw*)(p.ws + WS_WUP); bfraw* WdnT = (bfraw*)(p.ws + WS_WDN);
  bfraw* XB = (bfraw*)(p.ws + WS_XB);
  constexpr int PER_L = 768 + 256 + 1024 + 1024, NW = DEPTH * PER_L, NX = TT / 16;
  for (int it0 = blockIdx.x * 2; it0 < NW + NX; it0 += vgrid()) {
    const int it = min(it0 + half_id(), NW + NX - 1);
    if (it < NW) {
      const int l = it / PER_L; int r = it % PER_L;
      if (r < 768) prep_transpose(p.w_in + (size_t)l * D * DIN, DIN, D, (r & 15) * 64, (r >> 4) * 64, WinT + (size_t)l * NIN * D, true, (float*)lds);
      else if (r < 1024) { r -= 768; prep_transpose(p.w_out + (size_t)l * D * D, D, D, (r & 15) * 64, (r >> 4) * 64, WoutT + (size_t)l * D * D, false, (float*)lds); }
      else if (r < 2048) { r -= 1024; prep_transpose(p.w_up + (size_t)l * D * DFF, DFF, D, (r & 15) * 64, (r >> 4) * 64, WupT + (size_t)l * DFF * D, false, (float*)lds); }
      else { r -= 2048; prep_transpose(p.w_down + (size_t)l * DFF * D, D, DFF, (r & 63) * 64, (r >> 6) * 64, WdnT + (size_t)l * D * DFF, false, (float*)lds); }
    } else {
      const int tid0 = fresh_tid();
      const int row0 = (it - NW) * 16;
      const float* src = row0 < TP ? p.x_prompt + (size_t)row0 * D : p.x_sample + (size_t)(row0 - TP) * D;
      bfraw* dst = XB + (size_t)row0 * D;
#pragma unroll 4
      for (int i = 0; i < 16; ++i) {
        const int idx = (tid0 + 256 * i) * 4;
        const float4 v = *(const float4*)(src + idx);
        uint2 o; o.x = pack2(v.x, v.y); o.y = pack2(v.z, v.w);
        *(uint2*)(dst + idx) = o;
      }
    }
  }
}

enum { EPI_INPROJ = 0, EPI_RESID = 1, EPI_UP = 2, EPI_RESID_IN = 3 };

template <int EPI, int MI, int NI>
DI void gemm_epilogue(const Params& p, int layer, f32x16 (&acc)[MI][NI], int m0, int rbase, int nc0, int r32, int h, bool from_input) {
  if (EPI == EPI_INPROJ) {
    bfraw* QKV = (bfraw*)(p.ws + WS_QKV);
    if (nc0 < QKVW) {
      const int which = nc0 / 384;
      const float scale = (which == 0 || which == 3) ? 0.125f : 1.f;
      const int colin = nc0 - which * 384;
      const size_t offp = which == 1 ? O_PFK : which == 2 ? O_PFV : which == 4 ? O_PSK : O_PSV;
      const size_t offs = which == 1 ? O_SFK : which == 2 ? O_SFV : which == 4 ? O_SSK : O_SSV;
      const bool has_out = (which == 1 || which == 2 || which == 4 || which == 5);
      float* outP = p.out + offp + (size_t)layer * TP * 384 + colin + r32;
      float* outS = p.out + offs + ((size_t)layer * TS * 384 - (size_t)TP * 384) + colin + r32;
#pragma unroll
      for (int mi = 0; mi < MI; ++mi)
#pragma unroll
        for (int ni = 0; ni < NI; ++ni)
#pragma unroll
          for (int i = 0; i < 16; ++i) {
            const int row = m0 + rbase + mi * 32 + (i & 3) + 8 * (i >> 2) + 4 * h;
            const float v = acc[mi][ni][i];
            QKV[(size_t)row * QKVW + nc0 + ni * 32 + r32] = (bfraw)(pack2(v * scale, 0.f) & 0xffffu);
            if (has_out) { float* ob = row < TP ? outP : outS; ob[(size_t)row * 384 + ni * 32] = v; }
          }
    } else if (nc0 < 2560) {
      bfraw* U = (bfraw*)(p.ws + WS_U);
#pragma unroll
      for (int mi = 0; mi < MI; ++mi)
#pragma unroll
        for (int ni = 0; ni < NI; ++ni)
#pragma unroll
          for (int i = 0; i < 16; ++i) {
            const int rl = rbase + mi * 32 + (i & 3) + 8 * (i >> 2) + 4 * h;
            const int col = ni * 32 + r32;
            U[(size_t)(m0 + rl) * 256 + (nc0 - 2304) + col] = (bfraw)(pack2(gelu_tanh(acc[mi][ni][i]), 0.f) & 0xffffu);
          }
    } else if (nc0 < 2816) {
      float* VG = (float*)(p.ws + WS_VG);
#pragma unroll
      for (int mi = 0; mi < MI; ++mi)
#pragma unroll
        for (int ni = 0; ni < NI; ++ni)
#pragma unroll
          for (int i = 0; i < 16; ++i) {
            const int rl = rbase + mi * 32 + (i & 3) + 8 * (i >> 2) + 4 * h;
            const int col = ni * 32 + r32;
            VG[(size_t)(m0 + rl) * 256 + (nc0 - 2560) + col] = gelu_tanh(acc[mi][ni][i]);
          }
    } else if (nc0 == 2816) {
      if (r32 < 6) {
        float* LOGF = (float*)(p.ws + WS_LOGF);
        float* outP = p.out + O_PFL + (size_t)layer * TP * 6 + r32;
        float* outS = p.out + O_SFL + ((size_t)layer * TS * 6 - (size_t)TP * 6) + r32;
        const float bias = p.b_f[layer * 6 + r32];
#pragma unroll
        for (int mi = 0; mi < MI; ++mi)
#pragma unroll
          for (int i = 0; i < 16; ++i) {
            const int row = m0 + rbase + mi * 32 + (i & 3) + 8 * (i >> 2) + 4 * h;
            const float lf = log_sigmoid(acc[mi][0][i] + bias);
            LOGF[(size_t)row * 8 + r32] = lf;
            float* ob = row < TP ? outP : outS;
            ob[(size_t)row * 6] = lf;
          }
      }
    }
  } else if (EPI == EPI_RESID_IN) {
    unsigned char* Yb = p.ws + WS_Y;
    const float* xp = p.x_prompt + nc0 + r32;
    const float* xs = p.x_sample - (size_t)TP * D + nc0 + r32;
    const unsigned o0 = (unsigned)(((m0 + rbase + 4 * h) * D + nc0 + r32) * 4);
#pragma unroll
    for (int mi = 0; mi < MI; ++mi) {
      float xr[NI][16];
#pragma unroll
      for (int ni = 0; ni < NI; ++ni)
#pragma unroll
        for (int i = 0; i < 16; ++i) {
          const int row = m0 + rbase + 4 * h + mi * 32 + (i & 3) + 8 * (i >> 2);
          xr[ni][i] = (row < TP ? xp : xs)[(size_t)row * D + ni * 32];
        }
#pragma unroll
      for (int ni = 0; ni < NI; ++ni)
#pragma unroll
        for (int i = 0; i < 16; ++i)
          *(float*)(Yb + (o0 + (unsigned)(((mi * 32 + (i & 3) + 8 * (i >> 2)) * D + ni * 32) * 4))) = ALPHA * xr[ni][i] + acc[mi][ni][i];
    }
  } else if (EPI == EPI_RESID) {
    unsigned char* Yb = p.ws + WS_Y;
    const unsigned char* Xb = p.ws + WS_X32;
    const unsigned o0 = (unsigned)(((m0 + rbase + 4 * h) * D + nc0 + r32) * 4);
#pragma unroll
    for (int mi = 0; mi < MI; ++mi) {
      float xr[NI][16];
#pragma unroll
      for (int ni = 0; ni < NI; ++ni)
#pragma unroll
        for (int i = 0; i < 16; ++i)
          xr[ni][i] = *(const float*)(Xb + (o0 + (unsigned)(((mi * 32 + (i & 3) + 8 * (i >> 2)) * D + ni * 32) * 4)));
#pragma unroll
      for (int ni = 0; ni < NI; ++ni)
#pragma unroll
        for (int i = 0; i < 16; ++i)
          *(float*)(Yb + (o0 + (unsigned)(((mi * 32 + (i & 3) + 8 * (i >> 2)) * D + ni * 32) * 4))) = ALPHA * xr[ni][i] + acc[mi][ni][i];
    }
  } else {
    bfraw* H = (bfraw*)(p.ws + WS_H);
#pragma unroll
    for (int mi = 0; mi < MI; ++mi)
#pragma unroll
      for (int ni = 0; ni < NI; ++ni)
#pragma unroll
        for (int i = 0; i < 16; ++i) {
          const int rl = rbase + mi * 32 + (i & 3) + 8 * (i >> 2) + 4 * h;
          const int col = nc0 + ni * 32 + r32;
          const float v = fmaxf(acc[mi][ni][i], 0.f);
          H[(size_t)(m0 + rl) * DFF + col] = (bfraw)(pack2(v * v, 0.f) & 0xffffu);
        }
  }
}

template <int EPI, int MI, int NI>
__device__ void gemm_tile8(const Params& p, int layer, const bfraw* __restrict__ A, const bfraw* __restrict__ Bt, int K, int m0, int n0, unsigned char* ring, bool from_input,
                           bool first, bool has_next, int next_m0, int next_n0) {
  constexpr int WGM = NI == 2 ? 2 : 1, WGN = 8 / WGM;
  constexpr int BM = WGM * MI * 32;
  constexpr int STAGE = (BM + 256) * 128;
  constexpr int NAI = BM / 8;
  constexpr int NA = (NAI + 7) / 8;
  int tid = threadIdx.x; asm volatile("" : "+v"(tid));
  const int lane = tid & 63, wid = tid >> 6, wm = wid / WGN, wn = wid % WGN;
  const int r32 = lane & 31, h = lane >> 5;
  f32x16 acc[MI][NI];
#pragma unroll
  for (int a = 0; a < MI; ++a)
#pragma unroll
    for (int b = 0; b < NI; ++b)
#pragma unroll
      for (int i = 0; i < 16; ++i) acc[a][b][i] = 0.f;
  const int dc = (lane & 7) ^ (((wid & 1) * 4 + (lane >> 4)) & 7);
  const unsigned loff = (unsigned)(((wid * 8 + (lane >> 3)) * K + dc * 8) * 2);
  const unsigned char* ab = (const unsigned char*)(A + (size_t)m0 * K);
  const unsigned char* bb = (const unsigned char*)(Bt + (size_t)n0 * K);
  unsigned char* dl = ring + wid * 1024 + lane * 16;
#define ISSUE8A(ab, kt_, st_) do { \
    _Pragma("unroll") for (int j = 0; j < NA; ++j) { \
      if (NAI % 8 == 0 || j < NA - 1 || wid < NAI % 8) \
        __builtin_amdgcn_global_load_lds((const unsigned*)(ab + ((size_t)j * 64 * K + (kt_) * 64) * 2 + loff), (unsigned*)(dl + (st_) * STAGE + j * 8192), 16, 0, 0); } \
  } while (0)
#define ISSUE8B(bb, kt_, st_) do { \
    _Pragma("unroll") for (int j = 0; j < 4; ++j) \
      __builtin_amdgcn_global_load_lds((const unsigned*)(bb + ((size_t)j * 64 * K + (kt_) * 64) * 2 + loff), (unsigned*)(dl + (st_) * STAGE + BM * 128 + j * 8192), 16, 0, 0); \
  } while (0)
#define ISSUE8(ab, bb, kt_, st_) do { ISSUE8A(ab, kt_, st_); ISSUE8B(bb, kt_, st_); } while (0)
  const int key = (r32 >> 1) & 7;
  const unsigned char* afr = ring + (wm * (MI * 32) + r32) * 128;
  const unsigned char* bfr = ring + BM * 128 + (wn * (NI * 32) + r32) * 128;
  const int nk = K >> 6;
  const unsigned char* abn = (const unsigned char*)(A + (size_t)next_m0 * K);
  const unsigned char* bbn = (const unsigned char*)(Bt + (size_t)next_n0 * K);
  if (first) {
    asm volatile("s_waitcnt vmcnt(0)" ::: "memory");
    __builtin_amdgcn_s_barrier();
    asm volatile("" ::: "memory");
    ISSUE8(ab, bb, 0, 0);
  }
  int st = 0;
  for (int kt = 0; kt < nk; ++kt) {
    asm volatile("s_waitcnt vmcnt(0)" ::: "memory");
    __builtin_amdgcn_s_barrier();
    asm volatile("" ::: "memory");
    if (kt + 1 < nk) ISSUE8A(ab, kt + 1, st ^ 1);
    else if (has_next) ISSUE8A(abn, 0, st ^ 1);
    const unsigned char* as = afr + st * STAGE;
    const unsigned char* bs = bfr + st * STAGE;
#pragma unroll
    for (int ks = 0; ks < 4; ++ks) {
      if (ks == 2) { if (kt + 1 < nk) ISSUE8B(bb, kt + 1, st ^ 1); else if (has_next) ISSUE8B(bbn, 0, st ^ 1); }
      const int o = ((ks * 2 + h) ^ key) * 16;
      bf16x8 af[MI], bq[NI];
#pragma unroll
      for (int mi = 0; mi < MI; ++mi) af[mi] = *(const bf16x8*)(as + mi * 4096 + o);
#pragma unroll
      for (int ni = 0; ni < NI; ++ni) bq[ni] = *(const bf16x8*)(bs + ni * 4096 + o);
#pragma unroll
      for (int mi = 0; mi < MI; ++mi)
#pragma unroll
        for (int ni = 0; ni < NI; ++ni)
          acc[mi][ni] = __builtin_amdgcn_mfma_f32_32x32x16_bf16(af[mi], bq[ni], acc[mi][ni], 0, 0, 0);
    }
    st ^= 1;
  }
#undef ISSUE8
#undef ISSUE8A
#undef ISSUE8B
  gemm_epilogue<EPI, MI, NI>(p, layer, acc, m0, wm * (MI * 32), n0 + wn * (NI * 32), r32, h, from_input);
}

template <int EPI, int MI, int NI>
__device__ void phase_gemm8(const Params& p, int layer, const bfraw* A, const bfraw* Bt, int N, int K, unsigned char* ring, bool from_input = false) {
  constexpr int BM = (NI == 2 ? 2 : 1) * MI * 32;
  const int ntn = N / 256, ntiles = (TT / BM) * ntn;
  for (int t = blockIdx.x; t < ntiles; t += gridDim.x) {
    const int tm = t / ntn, tn = t % ntn;
    const int t2 = t + gridDim.x;
    const bool has_next = t2 < ntiles;
    const int tm2 = has_next ? t2 / ntn : tm, tn2 = has_next ? t2 % ntn : tn;
    gemm_tile8<EPI, MI, NI>(p, layer, A, Bt, K, tm * BM, tn * 256, ring, from_input, t == (int)blockIdx.x, has_next, tm2 * BM, tn2 * 256);
  }
  __syncthreads();
}

__device__ void phase_ln(const Params& p, const float* __restrict__ gam, const float* __restrict__ bet, bool last) {
  const float* Y = (const float*)(p.ws + WS_Y);
  float* X32 = (float*)(p.ws + WS_X32);
  bfraw* XB = (bfraw*)(p.ws + WS_XB);
  const int tid_ = fresh_tid(); const int lane = tid_ & 63, wid = tid_ >> 6;
  for (int row = vblock() * 4 + wid; row < TT; row += vgrid() * 4) {
    const float* y = Y + (size_t)row * D;
    float4 v[4];
#pragma unroll
    for (int j = 0; j < 4; ++j) v[j] = *(const float4*)(y + lane * 4 + 256 * j);
    float s = 0.f;
#pragma unroll
    for (int j = 0; j < 4; ++j) s += v[j].x + v[j].y + v[j].z + v[j].w;
    const float mu = wave_sum(s) * (1.f / D);
    float q = 0.f;
#pragma unroll
    for (int j = 0; j < 4; ++j) { v[j].x -= mu; v[j].y -= mu; v[j].z -= mu; v[j].w -= mu; q += v[j].x * v[j].x + v[j].y * v[j].y + v[j].z * v[j].z + v[j].w * v[j].w; }
    const float rstd = rsqrtf(wave_sum(q) * (1.f / D) + 1e-5f);
#pragma unroll
    for (int j = 0; j < 4; ++j) {
      const int c = lane * 4 + 256 * j;
      const float4 g = *(const float4*)(gam + c), b = *(const float4*)(bet + c);
      float4 o;
      o.x = v[j].x * rstd * g.x + b.x; o.y = v[j].y * rstd * g.y + b.y; o.z = v[j].z * rstd * g.z + b.z; o.w = v[j].w * rstd * g.w + b.w;
      if (last) {
        *(float4*)(p.out + (size_t)row * D + c) = o;
      } else {
        *(float4*)(X32 + (size_t)row * D + c) = o;
        uint2 ob; ob.x = pack2(o.x, o.y); ob.y = pack2(o.z, o.w);
        *(uint2*)(XB + (size_t)row * D + c) = ob;
      }
    }
  }
}

DI float wave_incl_scan(float v, int lane) {
#pragma unroll
  for (int o = 1; o < 64; o <<= 1) { const float t = __shfl_up(v, o); if (lane >= o) v += t; }
  return v;
}
__device__ void phase_scan(const Params& p, int layer, unsigned char* lds) {
  const float* LOGF = (const float*)(p.ws + WS_LOGF);
  float* C = (float*)(p.ws + WS_C);
  float* CC = (float*)(p.ws + WS_CC);
  float* red = (float*)lds;
  const int tid = fresh_tid(), lane = tid & 63, wid = tid >> 6;
  {
    const bfraw* QKV = (const bfraw*)(p.ws + WS_QKV);
    unsigned* kmx = (unsigned*)(p.ws + WS_CTL) + KMAX_WORD + 64 * layer;
    for (int it = vblock(); it < 24 * 16; it += vgrid()) {
      const int bh = it >> 4, b = bh / 6, h = bh % 6, pos = (it & 15) * 256 + tid;
      const uint4* kp = (const uint4*)(QKV + (size_t)(b * SEQ + pos) * QKVW + 384 + h * 64);
      float ss = 0.f;
#pragma unroll
      for (int i = 0; i < 8; ++i) {
        const uint4 u = kp[i];
        const unsigned w[4] = {u.x, u.y, u.z, u.w};
#pragma unroll
        for (int k = 0; k < 4; ++k) { const float a = __uint_as_float(w[k] << 16), c = __uint_as_float(w[k] & 0xffff0000u); ss += a * a + c * c; }
      }
#pragma unroll
      for (int o = 32; o > 0; o >>= 1) ss = fmaxf(ss, __shfl_xor(ss, o));
      if (lane == 0) atomicMax(&kmx[bh], __float_as_uint(ss));
    }
  }
  for (int seq0 = blockIdx.x * 2; seq0 < 24 + 192; seq0 += vgrid()) {
    const int seq = min(seq0 + half_id(), 24 + 192 - 1);
    const bool pr = seq < 24;
    const int s = pr ? seq : seq - 24, b = s / 6, h = s % 6;
    float v[16];
    if (pr) {
      const float* base = LOGF + ((size_t)b * SEQ + tid * 16) * 8 + h;
#pragma unroll
      for (int i = 0; i < 16; ++i) v[i] = base[i * 8];
    } else {
      const float* base = p.cfl + (((size_t)layer * DECB + b) * PAST + tid * 8) * 6 + h;
#pragma unroll
      for (int i = 0; i < 8; ++i) v[i] = base[i * 6];
#pragma unroll
      for (int i = 8; i < 16; ++i) v[i] = 0.f;
    }
#pragma unroll
    for (int i = 1; i < 16; ++i) v[i] += v[i - 1];
    const float tot = v[15];
    const float inc = wave_incl_scan(tot, lane);
    if (lane == 63) red[wid] = inc;
    __syncthreads();
    const float r0 = red[0], r1 = red[1], r2 = red[2], r3 = red[3];
    float off = inc - tot;
    off += (wid > 0 ? r0 : 0.f) + (wid > 1 ? r1 : 0.f) + (wid > 2 ? r2 : 0.f);
    if (pr) {
      float* dst = C + ((size_t)b * SEQ + tid * 16) * 8 + h;
#pragma unroll
      for (int i = 0; i < 16; ++i) dst[i * 8] = off + v[i];
    } else {
      float* dst = CC + ((size_t)b * PAST + tid * 8) * 8 + h;
#pragma unroll
      for (int i = 0; i < 8; ++i) dst[i * 8] = off + v[i];
      if (wid == 0) {
        const size_t idx = ((size_t)TP + b * DECS + lane) * 8 + h;
        C[idx] = ((r0 + r1) + (r2 + r3)) + wave_incl_scan(LOGF[idx], lane);
      }
    }
    __syncthreads();
  }
}

__device__ void attn_item(const Params& p, int layer, int type, bool sample, int b, int h, int qb, unsigned char* lds, volatile LAS int* flg) {
  const bfraw* QKV = (const bfraw*)(p.ws + WS_QKV);
  const float* C = (const float*)(p.ws + WS_C);
  const float* CC = (const float*)(p.ws + WS_CC);
  bfraw* O = (bfraw*)(p.ws + WS_O);
  const int tid = fresh_tid(), lane = tid & 63, wid = tid >> 6, l15 = lane & 15, g = lane >> 4;
  const int qrow0 = sample ? TP + b * DECS : b * SEQ + qb * 64;
  const int ntiles = sample ? 33 : qb + 1;
  const int qoff = type ? 1152 : 0, koff = qoff + 384, voff = qoff + 768, hc = h * 64;
  const int qrow = qrow0 + wid * 16 + l15;
  const bfraw* qp = QKV + (size_t)qrow * QKVW + qoff + hc + g * 8;
  const bf16x8 q0 = *(const bf16x8*)qp, q1 = *(const bf16x8*)(qp + 32);
  float cq2 = 0.f;
  if (type == 0) cq2 = C[(size_t)qrow * 8 + h] * LOG2E;
  const bool fexit = (type == 0) && !sample;
  float bqk = 0.f, cnext = 0.f;
  if (fexit) {
    float qs = 0.f;
#pragma unroll
    for (int i = 0; i < 8; ++i) { const float a = bf2f((bfraw)q0[i]), c = bf2f((bfraw)q1[i]); qs += a * a + c * c; }
    qs += __shfl_xor(qs, 16); qs += __shfl_xor(qs, 32);
    const float kmax2 = __uint_as_float(((const unsigned*)(p.ws + WS_CTL))[KMAX_WORD + 64 * layer + b * 6 + h]);
    bqk = sqrtf(qs * kmax2) * (LOG2E * 1.01f) + 1.f;
  }
  const float* kcache = type ? p.csk : p.cfk;
  const float* vcache = type ? p.csv : p.cfv;

  float4 st[8]; float stc = 0.f;
  const int key_l = tid >> 3, dc = tid & 7;
  unsigned char* kd = lds + key_l * 144 + dc * 16;
  unsigned char* vd = kd + 9216;
  float* ckl = (float*)(lds + 18432);

#define ATTN_PREFETCH(t_)                                                                                         \
  do {                                                                                                            \
    const int tt_ = (t_);                                                                                         \
    if (!(sample && tt_ < 32)) {                                                                                  \
      const int krow = sample ? TP + b * DECS : b * SEQ + tt_ * 64;                                               \
      const bfraw* kp = QKV + (size_t)(krow + key_l) * QKVW + hc + dc * 8;                                        \
      st[0] = *(const float4*)(kp + koff); st[1] = *(const float4*)(kp + koff + 32 * QKVW);                       \
      st[2] = *(const float4*)(kp + voff); st[3] = *(const float4*)(kp + voff + 32 * QKVW);                       \
      if (type == 0 && tid < 64) stc = C[(size_t)(krow + tid) * 8 + h];                                           \
    } else {                                                                                                      \
      const size_t off = ((((size_t)layer * DECB + b) * PAST + tt_ * 64 + key_l) * 6 + h) * 64 + dc * 8;          \
      const float* kc = kcache + off; const float* vc = vcache + off;                                             \
      st[0] = *(const float4*)kc; st[1] = *(const float4*)(kc + 4);                                               \
      st[2] = *(const float4*)(kc + 32 * 384); st[3] = *(const float4*)(kc + 32 * 384 + 4);                       \
      st[4] = *(const float4*)vc; st[5] = *(const float4*)(vc + 4);                                               \
      st[6] = *(const float4*)(vc + 32 * 384); st[7] = *(const float4*)(vc + 32 * 384 + 4);                       \
      if (type == 0 && tid < 64) stc = CC[((size_t)b * PAST + tt_ * 64 + tid) * 8 + h];                           \
    }                                                                                                             \
  } while (0)

  f32x4 oacc[4];
#pragma unroll
  for (int i = 0; i < 4; ++i) oacc[i] = (f32x4){0.f, 0.f, 0.f, 0.f};
  float m = -1e30f, lsum = 0.f, R = 0.f;
  const int ql = wid * 16 + l15;
  const int i16 = l15, qq = i16 >> 2, pp = i16 & 3;
  const unsigned char* vtr = lds + 9216 + (4 * g + qq) * 144 + pp * 8;

  ATTN_PREFETCH(ntiles - 1);
  for (int t = ntiles - 1; t >= 0; --t) {
    if (!(sample && t < 32)) {
      *(float4*)kd = st[0]; *(float4*)(kd + 32 * 144) = st[1]; *(float4*)vd = st[2]; *(float4*)(vd + 32 * 144) = st[3];
    } else {
      uint4 a;
      a.x = pack2(st[0].x, st[0].y); a.y = pack2(st[0].z, st[0].w); a.z = pack2(st[1].x, st[1].y); a.w = pack2(st[1].z, st[1].w); *(uint4*)kd = a;
      a.x = pack2(st[2].x, st[2].y); a.y = pack2(st[2].z, st[2].w); a.z = pack2(st[3].x, st[3].y); a.w = pack2(st[3].z, st[3].w); *(uint4*)(kd + 32 * 144) = a;
      a.x = pack2(st[4].x, st[4].y); a.y = pack2(st[4].z, st[4].w); a.z = pack2(st[5].x, st[5].y); a.w = pack2(st[5].z, st[5].w); *(uint4*)vd = a;
      a.x = pack2(st[6].x, st[6].y); a.y = pack2(st[6].z, st[6].w); a.z = pack2(st[7].x, st[7].y); a.w = pack2(st[7].z, st[7].w); *(uint4*)(vd + 32 * 144) = a;
    }
    if (type == 0 && tid < 64) ckl[tid] = stc * LOG2E;
    __syncthreads();
    if (t > 0) ATTN_PREFETCH(t - 1);
    if (fexit && t > 0) cnext = C[(size_t)(b * SEQ + (t - 1) * 64 + 63) * 8 + h];
    const bool diag = (t == ntiles - 1);

    f32x4 s[4];
#pragma unroll
    for (int kb = 0; kb < 4; ++kb) {
      const unsigned char* ka = lds + (kb * 16 + l15) * 144 + g * 16;
      const bf16x8 a0 = *(const bf16x8*)ka, a1 = *(const bf16x8*)(ka + 64);
      f32x4 z = (f32x4){0.f, 0.f, 0.f, 0.f};
      z = __builtin_amdgcn_mfma_f32_16x16x32_bf16(a0, q0, z, 0, 0, 0);
      s[kb] = __builtin_amdgcn_mfma_f32_16x16x32_bf16(a1, q1, z, 0, 0, 0);
    }
    unsigned pk[8];
    if (type == 0) {
      float mx = -1e30f;
#pragma unroll
      for (int kb = 0; kb < 4; ++kb) {
        const f32x4 ck = *(const f32x4*)(ckl + kb * 16 + 4 * g);
#pragma unroll
        for (int j = 0; j < 4; ++j) {
          float x = s[kb][j] * LOG2E + cq2 - ck[j];
          if (diag && (kb * 16 + 4 * g + j > ql)) x = -1e30f;
          s[kb][j] = x; mx = fmaxf(mx, x);
        }
      }
      mx = fmaxf(mx, __shfl_xor(mx, 16)); mx = fmaxf(mx, __shfl_xor(mx, 32));
      const float mnew = fmaxf(m, mx);
      const float alpha = ex2(m - mnew);
      m = mnew;
      float ps = 0.f;
#pragma unroll
      for (int kb = 0; kb < 4; ++kb) {
        const float p0 = ex2(s[kb][0] - mnew), p1 = ex2(s[kb][1] - mnew), p2 = ex2(s[kb][2] - mnew), p3 = ex2(s[kb][3] - mnew);
        ps += (p0 + p1) + (p2 + p3);
        pk[kb * 2] = pack2(p0, p1); pk[kb * 2 + 1] = pack2(p2, p3);
      }
      lsum = lsum * alpha + ps;
#pragma unroll
      for (int db = 0; db < 4; ++db) oacc[db] *= alpha;
    } else {
      float lr[4][4];
#pragma unroll
      for (int kb = 0; kb < 4; ++kb)
#pragma unroll
        for (int j = 0; j < 4; ++j) {
          const float z2 = s[kb][j] * LOG2E;
          const float e = ex2(-fabsf(z2));
          float l = -(fmaxf(z2, 0.f) + lg2(1.f + e));
          if (diag && !(kb * 16 + 4 * g + j < ql)) l = 0.f;
          s[kb][j] = z2; lr[kb][j] = l;
        }
#pragma unroll
      for (int kb = 3; kb >= 0; --kb) {
        const float G = (lr[kb][0] + lr[kb][1]) + (lr[kb][2] + lr[kb][3]);
        const float a = __shfl_xor(G, 16), bb = __shfl_xor(G, 32), c = __shfl_xor(G, 48);
        const float tot = (G + a) + (bb + c);
        const float gt = ((g == 0 || g == 2) ? a : 0.f) + ((g < 2) ? (bb + c) : 0.f);
        const float a3 = R + gt, a2 = a3 + lr[kb][3], a1 = a2 + lr[kb][2], a0 = a1 + lr[kb][1];
        float p0 = ex2(s[kb][0] + lr[kb][0] + a0), p1 = ex2(s[kb][1] + lr[kb][1] + a1);
        float p2 = ex2(s[kb][2] + lr[kb][2] + a2), p3 = ex2(s[kb][3] + lr[kb][3] + a3);
        if (diag) {
          const int k0 = kb * 16 + 4 * g;
          if (!(k0 < ql)) p0 = 0.f;
          if (!(k0 + 1 < ql)) p1 = 0.f;
          if (!(k0 + 2 < ql)) p2 = 0.f;
          if (!(k0 + 3 < ql)) p3 = 0.f;
        }
        pk[kb * 2] = pack2(p0, p1); pk[kb * 2 + 1] = pack2(p2, p3);
        R += tot;
      }
      const int alldone = __all(R < SB_EXIT) ? 1 : 0;
      if (lane == 0) flg[half_id() * 4 + wid] = alldone;
    }
    if (fexit) {
      const int done = (t > 0 && __all(bqk + cq2 - cnext * LOG2E - m < FOX_EXIT)) ? 1 : 0;
      if (lane == 0) flg[half_id() * 4 + wid] = done;
    }
#pragma unroll
    for (int kk = 0; kk < 2; ++kk) {
      const uint4 pu = {pk[kk * 4], pk[kk * 4 + 1], pk[kk * 4 + 2], pk[kk * 4 + 3]};
      const bf16x8 pf = __builtin_bit_cast(bf16x8, pu);
#pragma unroll
      for (int db = 0; db < 4; ++db) {
        const unsigned char* va = vtr + (32 * kk) * 144 + db * 32;
        const s16x4 lo = __builtin_amdgcn_ds_read_tr16_b64_v4i16((LAS s16x4*)(va));
        const s16x4 hi = __builtin_amdgcn_ds_read_tr16_b64_v4i16((LAS s16x4*)(va + 16 * 144));
        const bf16x8 vf = __builtin_shufflevector(lo, hi, 0, 1, 2, 3, 4, 5, 6, 7);
        oacc[db] = __builtin_amdgcn_mfma_f32_16x16x32_bf16(vf, pf, oacc[db], 0, 0, 0);
      }
    }
    __syncthreads();
    if (type == 1 || fexit) { if (flg[0] & flg[1] & flg[2] & flg[3] & flg[4] & flg[5] & flg[6] & flg[7]) break; }
  }
#undef ATTN_PREFETCH
  if (type == 0) {
    lsum += __shfl_xor(lsum, 16); lsum += __shfl_xor(lsum, 32);
    const float inv = 1.f / lsum;
#pragma unroll
    for (int db = 0; db < 4; ++db) oacc[db] *= inv;
  }
  float ss = 0.f;
#pragma unroll
  for (int db = 0; db < 4; ++db)
#pragma unroll
    for (int j = 0; j < 4; ++j) ss += oacc[db][j] * oacc[db][j];
  ss += __shfl_xor(ss, 16); ss += __shfl_xor(ss, 32);
  const float rs = rsqrtf(ss * (1.f / 64.f) + 1e-6f);
  const int hoff = type ? 640 + hc : hc;
#pragma unroll
  for (int db = 0; db < 4; ++db) {
    const int d0 = 16 * db + 4 * g;
    const float4 gm = *(const float4*)(p.g_mix + layer * D + hoff + d0);
    uint2 o;
    o.x = pack2(oacc[db][0] * rs * gm.x, oacc[db][1] * rs * gm.y);
    o.y = pack2(oacc[db][2] * rs * gm.z, oacc[db][3] * rs * gm.w);
    *(uint2*)(O + (size_t)qrow * D + hoff + d0) = o;
  }
}

__device__ void sgu_item(const Params& p, int layer, bool sample, int ci, int g, unsigned char* lds) {
  const float* VG = (const float*)(p.ws + WS_VG);
  const bfraw* U = (const bfraw*)(p.ws + WS_U);
  bfraw* O = (bfraw*)(p.ws + WS_O);
  constexpr int LROW = 272;
  unsigned char* Wl = lds;
  unsigned char* Vt = lds + 128 * LROW;
  const int tid = fresh_tid(), lane = tid & 63, wid = tid >> 6;
  const int r0 = sample ? TP + ci * DECS : ci * 128;
  const int L = sample ? 64 : 128;
  {
    const float4 gv = *(const float4*)(p.g_v + layer * 256 + lane * 4), bv = *(const float4*)(p.b_v + layer * 256 + lane * 4);
    for (int i = wid; i < L; i += 4) {
      float4 v = *(const float4*)(VG + (size_t)(r0 + i) * 256 + lane * 4);
      const float mu = wave_sum(v.x + v.y + v.z + v.w) * (1.f / 256.f);
      v.x -= mu; v.y -= mu; v.z -= mu; v.w -= mu;
      const float rstd = rsqrtf(wave_sum(v.x * v.x + v.y * v.y + v.z * v.z + v.w * v.w) * (1.f / 256.f) + 1e-5f);
      float4 o;
      o.x = v.x * rstd * gv.x + bv.x; o.y = v.y * rstd * gv.y + bv.y; o.z = v.z * rstd * gv.z + bv.z; o.w = v.w * rstd * gv.w + bv.w;
      if ((lane >> 4) == g) {
        const unsigned lo = pack2(o.x, o.y), hi = pack2(o.z, o.w);
        unsigned char* vp = Vt + ((lane & 15) * 4) * LROW + i * 2;
        *(bfraw*)(vp) = (bfraw)(lo & 0xffffu); *(bfraw*)(vp + LROW) = (bfraw)(lo >> 16);
        *(bfraw*)(vp + 2 * LROW) = (bfraw)(hi & 0xffffu); *(bfraw*)(vp + 3 * LROW) = (bfraw)(hi >> 16);
        if (sample) *(float4*)(p.out + O_SGV + ((size_t)layer * TS + (r0 - TP) + i) * 256 + lane * 4) = o;
      }
    }
    const float* wg = p.w_s + ((size_t)layer * 4 + g) * 128 * 128;
#pragma unroll 4
    for (int k = 0; k < 16; ++k) {
      const int idx = tid + 256 * k, row = idx >> 5, c4 = (idx & 31) * 4;
      if (row < L) {
        const float4 w = *(const float4*)(wg + row * 128 + c4);
        uint2 o;
        o.x = pack2(c4 <= row ? w.x : 0.f, c4 + 1 <= row ? w.y : 0.f);
        o.y = pack2(c4 + 2 <= row ? w.z : 0.f, c4 + 3 <= row ? w.w : 0.f);
        *(uint2*)(Wl + row * LROW + c4 * 2) = o;
      }
    }
  }
  __syncthreads();
  if (wid * 32 < L) {
    const int r32 = lane & 31, h = lane >> 5;
    f32x16 acc[2];
#pragma unroll
    for (int ni = 0; ni < 2; ++ni)
#pragma unroll
      for (int i = 0; i < 16; ++i) acc[ni][i] = 0.f;
    const unsigned char* ap = Wl + (wid * 32 + r32) * LROW + h * 16;
    const unsigned char* bp = Vt + r32 * LROW + h * 16;
    const int nks = min(L / 16, 2 * (wid + 1));
    for (int ks = 0; ks < nks; ++ks) {
      const bf16x8 a = *(const bf16x8*)(ap + ks * 32);
      const bf16x8 b0 = *(const bf16x8*)(bp + ks * 32), b1 = *(const bf16x8*)(bp + 32 * LROW + ks * 32);
      acc[0] = __builtin_amdgcn_mfma_f32_32x32x16_bf16(a, b0, acc[0], 0, 0, 0);
      acc[1] = __builtin_amdgcn_mfma_f32_32x32x16_bf16(a, b1, acc[1], 0, 0, 0);
    }
    const float* bsp = p.b_s + ((size_t)layer * 4 + g) * 128 + wid * 32 + 4 * h;
    const float* gm = p.g_mix + layer * D + 384 + g * 64 + r32;
    const float gm0 = gm[0], gm1 = gm[32];
    const size_t rowb = (size_t)(r0 + wid * 32 + 4 * h);
#pragma unroll
    for (int i = 0; i < 16; ++i) {
      const int rl = (i & 3) + 8 * (i >> 2);
      const float bs = bsp[rl];
      const bfraw* up = U + (rowb + rl) * 256 + g * 64 + r32;
      const float o0 = bf2f(up[0]) * (acc[0][i] + bs), o1 = bf2f(up[32]) * (acc[1][i] + bs);
      float ss = o0 * o0 + o1 * o1;
      ss += __shfl_xor(ss, 1); ss += __shfl_xor(ss, 2); ss += __shfl_xor(ss, 4); ss += __shfl_xor(ss, 8); ss += __shfl_xor(ss, 16);
      const float rs = rsqrtf(ss * (1.f / 64.f) + 1e-6f);
      bfraw* op = O + (rowb + rl) * D + 384 + g * 64 + r32;
      op[0] = (bfraw)(pack2(o0 * rs * gm0, 0.f) & 0xffffu);
      op[32] = (bfraw)(pack2(o1 * rs * gm1, 0.f) & 0xffffu);
    }
  }
  __syncthreads();
}

__device__ void phase_mix(const Params& p, int layer, unsigned char* lds, volatile LAS int* slot) {
  unsigned* ctr = (unsigned*)(p.ws + WS_CTL) + QCTR_WORD + 64 * layer;
  volatile LAS int* flg = slot + 4;
  constexpr int N_SAMPLE = 384, N_PROMPT = 3072, N_SGU = 640, N_ALL = N_SAMPLE + N_PROMPT + N_SGU;
  for (;;) {
    if (threadIdx.x == 0) *slot = (int)atomicAdd(ctr, 1u);
    __syncthreads();
    const int item = *slot * 2 + half_id();
    __syncthreads();
    if (item >= N_ALL) break;
    if (item < N_SAMPLE) {
      const int type = item < 192 ? 1 : 0, r = item % 192;
      attn_item(p, layer, type, true, r / 6, r % 6, 0, lds, flg);
    } else if (item < N_SAMPLE + N_PROMPT) {
      const int r = item - N_SAMPLE, qb = 63 - r / 48, rr = r % 48, type = rr < 24 ? 1 : 0, bh = rr % 24;
      attn_item(p, layer, type, false, bh / 6, bh % 6, qb, lds, flg);
    } else {
      int r = item - N_SAMPLE - N_PROMPT;
      if (r < 512) sgu_item(p, layer, false, r >> 2, r & 3, lds);
      else { r -= 512; sgu_item(p, layer, true, r >> 2, r & 3, lds); }
    }
  }
}

__device__ void run_phase(const Params& p, int ph, unsigned char* lds, unsigned char* ring, volatile LAS int* slot) {
  const bfraw* XB = (const bfraw*)(p.ws + WS_XB);
  if (ph == 0) { phase_prep(p, lds); return; }
  const int layer = (ph - 1) >> 3, sub = (ph - 1) & 7;
  switch (sub) {
    case 0: phase_gemm8<EPI_INPROJ, 9, 1>(p, layer, XB, (const bfraw*)(p.ws + WS_WIN) + (size_t)layer * NIN * D, NIN, D, ring); break;
    case 1: phase_scan(p, layer, lds); break;
    case 2: phase_mix(p, layer, lds, slot); break;
    case 3: if (layer == 0) phase_gemm8<EPI_RESID_IN, 9, 1>(p, layer, (const bfraw*)(p.ws + WS_O), (const bfraw*)(p.ws + WS_WOUT) + (size_t)layer * D * D, D, D, ring);
            else phase_gemm8<EPI_RESID, 9, 1>(p, layer, (const bfraw*)(p.ws + WS_O), (const bfraw*)(p.ws + WS_WOUT) + (size_t)layer * D * D, D, D, ring);
            break;
    case 4: phase_ln(p, p.ln1_g + layer * D, p.ln1_b + layer * D, false); break;
    case 5: phase_gemm8<EPI_UP, 9, 1>(p, layer, XB, (const bfraw*)(p.ws + WS_WUP) + (size_t)layer * DFF * D, DFF, D, ring); break;
    case 6: phase_gemm8<EPI_RESID, 9, 1>(p, layer, (const bfraw*)(p.ws + WS_H), (const bfraw*)(p.ws + WS_WDN) + (size_t)layer * D * DFF, D, DFF, ring); break;
    default: phase_ln(p, p.ln2_g + layer * D, p.ln2_b + layer * D, layer == DEPTH - 1); break;
  }
}

__global__ void __launch_bounds__(512, 2) fwd_kernel(Params p) {
  extern __shared__ __attribute__((aligned(16))) unsigned char smem[];
  unsigned char* lds = smem + LDS_DATA + half_id() * HALF_LDS;
  volatile LAS unsigned* st = (volatile LAS unsigned*)smem;
  volatile LAS int* slot = (volatile LAS int*)(smem + 16);
  if (threadIdx.x == 0) { st[0] = 0u; st[1] = 0u; st[2] = 0u; st[3] = 0u; }
  __syncthreads();
  XcdBarrier xb;
  xb.bar = (unsigned*)(p.ws + WS_CTL); xb.x = 0; xb.st = st;
  if (p.coop) xb = xcd_barrier_post((unsigned*)(p.ws + WS_CTL), st);
  for (int ph = p.ph_lo; ph < p.ph_hi; ++ph) {
    if (ph > p.ph_lo) {
      if (p.pad) cg::this_grid().sync();
      xcd_barrier(xb);
    }
    run_phase(p, ph, lds, smem + LDS_DATA, slot);
  }
}

extern "C" void kernel_launch(void* const* d_in, const int* in_sizes, int n_in, void* d_out, int out_size, void* d_ws, size_t ws_size,
                              hipStream_t stream) {
  static int grid = 0;
  if (grid == 0) {
    if (n_in != 21 || (size_t)out_size != O_END || ws_size < WS_END) {
      fprintf(stderr, "kernel_launch: unexpected shapes: n_in %d out %d (want %zu) ws %zu (want >= %zu)\n", n_in, out_size, (size_t)O_END, ws_size, (size_t)WS_END);
      grid = -1; return;
    }
    int dev = 0, cus = 0, per_cu = 0;
    hipGetDevice(&dev);
    hipDeviceGetAttribute(&cus, hipDeviceAttributeMultiprocessorCount, dev);
    if (hipFuncSetAttribute((const void*)fwd_kernel, hipFuncAttributeMaxDynamicSharedMemorySize, LDS_BYTES) != hipSuccess) {
      fprintf(stderr, "kernel_launch: hipFuncSetAttribute failed\n"); grid = -1; return;
    }
    hipOccupancyMaxActiveBlocksPerMultiprocessor(&per_cu, (const void*)fwd_kernel, 512, LDS_BYTES);
    if (per_cu < 1) { fprintf(stderr, "kernel_launch: occupancy query says %d\n", per_cu); per_cu = 1; }
    if (per_cu > 1) per_cu = 1;
    grid = cus * per_cu;
  }
  if (grid < 0) return;
  hipMemsetAsync((char*)d_ws + WS_CTL, 0, CTL_BYTES, stream);
  Params p{};
  const float** f = (const float**)&p;
  for (int i = 0; i < 21; ++i) f[i] = (const float*)d_in[i];
  p.out = (float*)d_out; p.ws = (unsigned char*)d_ws;
#if MK_MODE == 0
  for (int ph = 0; ph < NPHASE; ++ph) {
    p.ph_lo = ph; p.ph_hi = ph + 1; p.coop = 0; p.pad = 0;
    hipLaunchKernelGGL(fwd_kernel, dim3(grid), dim3(512), LDS_BYTES, stream, p);
  }
#else
  p.ph_lo = 0; p.ph_hi = NPHASE; p.coop = 1; p.pad = 0;
  void* args[] = {&p};
  hipError_t e = hipLaunchCooperativeKernel((const void*)fwd_kernel, dim3(grid), dim3(512), args, LDS_BYTES, stream);
  if (e != hipSuccess) fprintf(stderr, "cooperative launch failed: %s (grid %d)\n", hipGetErrorString(e), grid);
#endif
}
```

```cpp
#include <hip/hip_runtime.h>
#include <hip/hip_cooperative_groups.h>
#include <cstdio>
#include <cstdint>
namespace cg = cooperative_groups;

#ifndef MK_MODE
#define MK_MODE 1
#endif

#define DI __device__ __forceinline__
typedef unsigned short bfraw;
typedef __attribute__((ext_vector_type(8))) short bf16x8;
typedef __attribute__((ext_vector_type(4))) short s16x4;
typedef __attribute__((ext_vector_type(4))) float f32x4;
typedef __attribute__((ext_vector_type(16))) float f32x16;
typedef __attribute__((ext_vector_type(2))) __bf16 bf2_t;
typedef __attribute__((ext_vector_type(2))) float f2_t;
#define LAS __attribute__((address_space(3)))

DI unsigned pack2(float a, float b) { f2_t x = {a, b}; bf2_t y = __builtin_convertvector(x, bf2_t); return __builtin_bit_cast(unsigned, y); }
DI float bf2f(bfraw v) { return __uint_as_float(((unsigned)v) << 16); }
DI int fresh_tid() { int t = threadIdx.x & 255; asm volatile("" : "+v"(t)); return t; }
DI int half_id() { return __builtin_amdgcn_readfirstlane((int)(threadIdx.x >> 8)); }
DI int vblock() { return (int)blockIdx.x * 2 + half_id(); }
DI int vgrid() { return (int)gridDim.x * 2; }
DI float ex2(float x) { return __builtin_amdgcn_exp2f(x); }
DI float lg2(float x) { return __builtin_amdgcn_logf(x); }

constexpr int D = 1024, TP = 16384, TS = 2048, TT = TP + TS, SEQ = 4096, DECB = 32, DECS = 64, PAST = 2048;
constexpr int NIN = 3072, DFF = 4096, DEPTH = 2, QKVW = 2304, DIN = 2822;
constexpr float ALPHA = 1.41421356237309515f;
constexpr float LOG2E = 1.44269504088896341f;
constexpr float LN2 = 0.69314718055994531f;
constexpr float SB_EXIT = -160.f;
constexpr float FOX_EXIT = -160.f;
constexpr int KMAX_WORD = 12288;

constexpr size_t O_YP = 0;
constexpr size_t O_YS = O_YP + (size_t)TP * D;
constexpr size_t O_PFK = O_YS + (size_t)TS * D;
constexpr size_t O_PFV = O_PFK + (size_t)DEPTH * TP * 384;
constexpr size_t O_PFL = O_PFV + (size_t)DEPTH * TP * 384;
constexpr size_t O_PSK = O_PFL + (size_t)DEPTH * TP * 6;
constexpr size_t O_PSV = O_PSK + (size_t)DEPTH * TP * 384;
constexpr size_t O_SFK = O_PSV + (size_t)DEPTH * TP * 384;
constexpr size_t O_SFV = O_SFK + (size_t)DEPTH * TS * 384;
constexpr size_t O_SFL = O_SFV + (size_t)DEPTH * TS * 384;
constexpr size_t O_SSK = O_SFL + (size_t)DEPTH * TS * 6;
constexpr size_t O_SSV = O_SSK + (size_t)DEPTH * TS * 384;
constexpr size_t O_SGV = O_SSV + (size_t)DEPTH * TS * 384;
constexpr size_t O_END = O_SGV + (size_t)DEPTH * TS * 256;

constexpr size_t WS_CTL = 0;
constexpr size_t CTL_BYTES = 65536;
constexpr size_t WS_WIN = WS_CTL + CTL_BYTES;
constexpr size_t WS_WOUT = WS_WIN + (size_t)DEPTH * NIN * D * 2;
constexpr size_t WS_WUP = WS_WOUT + (size_t)DEPTH * D * D * 2;
constexpr size_t WS_WDN = WS_WUP + (size_t)DEPTH * DFF * D * 2;
constexpr size_t WS_XB = WS_WDN + (size_t)DEPTH * D * DFF * 2;
constexpr size_t WS_X32 = WS_XB + (size_t)TT * D * 2;
constexpr size_t WS_Y = WS_X32 + (size_t)TT * D * 4;
constexpr size_t WS_QKV = WS_Y + (size_t)TT * D * 4;
constexpr size_t WS_U = WS_QKV + (size_t)TT * QKVW * 2;
constexpr size_t WS_VG = WS_U + (size_t)TT * 256 * 2;
constexpr size_t WS_LOGF = WS_VG + (size_t)TT * 256 * 4;
constexpr size_t WS_C = WS_LOGF + (size_t)TT * 8 * 4;
constexpr size_t WS_CC = WS_C + (size_t)TT * 8 * 4;
constexpr size_t WS_O = WS_CC + (size_t)DECB * PAST * 8 * 4;
constexpr size_t WS_H = WS_O + (size_t)TT * D * 2;
constexpr size_t WS_END = WS_H + (size_t)TT * DFF * 2;

constexpr int LDS_DATA = 64;
constexpr int ABUF = 128 * 144;
constexpr int HALF_LDS = 69632;
constexpr int LDS_BYTES = LDS_DATA + 2 * HALF_LDS;
constexpr int NPHASE = 1 + 8 * DEPTH;
constexpr int QCTR_WORD = 8192;

struct Params {
  const float *x_prompt, *x_sample, *cfk, *cfv, *cfl, *csk, *csv, *w_in, *b_f, *g_v, *b_v, *w_s, *b_s, *g_mix, *w_out,
      *ln1_g, *ln1_b, *w_up, *w_down, *ln2_g, *ln2_b;
  float* out;
  unsigned char* ws;
  int ph_lo, ph_hi, coop, pad;
};

#define XB_TMO      128
#define XB_XCNT(j)  (256  + 64 * (j))
#define XB_XSUB(j)  (1280 + 64 * (j))
#define XB_XGEN(j)  (2304 + 64 * (j))
#define XB_TOP      3328
#define XB_TOPGEN   3392
#define XCD_BAR_WORDS 3456
#define XB_SPIN_CAP (1u << 22)
DI unsigned xb_ld(unsigned* p) { return __hip_atomic_load(p, __ATOMIC_RELAXED, __HIP_MEMORY_SCOPE_AGENT); }
DI unsigned xb_add(unsigned* p, unsigned v) { return __hip_atomic_fetch_add(p, v, __ATOMIC_RELAXED, __HIP_MEMORY_SCOPE_AGENT); }
DI unsigned xb_xcc_id() { return (unsigned)__builtin_amdgcn_s_getreg((3 << 11) | 20) & 0xFu; }
#define XB_SPIN(cond, bar) do { unsigned _sp = 0; while (cond) { __builtin_amdgcn_s_sleep(1); \
    if ((++_sp & 255u) == 0u) { if (xb_ld(&(bar)[XB_TMO])) break; if (_sp > XB_SPIN_CAP) { atomicAdd(&(bar)[XB_TMO], 1u); break; } } } } while (0)
struct XcdBarrier { unsigned* bar; unsigned x; volatile LAS unsigned* st; };
DI XcdBarrier xcd_barrier_post(unsigned* bar, volatile LAS unsigned* st) {
  XcdBarrier b; b.bar = bar; b.x = xb_xcc_id(); b.st = st;
  if (threadIdx.x == 0) (void)xb_add(&bar[XB_XCNT(b.x)], 1u);
  return b;
}
DI void xcd_barrier_complete(unsigned* bar, unsigned x, unsigned& nloc, unsigned& nx) {
  const unsigned G = gridDim.x * gridDim.y * gridDim.z;
  unsigned sum, cnt, mine, sp = 0u;
  for (;;) {
    sum = 0u; cnt = 0u; mine = 0u;
#pragma unroll
    for (unsigned j = 0; j < 16; ++j) { const unsigned c = xb_ld(&bar[XB_XCNT(j)]); sum += c; cnt += (c > 0u) ? 1u : 0u; mine = (j == x) ? c : mine; }
    if (sum == G) break;
    __builtin_amdgcn_s_sleep(1);
    if ((++sp & 255u) == 0u) { if (xb_ld(&bar[XB_TMO])) break; if (sp > XB_SPIN_CAP) { atomicAdd(&bar[XB_TMO], 1u); break; } }
  }
  nloc = mine > 0u ? mine : 1u; nx = cnt > 0u ? cnt : 1u;
}
DI void xcd_barrier(const XcdBarrier& b) {
  asm volatile("s_waitcnt vmcnt(0)" ::: "memory");
  __syncthreads();
  if (threadIdx.x == 0) {
    unsigned* bar = b.bar;
    __builtin_amdgcn_s_waitcnt(0);
    unsigned nloc = b.st[0], nx = b.st[1];
    if (nloc == 0u) { xcd_barrier_complete(bar, b.x, nloc, nx); b.st[0] = nloc; b.st[1] = nx; }
    const unsigned old = xb_add(&bar[XB_XSUB(b.x)], 1u);
    const unsigned gen = old / nloc;
    if (old + 1u == (gen + 1u) * nloc) {
      __builtin_amdgcn_fence(__ATOMIC_RELEASE, "agent");
      asm volatile("s_waitcnt vmcnt(0)" ::: "memory");
      const unsigned og = xb_add(&bar[XB_TOP], 1u);
      const unsigned tg = og / nx;
      if (og + 1u == (tg + 1u) * nx) xb_add(&bar[XB_TOPGEN], 1u);
      else XB_SPIN(xb_ld(&bar[XB_TOPGEN]) == tg, bar);
      __builtin_amdgcn_fence(__ATOMIC_ACQUIRE, "agent");
      xb_add(&bar[XB_XGEN(b.x)], 1u);
      asm volatile("s_waitcnt vmcnt(0)" ::: "memory");
    } else {
      XB_SPIN(xb_ld(&bar[XB_XGEN(b.x)]) == gen, bar);
      __builtin_amdgcn_fence(__ATOMIC_ACQUIRE, "agent");
      asm volatile("s_waitcnt vmcnt(0)" ::: "memory");
    }
  }
  __syncthreads();
}

DI float gelu_tanh(float x) {
  const float y = 0.7978845608028654f * (x + 0.044715f * x * x * x);
  const float t = 1.f - 2.f / (1.f + __expf(2.f * y));
  return 0.5f * x * (1.f + t);
}
DI float log_sigmoid(float x) { return fminf(x, 0.f) - LN2 * lg2(1.f + ex2(-fabsf(x) * LOG2E)); }
DI float wave_sum(float v) {
#pragma unroll
  for (int o = 32; o > 0; o >>= 1) v += __shfl_xor(v, o);
  return v;
}

DI int win_map(int np) { return np < 1152 ? np : (np < 2304 ? np + 518 : (np < 2816 ? np - 1146 : (np < 2822 ? np - 1664 : -1))); }

__device__ void prep_transpose(const float* __restrict__ src, int srcN, int K, int k0, int n0, bfraw* __restrict__ dst, bool winmap, float* lds) {
  const int tid = fresh_tid(), nn = tid & 63, kr = tid >> 6;
  const int np = n0 + nn;
  const int n = winmap ? win_map(np) : np;
#pragma unroll
  for (int it = 0; it < 16; ++it) {
    const int kk = it * 4 + kr;
    const float v = (n >= 0) ? src[(size_t)(k0 + kk) * srcN + n] : 0.f;
    lds[kk * 65 + nn] = v;
  }
  __syncthreads();
#pragma unroll
  for (int j = 0; j < 2; ++j) {
    const int c = tid + 256 * j, n2 = c >> 3, kc = c & 7;
    const float* s = lds + (kc * 8) * 65 + n2;
    uint4 o;
    o.x = pack2(s[0], s[65]); o.y = pack2(s[130], s[195]); o.z = pack2(s[260], s[325]); o.w = pack2(s[390], s[455]);
    *(uint4*)(dst + (size_t)(n0 + n2) * K + k0 + kc * 8) = o;
  }
  __syncthreads();
}

__device__ void phase_prep(const Params& p, unsigned char* lds) {
  bfraw* WinT = (bfraw*)(p.ws + WS_WIN); bfraw* WoutT = (bfraw*)(p.ws + WS_WOUT);
  bfraw* WupT = (bfraw*)(p.ws + WS_WUP); bfraw* WdnT = (bfraw*)(p.ws + WS_WDN);
  bfraw* XB = (bfraw*)(p.ws + WS_XB);
  constexpr int PER_L = 768 + 256 + 1024 + 1024, NW = DEPTH * PER_L, NX = TT / 16;
  for (int it0 = blockIdx.x * 2; it0 < NW + NX; it0 += vgrid()) {
    const int it = min(it0 + half_id(), NW + NX - 1);
    if (it < NW) {
      const int l = it / PER_L; int r = it % PER_L;
      if (r < 768) prep_transpose(p.w_in + (size_t)l * D * DIN, DIN, D, (r & 15) * 64, (r >> 4) * 64, WinT + (size_t)l * NIN * D, true, (float*)lds);
      else if (r < 1024) { r -= 768; prep_transpose(p.w_out + (size_t)l * D * D, D, D, (r & 15) * 64, (r >> 4) * 64, WoutT + (size_t)l * D * D, false, (float*)lds); }
      else if (r < 2048) { r -= 1024; prep_transpose(p.w_up + (size_t)l * D * DFF, DFF, D, (r & 15) * 64, (r >> 4) * 64, WupT + (size_t)l * DFF * D, false, (float*)lds); }
      else { r -= 2048; prep_transpose(p.w_down + (size_t)l * DFF * D, D, DFF, (r & 63) * 64, (r >> 6) * 64, WdnT + (size_t)l * D * DFF, false, (float*)lds); }
    } else {
      const int tid0 = fresh_tid();
      const int row0 = (it - NW) * 16;
      const float* src = row0 < TP ? p.x_prompt + (size_t)row0 * D : p.x_sample + (size_t)(row0 - TP) * D;
      bfraw* dst = XB + (size_t)row0 * D;
#pragma unroll 4
      for (int i = 0; i < 16; ++i) {
        const int idx = (tid0 + 256 * i) * 4;
        const float4 v = *(const float4*)(src + idx);
        uint2 o; o.x = pack2(v.x, v.y); o.y = pack2(v.z, v.w);
        *(uint2*)(dst + idx) = o;
      }
    }
  }
}

enum { EPI_INPROJ = 0, EPI_RESID = 1, EPI_UP = 2, EPI_RESID_IN = 3 };

template <int EPI, int MI, int NI>
DI void gemm_epilogue(const Params& p, int layer, f32x16 (&acc)[MI][NI], int m0, int rbase, int nc0, int r32, int h, bool from_input) {
  if (EPI == EPI_INPROJ) {
    bfraw* QKV = (bfraw*)(p.ws + WS_QKV);
    if (nc0 < QKVW) {
      const int which = nc0 / 384;
      const float scale = (which == 0 || which == 3) ? 0.125f : 1.f;
      const int colin = nc0 - which * 384;
      const size_t offp = which == 1 ? O_PFK : which == 2 ? O_PFV : which == 4 ? O_PSK : O_PSV;
      const size_t offs = which == 1 ? O_SFK : which == 2 ? O_SFV : which == 4 ? O_SSK : O_SSV;
      const bool has_out = (which == 1 || which == 2 || which == 4 || which == 5);
      float* outP = p.out + offp + (size_t)layer * TP * 384 + colin + r32;
      float* outS = p.out + offs + ((size_t)layer * TS * 384 - (size_t)TP * 384) + colin + r32;
#pragma unroll
      for (int mi = 0; mi < MI; ++mi)
#pragma unroll
        for (int ni = 0; ni < NI; ++ni)
#pragma unroll
          for (int i = 0; i < 16; ++i) {
            const int row = m0 + rbase + mi * 32 + (i & 3) + 8 * (i >> 2) + 4 * h;
            const float v = acc[mi][ni][i];
            QKV[(size_t)row * QKVW + nc0 + ni * 32 + r32] = (bfraw)(pack2(v * scale, 0.f) & 0xffffu);
            if (has_out) { float* ob = row < TP ? outP : outS; ob[(size_t)row * 384 + ni * 32] = v; }
          }
    } else if (nc0 < 2560) {
      bfraw* U = (bfraw*)(p.ws + WS_U);
#pragma unroll
      for (int mi = 0; mi < MI; ++mi)
#pragma unroll
        for (int ni = 0; ni < NI; ++ni)
#pragma unroll
          for (int i = 0; i < 16; ++i) {
            const int rl = rbase + mi * 32 + (i & 3) + 8 * (i >> 2) + 4 * h;
            const int col = ni * 32 + r32;
            U[(size_t)(m0 + rl) * 256 + (nc0 - 2304) + col] = (bfraw)(pack2(gelu_tanh(acc[mi][ni][i]), 0.f) & 0xffffu);
          }
    } else if (nc0 < 2816) {
      float* VG = (float*)(p.ws + WS_VG);
#pragma unroll
      for (int mi = 0; mi < MI; ++mi)
#pragma unroll
        for (int ni = 0; ni < NI; ++ni)
#pragma unroll
          for (int i = 0; i < 16; ++i) {
            const int rl = rbase + mi * 32 + (i & 3) + 8 * (i >> 2) + 4 * h;
            const int col = ni * 32 + r32;
            VG[(size_t)(m0 + rl) * 256 + (nc0 - 2560) + col] = gelu_tanh(acc[mi][ni][i]);
          }
    } else if (nc0 == 2816) {
      if (r32 < 6) {
        float* LOGF = (float*)(p.ws + WS_LOGF);
        float* outP = p.out + O_PFL + (size_t)layer * TP * 6 + r32;
        float* outS = p.out + O_SFL + ((size_t)layer * TS * 6 - (size_t)TP * 6) + r32;
        const float bias = p.b_f[layer * 6 + r32];
#pragma unroll
        for (int mi = 0; mi < MI; ++mi)
#pragma unroll
          for (int i = 0; i < 16; ++i) {
            const int row = m0 + rbase + mi * 32 + (i & 3) + 8 * (i >> 2) + 4 * h;
            const float lf = log_sigmoid(acc[mi][0][i] + bias);
            LOGF[(size_t)row * 8 + r32] = lf;
            float* ob = row < TP ? outP : outS;
            ob[(size_t)row * 6] = lf;
          }
      }
    }
  } else if (EPI == EPI_RESID_IN) {
    unsigned char* Yb = p.ws + WS_Y;
    const float* xp = p.x_prompt + nc0 + r32;
    const float* xs = p.x_sample - (size_t)TP * D + nc0 + r32;
    const unsigned o0 = (unsigned)(((m0 + rbase + 4 * h) * D + nc0 + r32) * 4);
#pragma unroll
    for (int mi = 0; mi < MI; ++mi) {
      float xr[NI][16];
#pragma unroll
      for (int ni = 0; ni < NI; ++ni)
#pragma unroll
        for (int i = 0; i < 16; ++i) {
          const int row = m0 + rbase + 4 * h + mi * 32 + (i & 3) + 8 * (i >> 2);
          xr[ni][i] = (row < TP ? xp : xs)[(size_t)row * D + ni * 32];
        }
#pragma unroll
      for (int ni = 0; ni < NI; ++ni)
#pragma unroll
        for (int i = 0; i < 16; ++i)
          *(float*)(Yb + (o0 + (unsigned)(((mi * 32 + (i & 3) + 8 * (i >> 2)) * D + ni * 32) * 4))) = ALPHA * xr[ni][i] + acc[mi][ni][i];
    }
  } else if (EPI == EPI_RESID) {
    unsigned char* Yb = p.ws + WS_Y;
    const unsigned char* Xb = p.ws + WS_X32;
    const unsigned o0 = (unsigned)(((m0 + rbase + 4 * h) * D + nc0 + r32) * 4);
#pragma unroll
    for (int mi = 0; mi < MI; ++mi) {
      float xr[NI][16];
#pragma unroll
      for (int ni = 0; ni < NI; ++ni)
#pragma unroll
        for (int i = 0; i < 16; ++i)
          xr[ni][i] = *(const float*)(Xb + (o0 + (unsigned)(((mi * 32 + (i & 3) + 8 * (i >> 2)) * D + ni * 32) * 4)));
#pragma unroll
      for (int ni = 0; ni < NI; ++ni)
#pragma unroll
        for (int i = 0; i < 16; ++i)
          *(float*)(Yb + (o0 + (unsigned)(((mi * 32 + (i & 3) + 8 * (i >> 2)) * D + ni * 32) * 4))) = ALPHA * xr[ni][i] + acc[mi][ni][i];
    }
  } else {
    bfraw* H = (bfraw*)(p.ws + WS_H);
#pragma unroll
    for (int mi = 0; mi < MI; ++mi)
#pragma unroll
      for (int ni = 0; ni < NI; ++ni)
#pragma unroll
        for (int i = 0; i < 16; ++i) {
          const int rl = rbase + mi * 32 + (i & 3) + 8 * (i >> 2) + 4 * h;
          const int col = nc0 + ni * 32 + r32;
          const float v = fmaxf(acc[mi][ni][i], 0.f);
          H[(size_t)(m0 + rl) * DFF + col] = (bfraw)(pack2(v * v, 0.f) & 0xffffu);
        }
  }
}

template <int EPI, int MI, int NI>
__device__ void gemm_tile8(const Params& p, int layer, const bfraw* __restrict__ A, const bfraw* __restrict__ Bt, int K, int m0, int n0, unsigned char* ring, bool from_input,
                           bool first, bool has_next, int next_m0, int next_n0) {
  constexpr int WGM = NI == 2 ? 2 : 1, WGN = 8 / WGM;
  constexpr int BM = WGM * MI * 32;
  constexpr int STAGE = (BM + 256) * 128;
  constexpr int NAI = BM / 8;
  constexpr int NA = (NAI + 7) / 8;
  int tid = threadIdx.x; asm volatile("" : "+v"(tid));
  const int lane = tid & 63, wid = tid >> 6, wm = wid / WGN, wn = wid % WGN;
  const int r32 = lane & 31, h = lane >> 5;
  f32x16 acc[MI][NI];
#pragma unroll
  for (int a = 0; a < MI; ++a)
#pragma unroll
    for (int b = 0; b < NI; ++b)
#pragma unroll
      for (int i = 0; i < 16; ++i) acc[a][b][i] = 0.f;
  const int dc = (lane & 7) ^ (((wid & 1) * 4 + (lane >> 4)) & 7);
  const unsigned loff = (unsigned)(((wid * 8 + (lane >> 3)) * K + dc * 8) * 2);
  const unsigned char* ab = (const unsigned char*)(A + (size_t)m0 * K);
  const unsigned char* bb = (const unsigned char*)(Bt + (size_t)n0 * K);
  unsigned char* dl = ring + wid * 1024 + lane * 16;
#define ISSUE8A(ab, kt_, st_) do { \
    _Pragma("unroll") for (int j = 0; j < NA; ++j) { \
      if (NAI % 8 == 0 || j < NA - 1 || wid < NAI % 8) \
        __builtin_amdgcn_global_load_lds((const unsigned*)(ab + ((size_t)j * 64 * K + (kt_) * 64) * 2 + loff), (unsigned*)(dl + (st_) * STAGE + j * 8192), 16, 0, 0); } \
  } while (0)
#define ISSUE8B(bb, kt_, st_) do { \
    _Pragma("unroll") for (int j = 0; j < 4; ++j) \
      __builtin_amdgcn_global_load_lds((const unsigned*)(bb + ((size_t)j * 64 * K + (kt_) * 64) * 2 + loff), (unsigned*)(dl + (st_) * STAGE + BM * 128 + j * 8192), 16, 0, 0); \
  } while (0)
#define ISSUE8(ab, bb, kt_, st_) do { ISSUE8A(ab, kt_, st_); ISSUE8B(bb, kt_, st_); } while (0)
  const int key = (r32 >> 1) & 7;
  const unsigned char* afr = ring + (wm * (MI * 32) + r32) * 128;
  const unsigned char* bfr = ring + BM * 128 + (wn * (NI * 32) + r32) * 128;
  const int nk = K >> 6;
  const unsigned char* abn = (const unsigned char*)(A + (size_t)next_m0 * K);
  const unsigned char* bbn = (const unsigned char*)(Bt + (size_t)next_n0 * K);
  if (first) {
    asm volatile("s_waitcnt vmcnt(0)" ::: "memory");
    __builtin_amdgcn_s_barrier();
    asm volatile("" ::: "memory");
    ISSUE8(ab, bb, 0, 0);
  }
  int st = 0;
  for (int kt = 0; kt < nk; ++kt) {
    asm volatile("s_waitcnt vmcnt(0)" ::: "memory");
    __builtin_amdgcn_s_barrier();
    asm volatile("" ::: "memory");
    if (kt + 1 < nk) ISSUE8A(ab, kt + 1, st ^ 1);
    else if (has_next) ISSUE8A(abn, 0, st ^ 1);
    const unsigned char* as = afr + st * STAGE;
    const unsigned char* bs = bfr + st * STAGE;
#pragma unroll
    for (int ks = 0; ks < 4; ++ks) {
      if (ks == 2) { if (kt + 1 < nk) ISSUE8B(bb, kt + 1, st ^ 1); else if (has_next) ISSUE8B(bbn, 0, st ^ 1); }
      const int o = ((ks * 2 + h) ^ key) * 16;
      bf16x8 af[MI], bq[NI];
#pragma unroll
      for (int mi = 0; mi < MI; ++mi) af[mi] = *(const bf16x8*)(as + mi * 4096 + o);
#pragma unroll
      for (int ni = 0; ni < NI; ++ni) bq[ni] = *(const bf16x8*)(bs + ni * 4096 + o);
#pragma unroll
      for (int mi = 0; mi < MI; ++mi)
#pragma unroll
        for (int ni = 0; ni < NI; ++ni)
          acc[mi][ni] = __builtin_amdgcn_mfma_f32_32x32x16_bf16(af[mi], bq[ni], acc[mi][ni], 0, 0, 0);
    }
    st ^= 1;
  }
#undef ISSUE8
#undef ISSUE8A
#undef ISSUE8B
  gemm_epilogue<EPI, MI, NI>(p, layer, acc, m0, wm * (MI * 32), n0 + wn * (NI * 32), r32, h, from_input);
}

template <int EPI, int MI, int NI>
__device__ void phase_gemm8(const Params& p, int layer, const bfraw* A, const bfraw* Bt, int N, int K, unsigned char* ring, bool from_input = false) {
  constexpr int BM = (NI == 2 ? 2 : 1) * MI * 32;
  const int ntn = N / 256, ntiles = (TT / BM) * ntn;
  for (int t = blockIdx.x; t < ntiles; t += gridDim.x) {
    const int tm = t / ntn, tn = t % ntn;
    const int t2 = t + gridDim.x;
    const bool has_next = t2 < ntiles;
    const int tm2 = has_next ? t2 / ntn : tm, tn2 = has_next ? t2 % ntn : tn;
    gemm_tile8<EPI, MI, NI>(p, layer, A, Bt, K, tm * BM, tn * 256, ring, from_input, t == (int)blockIdx.x, has_next, tm2 * BM, tn2 * 256);
  }
  __syncthreads();
}

__device__ void phase_ln(const Params& p, const float* __restrict__ gam, const float* __restrict__ bet, bool last) {
  const float* Y = (const float*)(p.ws + WS_Y);
  float* X32 = (float*)(p.ws + WS_X32);
  bfraw* XB = (bfraw*)(p.ws + WS_XB);
  const int tid_ = fresh_tid(); const int lane = tid_ & 63, wid = tid_ >> 6;
  for (int row = vblock() * 4 + wid; row < TT; row += vgrid() * 4) {
    const float* y = Y + (size_t)row * D;
    float4 v[4];
#pragma unroll
    for (int j = 0; j < 4; ++j) v[j] = *(const float4*)(y + lane * 4 + 256 * j);
    float s = 0.f;
#pragma unroll
    for (int j = 0; j < 4; ++j) s += v[j].x + v[j].y + v[j].z + v[j].w;
    const float mu = wave_sum(s) * (1.f / D);
    float q = 0.f;
#pragma unroll
    for (int j = 0; j < 4; ++j) { v[j].x -= mu; v[j].y -= mu; v[j].z -= mu; v[j].w -= mu; q += v[j].x * v[j].x + v[j].y * v[j].y + v[j].z * v[j].z + v[j].w * v[j].w; }
    const float rstd = rsqrtf(wave_sum(q) * (1.f / D) + 1e-5f);
#pragma unroll
    for (int j = 0; j < 4; ++j) {
      const int c = lane * 4 + 256 * j;
      const float4 g = *(const float4*)(gam + c), b = *(const float4*)(bet + c);
      float4 o;
      o.x = v[j].x * rstd * g.x + b.x; o.y = v[j].y * rstd * g.y + b.y; o.z = v[j].z * rstd * g.z + b.z; o.w = v[j].w * rstd * g.w + b.w;
      if (last) {
        *(float4*)(p.out + (size_t)row * D + c) = o;
      } else {
        *(float4*)(X32 + (size_t)row * D + c) = o;
        uint2 ob; ob.x = pack2(o.x, o.y); ob.y = pack2(o.z, o.w);
        *(uint2*)(XB + (size_t)row * D + c) = ob;
      }
    }
  }
}

DI float wave_incl_scan(float v, int lane) {
#pragma unroll
  for (int o = 1; o < 64; o <<= 1) { const float t = __shfl_up(v, o); if (lane >= o) v += t; }
  return v;
}
__device__ void phase_scan(const Params& p, int layer, unsigned char* lds) {
  const float* LOGF = (const float*)(p.ws + WS_LOGF);
  float* C = (float*)(p.ws + WS_C);
  float* CC = (float*)(p.ws + WS_CC);
  float* red = (float*)lds;
  const int tid = fresh_tid(), lane = tid & 63, wid = tid >> 6;
  {
    const bfraw* QKV = (const bfraw*)(p.ws + WS_QKV);
    unsigned* kmx = (unsigned*)(p.ws + WS_CTL) + KMAX_WORD + 64 * layer;
    for (int it = vblock(); it < 24 * 16; it += vgrid()) {
      const int bh = it >> 4, b = bh / 6, h = bh % 6, pos = (it & 15) * 256 + tid;
      const uint4* kp = (const uint4*)(QKV + (size_t)(b * SEQ + pos) * QKVW + 384 + h * 64);
      float ss = 0.f;
#pragma unroll
      for (int i = 0; i < 8; ++i) {
        const uint4 u = kp[i];
        const unsigned w[4] = {u.x, u.y, u.z, u.w};
#pragma unroll
        for (int k = 0; k < 4; ++k) { const float a = __uint_as_float(w[k] << 16), c = __uint_as_float(w[k] & 0xffff0000u); ss += a * a + c * c; }
      }
#pragma unroll
      for (int o = 32; o > 0; o >>= 1) ss = fmaxf(ss, __shfl_xor(ss, o));
      if (lane == 0) atomicMax(&kmx[bh], __float_as_uint(ss));
    }
  }
  for (int seq0 = blockIdx.x * 2; seq0 < 24 + 192; seq0 += vgrid()) {
    const int seq = min(seq0 + half_id(), 24 + 192 - 1);
    const bool pr = seq < 24;
    const int s = pr ? seq : seq - 24, b = s / 6, h = s % 6;
    float v[16];
    if (pr) {
      const float* base = LOGF + ((size_t)b * SEQ + tid * 16) * 8 + h;
#pragma unroll
      for (int i = 0; i < 16; ++i) v[i] = base[i * 8];
    } else {
      const float* base = p.cfl + (((size_t)layer * DECB + b) * PAST + tid * 8) * 6 + h;
#pragma unroll
      for (int i = 0; i < 8; ++i) v[i] = base[i * 6];
#pragma unroll
      for (int i = 8; i < 16; ++i) v[i] = 0.f;
    }
#pragma unroll
    for (int i = 1; i < 16; ++i) v[i] += v[i - 1];
    const float tot = v[15];
    const float inc = wave_incl_scan(tot, lane);
    if (lane == 63) red[wid] = inc;
    __syncthreads();
    const float r0 = red[0], r1 = red[1], r2 = red[2], r3 = red[3];
    float off = inc - tot;
    off += (wid > 0 ? r0 : 0.f) + (wid > 1 ? r1 : 0.f) + (wid > 2 ? r2 : 0.f);
    if (pr) {
      float* dst = C + ((size_t)b * SEQ + tid * 16) * 8 + h;
#pragma unroll
      for (int i = 0; i < 16; ++i) dst[i * 8] = off + v[i];
    } else {
      float* dst = CC + ((size_t)b * PAST + tid * 8) * 8 + h;
#pragma unroll
      for (int i = 0; i < 8; ++i) dst[i * 8] = off + v[i];
      if (wid == 0) {
        const size_t idx = ((size_t)TP + b * DECS + lane) * 8 + h;
        C[idx] = ((r0 + r1) + (r2 + r3)) + wave_incl_scan(LOGF[idx], lane);
      }
    }
    __syncthreads();
  }
}

__device__ void attn_item(const Params& p, int layer, int type, bool sample, int b, int h, int qb, unsigned char* lds, volatile LAS int* flg) {
  const bfraw* QKV = (const bfraw*)(p.ws + WS_QKV);
  const float* C = (const float*)(p.ws + WS_C);
  const float* CC = (const float*)(p.ws + WS_CC);
  bfraw* O = (bfraw*)(p.ws + WS_O);
  const int tid = fresh_tid(), lane = tid & 63, wid = tid >> 6, l15 = lane & 15, g = lane >> 4;
  const int qrow0 = sample ? TP + b * DECS : b * SEQ + qb * 64;
  const int ntiles = sample ? 33 : qb + 1;
  const int qoff = type ? 1152 : 0, koff = qoff + 384, voff = qoff + 768, hc = h * 64;
  const int qrow = qrow0 + wid * 16 + l15;
  const bfraw* qp = QKV + (size_t)qrow * QKVW + qoff + hc + g * 8;
  const bf16x8 q0 = *(const bf16x8*)qp, q1 = *(const bf16x8*)(qp + 32);
  float cq2 = 0.f;
  if (type == 0) cq2 = C[(size_t)qrow * 8 + h] * LOG2E;
  const bool fexit = (type == 0) && !sample;
  float bqk = 0.f, cnext = 0.f;
  if (fexit) {
    float qs = 0.f;
#pragma unroll
    for (int i = 0; i < 8; ++i) { const float a = bf2f((bfraw)q0[i]), c = bf2f((bfraw)q1[i]); qs += a * a + c * c; }
    qs += __shfl_xor(qs, 16); qs += __shfl_xor(qs, 32);
    const float kmax2 = __uint_as_float(((const unsigned*)(p.ws + WS_CTL))[KMAX_WORD + 64 * layer + b * 6 + h]);
    bqk = sqrtf(qs * kmax2) * (LOG2E * 1.01f) + 1.f;
  }
  const float* kcache = type ? p.csk : p.cfk;
  const float* vcache = type ? p.csv : p.cfv;

  float4 st[8]; float stc = 0.f;
  const int key_l = tid >> 3, dc = tid & 7;
  unsigned char* kd = lds + key_l * 144 + dc * 16;
  unsigned char* vd = kd + 9216;
  float* ckl = (float*)(lds + 18432);

#define ATTN_PREFETCH(t_)                                                                                         \
  do {                                                                                                            \
    const int tt_ = (t_);                                                                                         \
    if (!(sample && tt_ < 32)) {                                                                                  \
      const int krow = sample ? TP + b * DECS : b * SEQ + tt_ * 64;                                               \
      const bfraw* kp = QKV + (size_t)(krow + key_l) * QKVW + hc + dc * 8;                                        \
      st[0] = *(const float4*)(kp + koff); st[1] = *(const float4*)(kp + koff + 32 * QKVW);                       \
      st[2] = *(const float4*)(kp + voff); st[3] = *(const float4*)(kp + voff + 32 * QKVW);                       \
      if (type == 0 && tid < 64) stc = C[(size_t)(krow + tid) * 8 + h];                                           \
    } else {                                                                                                      \
      const size_t off = ((((size_t)layer * DECB + b) * PAST + tt_ * 64 + key_l) * 6 + h) * 64 + dc * 8;          \
      const float* kc = kcache + off; const float* vc = vcache + off;                                             \
      st[0] = *(const float4*)kc; st[1] = *(const float4*)(kc + 4);                                               \
      st[2] = *(const float4*)(kc + 32 * 384); st[3] = *(const float4*)(kc + 32 * 384 + 4);                       \
      st[4] = *(const float4*)vc; st[5] = *(const float4*)(vc + 4);                                               \
      st[6] = *(const float4*)(vc + 32 * 384); st[7] = *(const float4*)(vc + 32 * 384 + 4);                       \
      if (type == 0 && tid < 64) stc = CC[((size_t)b * PAST + tt_ * 64 + tid) * 8 + h];                           \
    }                                                                                                             \
  } while (0)

  f32x4 oacc[4];
#pragma unroll
  for (int i = 0; i < 4; ++i) oacc[i] = (f32x4){0.f, 0.f, 0.f, 0.f};
  float m = -1e30f, lsum = 0.f, R = 0.f;
  const int ql = wid * 16 + l15;
  const int i16 = l15, qq = i16 >> 2, pp = i16 & 3;
  const unsigned char* vtr = lds + 9216 + (4 * g + qq) * 144 + pp * 8;

  ATTN_PREFETCH(ntiles - 1);
  for (int t = ntiles - 1; t >= 0; --t) {
    if (!(sample && t < 32)) {
      *(float4*)kd = st[0]; *(float4*)(kd + 32 * 144) = st[1]; *(float4*)vd = st[2]; *(float4*)(vd + 32 * 144) = st[3];
    } else {
      uint4 a;
      a.x = pack2(st[0].x, st[0].y); a.y = pack2(st[0].z, st[0].w); a.z = pack2(st[1].x, st[1].y); a.w = pack2(st[1].z, st[1].w); *(uint4*)kd = a;
      a.x = pack2(st[2].x, st[2].y); a.y = pack2(st[2].z, st[2].w); a.z = pack2(st[3].x, st[3].y); a.w = pack2(st[3].z, st[3].w); *(uint4*)(kd + 32 * 144) = a;
      a.x = pack2(st[4].x, st[4].y); a.y = pack2(st[4].z, st[4].w); a.z = pack2(st[5].x, st[5].y); a.w = pack2(st[5].z, st[5].w); *(uint4*)vd = a;
      a.x = pack2(st[6].x, st[6].y); a.y = pack2(st[6].z, st[6].w); a.z = pack2(st[7].x, st[7].y); a.w = pack2(st[7].z, st[7].w); *(uint4*)(vd + 32 * 144) = a;
    }
    if (type == 0 && tid < 64) ckl[tid] = stc * LOG2E;
    __syncthreads();
    if (t > 0) ATTN_PREFETCH(t - 1);
    if (fexit && t > 0) cnext = C[(size_t)(b * SEQ + (t - 1) * 64 + 63) * 8 + h];
    const bool diag = (t == ntiles - 1);

    f32x4 s[4];
#pragma unroll
    for (int kb = 0; kb < 4; ++kb) {
      const unsigned char* ka = lds + (kb * 16 + l15) * 144 + g * 16;
      const bf16x8 a0 = *(const bf16x8*)ka, a1 = *(const bf16x8*)(ka + 64);
      f32x4 z = (f32x4){0.f, 0.f, 0.f, 0.f};
      z = __builtin_amdgcn_mfma_f32_16x16x32_bf16(a0, q0, z, 0, 0, 0);
      s[kb] = __builtin_amdgcn_mfma_f32_16x16x32_bf16(a1, q1, z, 0, 0, 0);
    }
    unsigned pk[8];
    if (type == 0) {
      float mx = -1e30f;
#pragma unroll
      for (int kb = 0; kb < 4; ++kb) {
        const f32x4 ck = *(const f32x4*)(ckl + kb * 16 + 4 * g);
#pragma unroll
        for (int j = 0; j < 4; ++j) {
          float x = s[kb][j] * LOG2E + cq2 - ck[j];
          if (diag && (kb * 16 + 4 * g + j > ql)) x = -1e30f;
          s[kb][j] = x; mx = fmaxf(mx, x);
        }
      }
      mx = fmaxf(mx, __shfl_xor(mx, 16)); mx = fmaxf(mx, __shfl_xor(mx, 32));
      const float mnew = fmaxf(m, mx);
      const float alpha = ex2(m - mnew);
      m = mnew;
      float ps = 0.f;
#pragma unroll
      for (int kb = 0; kb < 4; ++kb) {
        const float p0 = ex2(s[kb][0] - mnew), p1 = ex2(s[kb][1] - mnew), p2 = ex2(s[kb][2] - mnew), p3 = ex2(s[kb][3] - mnew);
        ps += (p0 + p1) + (p2 + p3);
        pk[kb * 2] = pack2(p0, p1); pk[kb * 2 + 1] = pack2(p2, p3);
      }
      lsum = lsum * alpha + ps;
#pragma unroll
      for (int db = 0; db < 4; ++db) oacc[db] *= alpha;
    } else {
      float lr[4][4];
#pragma unroll
      for (int kb = 0; kb < 4; ++kb)
#pragma unroll
        for (int j = 0; j < 4; ++j) {
          const float z2 = s[kb][j] * LOG2E;
          const float e = ex2(-fabsf(z2));
          float l = -(fmaxf(z2, 0.f) + lg2(1.f + e));
          if (diag && !(kb * 16 + 4 * g + j < ql)) l = 0.f;
          s[kb][j] = z2; lr[kb][j] = l;
        }
#pragma unroll
      for (int kb = 3; kb >= 0; --kb) {
        const float G = (lr[kb][0] + lr[kb][1]) + (lr[kb][2] + lr[kb][3]);
        const float a = __shfl_xor(G, 16), bb = __shfl_xor(G, 32), c = __shfl_xor(G, 48);
        const float tot = (G + a) + (bb + c);
        const float gt = ((g == 0 || g == 2) ? a : 0.f) + ((g < 2) ? (bb + c) : 0.f);
        const float a3 = R + gt, a2 = a3 + lr[kb][3], a1 = a2 + lr[kb][2], a0 = a1 + lr[kb][1];
        float p0 = ex2(s[kb][0] + lr[kb][0] + a0), p1 = ex2(s[kb][1] + lr[kb][1] + a1);
        float p2 = ex2(s[kb][2] + lr[kb][2] + a2), p3 = ex2(s[kb][3] + lr[kb][3] + a3);
        if (diag) {
          const int k0 = kb * 16 + 4 * g;
          if (!(k0 < ql)) p0 = 0.f;
          if (!(k0 + 1 < ql)) p1 = 0.f;
          if (!(k0 + 2 < ql)) p2 = 0.f;
          if (!(k0 + 3 < ql)) p3 = 0.f;
        }
        pk[kb * 2] = pack2(p0, p1); pk[kb * 2 + 1] = pack2(p2, p3);
        R += tot;
      }
      const int alldone = __all(R < SB_EXIT) ? 1 : 0;
      if (lane == 0) flg[half_id() * 4 + wid] = alldone;
    }
    if (fexit) {
      const int done = (t > 0 && __all(bqk + cq2 - cnext * LOG2E - m < FOX_EXIT)) ? 1 : 0;
      if (lane == 0) flg[half_id() * 4 + wid] = done;
    }
#pragma unroll
    for (int kk = 0; kk < 2; ++kk) {
      const uint4 pu = {pk[kk * 4], pk[kk * 4 + 1], pk[kk * 4 + 2], pk[kk * 4 + 3]};
      const bf16x8 pf = __builtin_bit_cast(bf16x8, pu);
#pragma unroll
      for (int db = 0; db < 4; ++db) {
        const unsigned char* va = vtr + (32 * kk) * 144 + db * 32;
        const s16x4 lo = __builtin_amdgcn_ds_read_tr16_b64_v4i16((LAS s16x4*)(va));
        const s16x4 hi = __builtin_amdgcn_ds_read_tr16_b64_v4i16((LAS s16x4*)(va + 16 * 144));
        const bf16x8 vf = __builtin_shufflevector(lo, hi, 0, 1, 2, 3, 4, 5, 6, 7);
        oacc[db] = __builtin_amdgcn_mfma_f32_16x16x32_bf16(vf, pf, oacc[db], 0, 0, 0);
      }
    }
    __syncthreads();
    if (type == 1 || fexit) { if (flg[0] & flg[1] & flg[2] & flg[3] & flg[4] & flg[5] & flg[6] & flg[7]) break; }
  }
#undef ATTN_PREFETCH
  if (type == 0) {
    lsum += __shfl_xor(lsum, 16); lsum += __shfl_xor(lsum, 32);
    const float inv = 1.f / lsum;
#pragma unroll
    for (int db = 0; db < 4; ++db) oacc[db] *= inv;
  }
  float ss = 0.f;
#pragma unroll
  for (int db = 0; db < 4; ++db)
#pragma unroll
    for (int j = 0; j < 4; ++j) ss += oacc[db][j] * oacc[db][j];
  ss += __shfl_xor(ss, 16); ss += __shfl_xor(ss, 32);
  const float rs = rsqrtf(ss * (1.f / 64.f) + 1e-6f);
  const int hoff = type ? 640 + hc : hc;
#pragma unroll
  for (int db = 0; db < 4; ++db) {
    const int d0 = 16 * db + 4 * g;
    const float4 gm = *(const float4*)(p.g_mix + layer * D + hoff + d0);
    uint2 o;
    o.x = pack2(oacc[db][0] * rs * gm.x, oacc[db][1] * rs * gm.y);
    o.y = pack2(oacc[db][2] * rs * gm.z, oacc[db][3] * rs * gm.w);
    *(uint2*)(O + (size_t)qrow * D + hoff + d0) = o;
  }
}

__device__ void sgu_item(const Params& p, int layer, bool sample, int ci, int g, unsigned char* lds) {
  const float* VG = (const float*)(p.ws + WS_VG);
  const bfraw* U = (const bfraw*)(p.ws + WS_U);
  bfraw* O = (bfraw*)(p.ws + WS_O);
  constexpr int LROW = 272;
  unsigned char* Wl = lds;
  unsigned char* Vt = lds + 128 * LROW;
  const int tid = fresh_tid(), lane = tid & 63, wid = tid >> 6;
  const int r0 = sample ? TP + ci * DECS : ci * 128;
  const int L = sample ? 64 : 128;
  {
    const float4 gv = *(const float4*)(p.g_v + layer * 256 + lane * 4), bv = *(const float4*)(p.b_v + layer * 256 + lane * 4);
    for (int i = wid; i < L; i += 4) {
      float4 v = *(const float4*)(VG + (size_t)(r0 + i) * 256 + lane * 4);
      const float mu = wave_sum(v.x + v.y + v.z + v.w) * (1.f / 256.f);
      v.x -= mu; v.y -= mu; v.z -= mu; v.w -= mu;
      const float rstd = rsqrtf(wave_sum(v.x * v.x + v.y * v.y + v.z * v.z + v.w * v.w) * (1.f / 256.f) + 1e-5f);
      float4 o;
      o.x = v.x * rstd * gv.x + bv.x; o.y = v.y * rstd * gv.y + bv.y; o.z = v.z * rstd * gv.z + bv.z; o.w = v.w * rstd * gv.w + bv.w;
      if ((lane >> 4) == g) {
        const unsigned lo = pack2(o.x, o.y), hi = pack2(o.z, o.w);
        unsigned char* vp = Vt + ((lane & 15) * 4) * LROW + i * 2;
        *(bfraw*)(vp) = (bfraw)(lo & 0xffffu); *(bfraw*)(vp + LROW) = (bfraw)(lo >> 16);
        *(bfraw*)(vp + 2 * LROW) = (bfraw)(hi & 0xffffu); *(bfraw*)(vp + 3 * LROW) = (bfraw)(hi >> 16);
        if (sample) *(float4*)(p.out + O_SGV + ((size_t)layer * TS + (r0 - TP) + i) * 256 + lane * 4) = o;
      }
    }
    const float* wg = p.w_s + ((size_t)layer * 4 + g) * 128 * 128;
#pragma unroll 4
    for (int k = 0; k < 16; ++k) {
      const int idx = tid + 256 * k, row = idx >> 5, c4 = (idx & 31) * 4;
      if (row < L) {
        const float4 w = *(const float4*)(wg + row * 128 + c4);
        uint2 o;
        o.x = pack2(c4 <= row ? w.x : 0.f, c4 + 1 <= row ? w.y : 0.f);
        o.y = pack2(c4 + 2 <= row ? w.z : 0.f, c4 + 3 <= row ? w.w : 0.f);
        *(uint2*)(Wl + row * LROW + c4 * 2) = o;
      }
    }
  }
  __syncthreads();
  if (wid * 32 < L) {
    const int r32 = lane & 31, h = lane >> 5;
    f32x16 acc[2];
#pragma unroll
    for (int ni = 0; ni < 2; ++ni)
#pragma unroll
      for (int i = 0; i < 16; ++i) acc[ni][i] = 0.f;
    const unsigned char* ap = Wl + (wid * 32 + r32) * LROW + h * 16;
    const unsigned char* bp = Vt + r32 * LROW + h * 16;
    const int nks = min(L / 16, 2 * (wid + 1));
    for (int ks = 0; ks < nks; ++ks) {
      const bf16x8 a = *(const bf16x8*)(ap + ks * 32);
      const bf16x8 b0 = *(const bf16x8*)(bp + ks * 32), b1 = *(const bf16x8*)(bp + 32 * LROW + ks * 32);
      acc[0] = __builtin_amdgcn_mfma_f32_32x32x16_bf16(a, b0, acc[0], 0, 0, 0);
      acc[1] = __builtin_amdgcn_mfma_f32_32x32x16_bf16(a, b1, acc[1], 0, 0, 0);
    }
    const float* bsp = p.b_s + ((size_t)layer * 4 + g) * 128 + wid * 32 + 4 * h;
    const float* gm = p.g_mix + layer * D + 384 + g * 64 + r32;
    const float gm0 = gm[0], gm1 = gm[32];
    const size_t rowb = (size_t)(r0 + wid * 32 + 4 * h);
#pragma unroll
    for (int i = 0; i < 16; ++i) {
      const int rl = (i & 3) + 8 * (i >> 2);
      const float bs = bsp[rl];
      const bfraw* up = U + (rowb + rl) * 256 + g * 64 + r32;
      const float o0 = bf2f(up[0]) * (acc[0][i] + bs), o1 = bf2f(up[32]) * (acc[1][i] + bs);
      float ss = o0 * o0 + o1 * o1;
      ss += __shfl_xor(ss, 1); ss += __shfl_xor(ss, 2); ss += __shfl_xor(ss, 4); ss += __shfl_xor(ss, 8); ss += __shfl_xor(ss, 16);
      const float rs = rsqrtf(ss * (1.f / 64.f) + 1e-6f);
      bfraw* op = O + (rowb + rl) * D + 384 + g * 64 + r32;
      op[0] = (bfraw)(pack2(o0 * rs * gm0, 0.f) & 0xffffu);
      op[32] = (bfraw)(pack2(o1 * rs * gm1, 0.f) & 0xffffu);
    }
  }
  __syncthreads();
}

__device__ void phase_mix(const Params& p, int layer, unsigned char* lds, volatile LAS int* slot) {
  unsigned* ctr = (unsigned*)(p.ws + WS_CTL) + QCTR_WORD + 64 * layer;
  volatile LAS int* flg = slot + 4;
  constexpr int N_SAMPLE = 384, N_PROMPT = 3072, N_SGU = 640, N_ALL = N_SAMPLE + N_PROMPT + N_SGU;
  for (;;) {
    if (threadIdx.x == 0) *slot = (int)atomicAdd(ctr, 1u);
    __syncthreads();
    const int item = *slot * 2 + half_id();
    __syncthreads();
    if (item >= N_ALL) break;
    if (item < N_SAMPLE) {
      const int type = item < 192 ? 1 : 0, r = item % 192;
      attn_item(p, layer, type, true, r / 6, r % 6, 0, lds, flg);
    } else if (item < N_SAMPLE + N_SGU) {
      int r = item - N_SAMPLE;
      if (r < 512) sgu_item(p, layer, false, r >> 2, r & 3, lds);
      else { r -= 512; sgu_item(p, layer, true, r >> 2, r & 3, lds); }
    } else {
      const int r = item - N_SAMPLE - N_SGU, qb = 63 - r / 48, rr = r % 48, type = rr < 24 ? 1 : 0, bh = rr % 24;
      attn_item(p, layer, type, false, bh / 6, bh % 6, qb, lds, flg);
    }
  }
}

__device__ void run_phase(const Params& p, int ph, unsigned char* lds, unsigned char* ring, volatile LAS int* slot) {
  const bfraw* XB = (const bfraw*)(p.ws + WS_XB);
  if (ph == 0) { phase_prep(p, lds); return; }
  const int layer = (ph - 1) >> 3, sub = (ph - 1) & 7;
  switch (sub) {
    case 0: phase_gemm8<EPI_INPROJ, 9, 1>(p, layer, XB, (const bfraw*)(p.ws + WS_WIN) + (size_t)layer * NIN * D, NIN, D, ring); break;
    case 1: phase_scan(p, layer, lds); break;
    case 2: phase_mix(p, layer, lds, slot); break;
    case 3: if (layer == 0) phase_gemm8<EPI_RESID_IN, 9, 1>(p, layer, (const bfraw*)(p.ws + WS_O), (const bfraw*)(p.ws + WS_WOUT) + (size_t)layer * D * D, D, D, ring);
            else phase_gemm8<EPI_RESID, 9, 1>(p, layer, (const bfraw*)(p.ws + WS_O), (const bfraw*)(p.ws + WS_WOUT) + (size_t)layer * D * D, D, D, ring);
            break;
    case 4: phase_ln(p, p.ln1_g + layer * D, p.ln1_b + layer * D, false); break;
    case 5: phase_gemm8<EPI_UP, 9, 1>(p, layer, XB, (const bfraw*)(p.ws + WS_WUP) + (size_t)layer * DFF * D, DFF, D, ring); break;
    case 6: phase_gemm8<EPI_RESID, 9, 1>(p, layer, (const bfraw*)(p.ws + WS_H), (const bfraw*)(p.ws + WS_WDN) + (size_t)layer * D * DFF, D, DFF, ring); break;
    default: phase_ln(p, p.ln2_g + layer * D, p.ln2_b + layer * D, layer == DEPTH - 1); break;
  }
}

__global__ void __launch_bounds__(512, 2) fwd_kernel(Params p) {
  extern __shared__ __attribute__((aligned(16))) unsigned char smem[];
  unsigned char* lds = smem + LDS_DATA + half_id() * HALF_LDS;
  volatile LAS unsigned* st = (volatile LAS unsigned*)smem;
  volatile LAS int* slot = (volatile LAS int*)(smem + 16);
  if (threadIdx.x == 0) { st[0] = 0u; st[1] = 0u; st[2] = 0u; st[3] = 0u; }
  __syncthreads();
  XcdBarrier xb;
  xb.bar = (unsigned*)(p.ws + WS_CTL); xb.x = 0; xb.st = st;
  if (p.coop) xb = xcd_barrier_post((unsigned*)(p.ws + WS_CTL), st);
  for (int ph = p.ph_lo; ph < p.ph_hi; ++ph) {
    if (ph > p.ph_lo) {
      if (p.pad) cg::this_grid().sync();
      xcd_barrier(xb);
    }
    run_phase(p, ph, lds, smem + LDS_DATA, slot);
  }
}

extern "C" void kernel_launch(void* const* d_in, const int* in_sizes, int n_in, void* d_out, int out_size, void* d_ws, size_t ws_size,
                              hipStream_t stream) {
  static int grid = 0;
  if (grid == 0) {
    if (n_in != 21 || (size_t)out_size != O_END || ws_size < WS_END) {
      fprintf(stderr, "kernel_launch: unexpected shapes: n_in %d out %d (want %zu) ws %zu (want >= %zu)\n", n_in, out_size, (size_t)O_END, ws_size, (size_t)WS_END);
      grid = -1; return;
    }
    int dev = 0, cus = 0, per_cu = 0;
    hipGetDevice(&dev);
    hipDeviceGetAttribute(&cus, hipDeviceAttributeMultiprocessorCount, dev);
    if (hipFuncSetAttribute((const void*)fwd_kernel, hipFuncAttributeMaxDynamicSharedMemorySize, LDS_BYTES) != hipSuccess) {
      fprintf(stderr, "kernel_launch: hipFuncSetAttribute failed\n"); grid = -1; return;
    }
    hipOccupancyMaxActiveBlocksPerMultiprocessor(&per_cu, (const void*)fwd_kernel, 512, LDS_BYTES);
    if (per_cu < 1) { fprintf(stderr, "kernel_launch: occupancy query says %d\n", per_cu); per_cu = 1; }
    if (per_cu > 1) per_cu = 1;
    grid = cus * per_cu;
  }
  if (grid < 0) return;
  hipMemsetAsync((char*)d_ws + WS_CTL, 0, CTL_BYTES, stream);
  Params p{};
  const float** f = (const float**)&p;
  for (int i = 0; i < 21; ++i) f[i] = (const float*)d_in[i];
  p.out = (float*)d_out; p.ws = (unsigned char*)d_ws;
#if MK_MODE == 0
  for (int ph = 0; ph < NPHASE; ++ph) {
    p.ph_lo = ph; p.ph_hi = ph + 1; p.coop = 0; p.pad = 0;
    hipLaunchKernelGGL(fwd_kernel, dim3(grid), dim3(512), LDS_BYTES, stream, p);
  }
#else
  p.ph_lo = 0; p.ph_hi = NPHASE; p.coop = 1; p.pad = 0;
  void* args[] = {&p};
  hipError_t e = hipLaunchCooperativeKernel((const void*)fwd_kernel, dim3(grid), dim3(512), args, LDS_BYTES, stream);
  if (e != hipSuccess) fprintf(stderr, "cooperative launch failed: %s (grid %d)\n", hipGetErrorString(e), grid);
#endif
}
```

```cpp
#include <hip/hip_runtime.h>
#include <hip/hip_cooperative_groups.h>
#include <cstdio>
#include <cstdint>
namespace cg = cooperative_groups;

#ifndef MK_MODE
#define MK_MODE 1
#endif

#define DI __device__ __forceinline__
typedef unsigned short bfraw;
typedef __attribute__((ext_vector_type(8))) short bf16x8;
typedef __attribute__((ext_vector_type(4))) short s16x4;
typedef __attribute__((ext_vector_type(4))) float f32x4;
typedef __attribute__((ext_vector_type(16))) float f32x16;
typedef __attribute__((ext_vector_type(2))) __bf16 bf2_t;
typedef __attribute__((ext_vector_type(2))) float f2_t;
#define LAS __attribute__((address_space(3)))

DI unsigned pack2(float a, float b) { f2_t x = {a, b}; bf2_t y = __builtin_convertvector(x, bf2_t); return __builtin_bit_cast(unsigned, y); }
DI float bf2f(bfraw v) { return __uint_as_float(((unsigned)v) << 16); }
DI int fresh_tid() { int t = threadIdx.x & 255; asm volatile("" : "+v"(t)); return t; }
DI int half_id() { return __builtin_amdgcn_readfirstlane((int)(threadIdx.x >> 8)); }
DI int vblock() { return (int)blockIdx.x * 2 + half_id(); }
DI int vgrid() { return (int)gridDim.x * 2; }
DI float ex2(float x) { return __builtin_amdgcn_exp2f(x); }
DI float lg2(float x) { return __builtin_amdgcn_logf(x); }

constexpr int D = 1024, TP = 16384, TS = 2048, TT = TP + TS, SEQ = 4096, DECB = 32, DECS = 64, PAST = 2048;
constexpr int NIN = 3072, DFF = 4096, DEPTH = 2, QKVW = 2304, DIN = 2822;
constexpr float ALPHA = 1.41421356237309515f;
constexpr float LOG2E = 1.44269504088896341f;
constexpr float LN2 = 0.69314718055994531f;
constexpr float SB_EXIT = -160.f;
constexpr float FOX_EXIT = -160.f;
constexpr int KMAX_WORD = 12288;

constexpr size_t O_YP = 0;
constexpr size_t O_YS = O_YP + (size_t)TP * D;
constexpr size_t O_PFK = O_YS + (size_t)TS * D;
constexpr size_t O_PFV = O_PFK + (size_t)DEPTH * TP * 384;
constexpr size_t O_PFL = O_PFV + (size_t)DEPTH * TP * 384;
constexpr size_t O_PSK = O_PFL + (size_t)DEPTH * TP * 6;
constexpr size_t O_PSV = O_PSK + (size_t)DEPTH * TP * 384;
constexpr size_t O_SFK = O_PSV + (size_t)DEPTH * TP * 384;
constexpr size_t O_SFV = O_SFK + (size_t)DEPTH * TS * 384;
constexpr size_t O_SFL = O_SFV + (size_t)DEPTH * TS * 384;
constexpr size_t O_SSK = O_SFL + (size_t)DEPTH * TS * 6;
constexpr size_t O_SSV = O_SSK + (size_t)DEPTH * TS * 384;
constexpr size_t O_SGV = O_SSV + (size_t)DEPTH * TS * 384;
constexpr size_t O_END = O_SGV + (size_t)DEPTH * TS * 256;

constexpr size_t WS_CTL = 0;
constexpr size_t CTL_BYTES = 65536;
constexpr size_t WS_WIN = WS_CTL + CTL_BYTES;
constexpr size_t WS_WOUT = WS_WIN + (size_t)DEPTH * NIN * D * 2;
constexpr size_t WS_WUP = WS_WOUT + (size_t)DEPTH * D * D * 2;
constexpr size_t WS_WDN = WS_WUP + (size_t)DEPTH * DFF * D * 2;
constexpr size_t WS_XB = WS_WDN + (size_t)DEPTH * D * DFF * 2;
constexpr size_t WS_X32 = WS_XB + (size_t)TT * D * 2;
constexpr size_t WS_Y = WS_X32 + (size_t)TT * D * 4;
constexpr size_t WS_QKV = WS_Y + (size_t)TT * D * 4;
constexpr size_t WS_U = WS_QKV + (size_t)TT * QKVW * 2;
constexpr size_t WS_VG = WS_U + (size_t)TT * 256 * 2;
constexpr size_t WS_LOGF = WS_VG + (size_t)TT * 256 * 4;
constexpr size_t WS_C = WS_LOGF + (size_t)TT * 8 * 4;
constexpr size_t WS_CC = WS_C + (size_t)TT * 8 * 4;
constexpr size_t WS_O = WS_CC + (size_t)DECB * PAST * 8 * 4;
constexpr size_t WS_H = WS_O + (size_t)TT * D * 2;
constexpr size_t WS_END = WS_H + (size_t)TT * DFF * 2;

constexpr int LDS_DATA = 64;
constexpr int ABUF = 128 * 144;
constexpr int HALF_LDS = 69632;
constexpr int LDS_BYTES = LDS_DATA + 2 * HALF_LDS;
constexpr int NPHASE = 1 + 8 * DEPTH;
constexpr int QCTR_WORD = 8192;

struct Params {
  const float *x_prompt, *x_sample, *cfk, *cfv, *cfl, *csk, *csv, *w_in, *b_f, *g_v, *b_v, *w_s, *b_s, *g_mix, *w_out,
      *ln1_g, *ln1_b, *w_up, *w_down, *ln2_g, *ln2_b;
  float* out;
  unsigned char* ws;
  int ph_lo, ph_hi, coop, pad;
};

#define XB_TMO      128
#define XB_XCNT(j)  (256  + 64 * (j))
#define XB_XSUB(j)  (1280 + 64 * (j))
#define XB_XGEN(j)  (2304 + 64 * (j))
#define XB_TOP      3328
#define XB_TOPGEN   3392
#define XCD_BAR_WORDS 3456
#define XB_SPIN_CAP (1u << 22)
DI unsigned xb_ld(unsigned* p) { return __hip_atomic_load(p, __ATOMIC_RELAXED, __HIP_MEMORY_SCOPE_AGENT); }
DI unsigned xb_add(unsigned* p, unsigned v) { return __hip_atomic_fetch_add(p, v, __ATOMIC_RELAXED, __HIP_MEMORY_SCOPE_AGENT); }
DI unsigned xb_xcc_id() { return (unsigned)__builtin_amdgcn_s_getreg((3 << 11) | 20) & 0xFu; }
#define XB_SPIN(cond, bar) do { unsigned _sp = 0; while (cond) { __builtin_amdgcn_s_sleep(1); \
    if ((++_sp & 255u) == 0u) { if (xb_ld(&(bar)[XB_TMO])) break; if (_sp > XB_SPIN_CAP) { atomicAdd(&(bar)[XB_TMO], 1u); break; } } } } while (0)
struct XcdBarrier { unsigned* bar; unsigned x; volatile LAS unsigned* st; };
DI XcdBarrier xcd_barrier_post(unsigned* bar, volatile LAS unsigned* st) {
  XcdBarrier b; b.bar = bar; b.x = xb_xcc_id(); b.st = st;
  if (threadIdx.x == 0) (void)xb_add(&bar[XB_XCNT(b.x)], 1u);
  return b;
}
DI void xcd_barrier_complete(unsigned* bar, unsigned x, unsigned& nloc, unsigned& nx) {
  const unsigned G = gridDim.x * gridDim.y * gridDim.z;
  unsigned sum, cnt, mine, sp = 0u;
  for (;;) {
    sum = 0u; cnt = 0u; mine = 0u;
#pragma unroll
    for (unsigned j = 0; j < 16; ++j) { const unsigned c = xb_ld(&bar[XB_XCNT(j)]); sum += c; cnt += (c > 0u) ? 1u : 0u; mine = (j == x) ? c : mine; }
    if (sum == G) break;
    __builtin_amdgcn_s_sleep(1);
    if ((++sp & 255u) == 0u) { if (xb_ld(&bar[XB_TMO])) break; if (sp > XB_SPIN_CAP) { atomicAdd(&bar[XB_TMO], 1u); break; } }
  }
  nloc = mine > 0u ? mine : 1u; nx = cnt > 0u ? cnt : 1u;
}
DI void xcd_barrier(const XcdBarrier& b) {
  asm volatile("s_waitcnt vmcnt(0)" ::: "memory");
  __syncthreads();
  if (threadIdx.x == 0) {
    unsigned* bar = b.bar;
    __builtin_amdgcn_s_waitcnt(0);
    unsigned nloc = b.st[0], nx = b.st[1];
    if (nloc == 0u) { xcd_barrier_complete(bar, b.x, nloc, nx); b.st[0] = nloc; b.st[1] = nx; }
    const unsigned old = xb_add(&bar[XB_XSUB(b.x)], 1u);
    const unsigned gen = old / nloc;
    if (old + 1u == (gen + 1u) * nloc) {
      __builtin_amdgcn_fence(__ATOMIC_RELEASE, "agent");
      asm volatile("s_waitcnt vmcnt(0)" ::: "memory");
      const unsigned og = xb_add(&bar[XB_TOP], 1u);
      const unsigned tg = og / nx;
      if (og + 1u == (tg + 1u) * nx) xb_add(&bar[XB_TOPGEN], 1u);
      else XB_SPIN(xb_ld(&bar[XB_TOPGEN]) == tg, bar);
      __builtin_amdgcn_fence(__ATOMIC_ACQUIRE, "agent");
      xb_add(&bar[XB_XGEN(b.x)], 1u);
      asm volatile("s_waitcnt vmcnt(0)" ::: "memory");
    } else {
      XB_SPIN(xb_ld(&bar[XB_XGEN(b.x)]) == gen, bar);
      __builtin_amdgcn_fence(__ATOMIC_ACQUIRE, "agent");
      asm volatile("s_waitcnt vmcnt(0)" ::: "memory");
    }
  }
  __syncthreads();
}

DI float gelu_tanh(float x) {
  const float y = 0.7978845608028654f * (x + 0.044715f * x * x * x);
  const float t = 1.f - 2.f / (1.f + __expf(2.f * y));
  return 0.5f * x * (1.f + t);
}
DI float log_sigmoid(float x) { return fminf(x, 0.f) - LN2 * lg2(1.f + ex2(-fabsf(x) * LOG2E)); }
DI float wave_sum(float v) {
#pragma unroll
  for (int o = 32; o > 0; o >>= 1) v += __shfl_xor(v, o);
  return v;
}

DI int win_map(int np) { return np < 1152 ? np : (np < 2304 ? np + 518 : (np < 2816 ? np - 1146 : (np < 2822 ? np - 1664 : -1))); }

__device__ void prep_transpose(const float* __restrict__ src, int srcN, int K, int k0, int n0, bfraw* __restrict__ dst, bool winmap, float* lds) {
  const int tid = fresh_tid(), nn = tid & 63, kr = tid >> 6;
  const int np = n0 + nn;
  const int n = winmap ? win_map(np) : np;
#pragma unroll
  for (int it = 0; it < 16; ++it) {
    const int kk = it * 4 + kr;
    const float v = (n >= 0) ? src[(size_t)(k0 + kk) * srcN + n] : 0.f;
    lds[kk * 65 + nn] = v;
  }
  __syncthreads();
#pragma unroll
  for (int j = 0; j < 2; ++j) {
    const int c = tid + 256 * j, n2 = c >> 3, kc = c & 7;
    const float* s = lds + (kc * 8) * 65 + n2;
    uint4 o;
    o.x = pack2(s[0], s[65]); o.y = pack2(s[130], s[195]); o.z = pack2(s[260], s[325]); o.w = pack2(s[390], s[455]);
    *(uint4*)(dst + (size_t)(n0 + n2) * K + k0 + kc * 8) = o;
  }
  __syncthreads();
}

__device__ void phase_prep(const Params& p, unsigned char* lds) {
  bfraw* WinT = (bfraw*)(p.ws + WS_WIN); bfraw* WoutT = (bfraw*)(p.ws + WS_WOUT);
  bfraw* WupT = (bfraw*)(p.ws + WS_WUP); bfraw* WdnT = (bfraw*)(p.ws + WS_WDN);
  bfraw* XB = (bfraw*)(p.ws + WS_XB);
  constexpr int PER_L = 768 + 256 + 1024 + 1024, NW = DEPTH * PER_L, NX = TT / 16;
  for (int it0 = blockIdx.x * 2; it0 < NW + NX; it0 += vgrid()) {
    const int it = min(it0 + half_id(), NW + NX - 1);
    if (it < NW) {
      const int l = it / PER_L; int r = it % PER_L;
      if (r < 768) prep_transpose(p.w_in + (size_t)l * D * DIN, DIN, D, (r & 15) * 64, (r >> 4) * 64, WinT + (size_t)l * NIN * D, true, (float*)lds);
      else if (r < 1024) { r -= 768; prep_transpose(p.w_out + (size_t)l * D * D, D, D, (r & 15) * 64, (r >> 4) * 64, WoutT + (size_t)l * D * D, false, (float*)lds); }
      else if (r < 2048) { r -= 1024; prep_transpose(p.w_up + (size_t)l * D * DFF, DFF, D, (r & 15) * 64, (r >> 4) * 64, WupT + (size_t)l * DFF * D, false, (float*)lds); }
      else { r -= 2048; prep_transpose(p.w_down + (size_t)l * DFF * D, D, DFF, (r & 63) * 64, (r >> 6) * 64, WdnT + (size_t)l * D * DFF, false, (float*)lds); }
    } else {
      const int tid0 = fresh_tid();
      const int row0 = (it - NW) * 16;
      const float* src = row0 < TP ? p.x_prompt + (size_t)row0 * D : p.x_sample + (size_t)(row0 - TP) * D;
      bfraw* dst = XB + (size_t)row0 * D;
#pragma unroll 4
      for (int i = 0; i < 16; ++i) {
        const int idx = (tid0 + 256 * i) * 4;
        const float4 v = *(const float4*)(src + idx);
        uint2 o; o.x = pack2(v.x, v.y); o.y = pack2(v.z, v.w);
        *(uint2*)(dst + idx) = o;
      }
    }
  }
}

enum { EPI_INPROJ = 0, EPI_RESID = 1, EPI_UP = 2, EPI_RESID_IN = 3 };

template <int EPI, int MI, int NI>
DI void gemm_epilogue(const Params& p, int layer, f32x16 (&acc)[MI][NI], int m0, int rbase, int nc0, int r32, int h, bool from_input) {
  if (EPI == EPI_INPROJ) {
    bfraw* QKV = (bfraw*)(p.ws + WS_QKV);
    if (nc0 < QKVW) {
      const int which = nc0 / 384;
      const float scale = (which == 0 || which == 3) ? 0.125f : 1.f;
      const int colin = nc0 - which * 384;
      const size_t offp = which == 1 ? O_PFK : which == 2 ? O_PFV : which == 4 ? O_PSK : O_PSV;
      const size_t offs = which == 1 ? O_SFK : which == 2 ? O_SFV : which == 4 ? O_SSK : O_SSV;
      const bool has_out = (which == 1 || which == 2 || which == 4 || which == 5);
      float* outP = p.out + offp + (size_t)layer * TP * 384 + colin + r32;
      float* outS = p.out + offs + ((size_t)layer * TS * 384 - (size_t)TP * 384) + colin + r32;
#pragma unroll
      for (int mi = 0; mi < MI; ++mi)
#pragma unroll
        for (int ni = 0; ni < NI; ++ni)
#pragma unroll
          for (int i = 0; i < 16; ++i) {
            const int row = m0 + rbase + mi * 32 + (i & 3) + 8 * (i >> 2) + 4 * h;
            const float v = acc[mi][ni][i];
            QKV[(size_t)row * QKVW + nc0 + ni * 32 + r32] = (bfraw)(pack2(v * scale, 0.f) & 0xffffu);
            if (has_out) { float* ob = row < TP ? outP : outS; ob[(size_t)row * 384 + ni * 32] = v; }
          }
    } else if (nc0 < 2560) {
      bfraw* U = (bfraw*)(p.ws + WS_U);
#pragma unroll
      for (int mi = 0; mi < MI; ++mi)
#pragma unroll
        for (int ni = 0; ni < NI; ++ni)
#pragma unroll
          for (int i = 0; i < 16; ++i) {
            const int rl = rbase + mi * 32 + (i & 3) + 8 * (i >> 2) + 4 * h;
            const int col = ni * 32 + r32;
            U[(size_t)(m0 + rl) * 256 + (nc0 - 2304) + col] = (bfraw)(pack2(gelu_tanh(acc[mi][ni][i]), 0.f) & 0xffffu);
          }
    } else if (nc0 < 2816) {
      float* VG = (float*)(p.ws + WS_VG);
#pragma unroll
      for (int mi = 0; mi < MI; ++mi)
#pragma unroll
        for (int ni = 0; ni < NI; ++ni)
#pragma unroll
          for (int i = 0; i < 16; ++i) {
            const int rl = rbase + mi * 32 + (i & 3) + 8 * (i >> 2) + 4 * h;
            const int col = ni * 32 + r32;
            VG[(size_t)(m0 + rl) * 256 + (nc0 - 2560) + col] = gelu_tanh(acc[mi][ni][i]);
          }
    } else if (nc0 == 2816) {
      if (r32 < 6) {
        float* LOGF = (float*)(p.ws + WS_LOGF);
        float* outP = p.out + O_PFL + (size_t)layer * TP * 6 + r32;
        float* outS = p.out + O_SFL + ((size_t)layer * TS * 6 - (size_t)TP * 6) + r32;
        const float bias = p.b_f[layer * 6 + r32];
#pragma unroll
        for (int mi = 0; mi < MI; ++mi)
#pragma unroll
          for (int i = 0; i < 16; ++i) {
            const int row = m0 + rbase + mi * 32 + (i & 3) + 8 * (i >> 2) + 4 * h;
            const float lf = log_sigmoid(acc[mi][0][i] + bias);
            LOGF[(size_t)row * 8 + r32] = lf;
            float* ob = row < TP ? outP : outS;
            ob[(size_t)row * 6] = lf;
          }
      }
    }
  } else if (EPI == EPI_RESID_IN) {
    unsigned char* Yb = p.ws + WS_Y;
    const float* xp = p.x_prompt + nc0 + r32;
    const float* xs = p.x_sample - (size_t)TP * D + nc0 + r32;
    const unsigned o0 = (unsigned)(((m0 + rbase + 4 * h) * D + nc0 + r32) * 4);
#pragma unroll
    for (int mi = 0; mi < MI; ++mi) {
      float xr[NI][16];
#pragma unroll
      for (int ni = 0; ni < NI; ++ni)
#pragma unroll
        for (int i = 0; i < 16; ++i) {
          const int row = m0 + rbase + 4 * h + mi * 32 + (i & 3) + 8 * (i >> 2);
          xr[ni][i] = (row < TP ? xp : xs)[(size_t)row * D + ni * 32];
        }
#pragma unroll
      for (int ni = 0; ni < NI; ++ni)
#pragma unroll
        for (int i = 0; i < 16; ++i)
          *(float*)(Yb + (o0 + (unsigned)(((mi * 32 + (i & 3) + 8 * (i >> 2)) * D + ni * 32) * 4))) = ALPHA * xr[ni][i] + acc[mi][ni][i];
    }
  } else if (EPI == EPI_RESID) {
    unsigned char* Yb = p.ws + WS_Y;
    const unsigned char* Xb = p.ws + WS_X32;
    const unsigned o0 = (unsigned)(((m0 + rbase + 4 * h) * D + nc0 + r32) * 4);
#pragma unroll
    for (int mi = 0; mi < MI; ++mi) {
      float xr[NI][16];
#pragma unroll
      for (int ni = 0; ni < NI; ++ni)
#pragma unroll
        for (int i = 0; i < 16; ++i)
          xr[ni][i] = *(const float*)(Xb + (o0 + (unsigned)(((mi * 32 + (i & 3) + 8 * (i >> 2)) * D + ni * 32) * 4)));
#pragma unroll
      for (int ni = 0; ni < NI; ++ni)
#pragma unroll
        for (int i = 0; i < 16; ++i)
          *(float*)(Yb + (o0 + (unsigned)(((mi * 32 + (i & 3) + 8 * (i >> 2)) * D + ni * 32) * 4))) = ALPHA * xr[ni][i] + acc[mi][ni][i];
    }
  } else {
    bfraw* H = (bfraw*)(p.ws + WS_H);
#pragma unroll
    for (int mi = 0; mi < MI; ++mi)
#pragma unroll
      for (int ni = 0; ni < NI; ++ni)
#pragma unroll
        for (int i = 0; i < 16; ++i) {
          const int rl = rbase + mi * 32 + (i & 3) + 8 * (i >> 2) + 4 * h;
          const int col = nc0 + ni * 32 + r32;
          const float v = fmaxf(acc[mi][ni][i], 0.f);
          H[(size_t)(m0 + rl) * DFF + col] = (bfraw)(pack2(v * v, 0.f) & 0xffffu);
        }
  }
}

template <int EPI, int MI, int NI>
__device__ void gemm_tile8(const Params& p, int layer, const bfraw* __restrict__ A, const bfraw* __restrict__ Bt, int K, int m0, int n0, unsigned char* ring, bool from_input,
                           bool first, bool has_next, int next_m0, int next_n0) {
  constexpr int WGM = NI == 2 ? 2 : 1, WGN = 8 / WGM;
  constexpr int BM = WGM * MI * 32;
  constexpr int STAGE = (BM + 256) * 128;
  constexpr int NAI = BM / 8;
  constexpr int NA = (NAI + 7) / 8;
  int tid = threadIdx.x; asm volatile("" : "+v"(tid));
  const int lane = tid & 63, wid = tid >> 6, wm = wid / WGN, wn = wid % WGN;
  const int r32 = lane & 31, h = lane >> 5;
  f32x16 acc[MI][NI];
#pragma unroll
  for (int a = 0; a < MI; ++a)
#pragma unroll
    for (int b = 0; b < NI; ++b)
#pragma unroll
      for (int i = 0; i < 16; ++i) acc[a][b][i] = 0.f;
  const int dc = (lane & 7) ^ (((wid & 1) * 4 + (lane >> 4)) & 7);
  const unsigned loff = (unsigned)(((wid * 8 + (lane >> 3)) * K + dc * 8) * 2);
  const unsigned char* ab = (const unsigned char*)(A + (size_t)m0 * K);
  const unsigned char* bb = (const unsigned char*)(Bt + (size_t)n0 * K);
  unsigned char* dl = ring + wid * 1024 + lane * 16;
#define ISSUE8A(ab, kt_, st_) do { \
    _Pragma("unroll") for (int j = 0; j < NA; ++j) { \
      if (NAI % 8 == 0 || j < NA - 1 || wid < NAI % 8) \
        __builtin_amdgcn_global_load_lds((const unsigned*)(ab + ((size_t)j * 64 * K + (kt_) * 64) * 2 + loff), (unsigned*)(dl + (st_) * STAGE + j * 8192), 16, 0, 0); } \
  } while (0)
#define ISSUE8B(bb, kt_, st_) do { \
    _Pragma("unroll") for (int j = 0; j < 4; ++j) \
      __builtin_amdgcn_global_load_lds((const unsigned*)(bb + ((size_t)j * 64 * K + (kt_) * 64) * 2 + loff), (unsigned*)(dl + (st_) * STAGE + BM * 128 + j * 8192), 16, 0, 0); \
  } while (0)
#define ISSUE8(ab, bb, kt_, st_) do { ISSUE8A(ab, kt_, st_); ISSUE8B(bb, kt_, st_); } while (0)
  const int key = (r32 >> 1) & 7;
  const unsigned char* afr = ring + (wm * (MI * 32) + r32) * 128;
  const unsigned char* bfr = ring + BM * 128 + (wn * (NI * 32) + r32) * 128;
  const int nk = K >> 6;
  const unsigned char* abn = (const unsigned char*)(A + (size_t)next_m0 * K);
  const unsigned char* bbn = (const unsigned char*)(Bt + (size_t)next_n0 * K);
  if (first) {
    asm volatile("s_waitcnt vmcnt(0)" ::: "memory");
    __builtin_amdgcn_s_barrier();
    asm volatile("" ::: "memory");
    ISSUE8(ab, bb, 0, 0);
  }
  int st = 0;
  for (int kt = 0; kt < nk; ++kt) {
    asm volatile("s_waitcnt vmcnt(0)" ::: "memory");
    __builtin_amdgcn_s_barrier();
    asm volatile("" ::: "memory");
    if (kt + 1 < nk) ISSUE8A(ab, kt + 1, st ^ 1);
    else if (has_next) ISSUE8A(abn, 0, st ^ 1);
    const unsigned char* as = afr + st * STAGE;
    const unsigned char* bs = bfr + st * STAGE;
#pragma unroll
    for (int ks = 0; ks < 4; ++ks) {
      if (ks == 2) { if (kt + 1 < nk) ISSUE8B(bb, kt + 1, st ^ 1); else if (has_next) ISSUE8B(bbn, 0, st ^ 1); }
      const int o = ((ks * 2 + h) ^ key) * 16;
      bf16x8 af[MI], bq[NI];
#pragma unroll
      for (int mi = 0; mi < MI; ++mi) af[mi] = *(const bf16x8*)(as + mi * 4096 + o);
#pragma unroll
      for (int ni = 0; ni < NI; ++ni) bq[ni] = *(const bf16x8*)(bs + ni * 4096 + o);
#pragma unroll
      for (int mi = 0; mi < MI; ++mi)
#pragma unroll
        for (int ni = 0; ni < NI; ++ni)
          acc[mi][ni] = __builtin_amdgcn_mfma_f32_32x32x16_bf16(af[mi], bq[ni], acc[mi][ni], 0, 0, 0);
    }
    st ^= 1;
  }
#undef ISSUE8
#undef ISSUE8A
#undef ISSUE8B
  gemm_epilogue<EPI, MI, NI>(p, layer, acc, m0, wm * (MI * 32), n0 + wn * (NI * 32), r32, h, from_input);
}

template <int EPI, int MI, int NI>
__device__ void phase_gemm8(const Params& p, int layer, const bfraw* A, const bfraw* Bt, int N, int K, unsigned char* ring, bool from_input = false) {
  constexpr int BM = (NI == 2 ? 2 : 1) * MI * 32;
  const int ntn = N / 256, ntiles = (TT / BM) * ntn;
  for (int t = blockIdx.x; t < ntiles; t += gridDim.x) {
    const int tm = t / ntn, tn = t % ntn;
    const int t2 = t + gridDim.x;
    const bool has_next = t2 < ntiles;
    const int tm2 = has_next ? t2 / ntn : tm, tn2 = has_next ? t2 % ntn : tn;
    gemm_tile8<EPI, MI, NI>(p, layer, A, Bt, K, tm * BM, tn * 256, ring, from_input, t == (int)blockIdx.x, has_next, tm2 * BM, tn2 * 256);
  }
  __syncthreads();
}

__device__ void phase_ln(const Params& p, const float* __restrict__ gam, const float* __restrict__ bet, bool last) {
  const float* Y = (const float*)(p.ws + WS_Y);
  float* X32 = (float*)(p.ws + WS_X32);
  bfraw* XB = (bfraw*)(p.ws + WS_XB);
  const int tid_ = fresh_tid(); const int lane = tid_ & 63, wid = tid_ >> 6;
  for (int row = vblock() * 4 + wid; row < TT; row += vgrid() * 4) {
    const float* y = Y + (size_t)row * D;
    float4 v[4];
#pragma unroll
    for (int j = 0; j < 4; ++j) v[j] = *(const float4*)(y + lane * 4 + 256 * j);
    float s = 0.f;
#pragma unroll
    for (int j = 0; j < 4; ++j) s += v[j].x + v[j].y + v[j].z + v[j].w;
    const float mu = wave_sum(s) * (1.f / D);
    float q = 0.f;
#pragma unroll
    for (int j = 0; j < 4; ++j) { v[j].x -= mu; v[j].y -= mu; v[j].z -= mu; v[j].w -= mu; q += v[j].x * v[j].x + v[j].y * v[j].y + v[j].z * v[j].z + v[j].w * v[j].w; }
    const float rstd = rsqrtf(wave_sum(q) * (1.f / D) + 1e-5f);
#pragma unroll
    for (int j = 0; j < 4; ++j) {
      const int c = lane * 4 + 256 * j;
      const float4 g = *(const float4*)(gam + c), b = *(const float4*)(bet + c);
      float4 o;
      o.x = v[j].x * rstd * g.x + b.x; o.y = v[j].y * rstd * g.y + b.y; o.z = v[j].z * rstd * g.z + b.z; o.w = v[j].w * rstd * g.w + b.w;
      if (last) {
        *(float4*)(p.out + (size_t)row * D + c) = o;
      } else {
        *(float4*)(X32 + (size_t)row * D + c) = o;
        uint2 ob; ob.x = pack2(o.x, o.y); ob.y = pack2(o.z, o.w);
        *(uint2*)(XB + (size_t)row * D + c) = ob;
      }
    }
  }
}

DI float wave_incl_scan(float v, int lane) {
#pragma unroll
  for (int o = 1; o < 64; o <<= 1) { const float t = __shfl_up(v, o); if (lane >= o) v += t; }
  return v;
}
__device__ void phase_scan(const Params& p, int layer, unsigned char* lds) {
  const float* LOGF = (const float*)(p.ws + WS_LOGF);
  float* C = (float*)(p.ws + WS_C);
  float* CC = (float*)(p.ws + WS_CC);
  float* red = (float*)lds;
  const int tid = fresh_tid(), lane = tid & 63, wid = tid >> 6;
  {
    const bfraw* QKV = (const bfraw*)(p.ws + WS_QKV);
    unsigned* kmx = (unsigned*)(p.ws + WS_CTL) + KMAX_WORD + 64 * layer;
    for (int it = vblock(); it < 24 * 16; it += vgrid()) {
      const int bh = it >> 4, b = bh / 6, h = bh % 6, pos = (it & 15) * 256 + tid;
      const uint4* kp = (const uint4*)(QKV + (size_t)(b * SEQ + pos) * QKVW + 384 + h * 64);
      float ss = 0.f;
#pragma unroll
      for (int i = 0; i < 8; ++i) {
        const uint4 u = kp[i];
        const unsigned w[4] = {u.x, u.y, u.z, u.w};
#pragma unroll
        for (int k = 0; k < 4; ++k) { const float a = __uint_as_float(w[k] << 16), c = __uint_as_float(w[k] & 0xffff0000u); ss += a * a + c * c; }
      }
#pragma unroll
      for (int o = 32; o > 0; o >>= 1) ss = fmaxf(ss, __shfl_xor(ss, o));
      if (lane == 0) atomicMax(&kmx[bh], __float_as_uint(ss));
    }
  }
  for (int seq0 = blockIdx.x * 2; seq0 < 24 + 192; seq0 += vgrid()) {
    const int seq = min(seq0 + half_id(), 24 + 192 - 1);
    const bool pr = seq < 24;
    const int s = pr ? seq : seq - 24, b = s / 6, h = s % 6;
    float v[16];
    if (pr) {
      const float* base = LOGF + ((size_t)b * SEQ + tid * 16) * 8 + h;
#pragma unroll
      for (int i = 0; i < 16; ++i) v[i] = base[i * 8];
    } else {
      const float* base = p.cfl + (((size_t)layer * DECB + b) * PAST + tid * 8) * 6 + h;
#pragma unroll
      for (int i = 0; i < 8; ++i) v[i] = base[i * 6];
#pragma unroll
      for (int i = 8; i < 16; ++i) v[i] = 0.f;
    }
#pragma unroll
    for (int i = 1; i < 16; ++i) v[i] += v[i - 1];
    const float tot = v[15];
    const float inc = wave_incl_scan(tot, lane);
    if (lane == 63) red[wid] = inc;
    __syncthreads();
    const float r0 = red[0], r1 = red[1], r2 = red[2], r3 = red[3];
    float off = inc - tot;
    off += (wid > 0 ? r0 : 0.f) + (wid > 1 ? r1 : 0.f) + (wid > 2 ? r2 : 0.f);
    if (pr) {
      float* dst = C + ((size_t)b * SEQ + tid * 16) * 8 + h;
#pragma unroll
      for (int i = 0; i < 16; ++i) dst[i * 8] = off + v[i];
    } else {
      float* dst = CC + ((size_t)b * PAST + tid * 8) * 8 + h;
#pragma unroll
      for (int i = 0; i < 8; ++i) dst[i * 8] = off + v[i];
      if (wid == 0) {
        const size_t idx = ((size_t)TP + b * DECS + lane) * 8 + h;
        C[idx] = ((r0 + r1) + (r2 + r3)) + wave_incl_scan(LOGF[idx], lane);
      }
    }
    __syncthreads();
  }
}

__device__ void attn_item(const Params& p, int layer, int type, bool sample, int b, int h, int qb, unsigned char* lds, volatile LAS int* flg) {
  const bfraw* QKV = (const bfraw*)(p.ws + WS_QKV);
  const float* C = (const float*)(p.ws + WS_C);
  const float* CC = (const float*)(p.ws + WS_CC);
  bfraw* O = (bfraw*)(p.ws + WS_O);
  const int tid = fresh_tid(), lane = tid & 63, wid = tid >> 6, l15 = lane & 15, g = lane >> 4;
  const int qrow0 = sample ? TP + b * DECS : b * SEQ + qb * 64;
  const int ntiles = sample ? 33 : qb + 1;
  const int qoff = type ? 1152 : 0, koff = qoff + 384, voff = qoff + 768, hc = h * 64;
  const int qrow = qrow0 + wid * 16 + l15;
  const bfraw* qp = QKV + (size_t)qrow * QKVW + qoff + hc + g * 8;
  const bf16x8 q0 = *(const bf16x8*)qp, q1 = *(const bf16x8*)(qp + 32);
  float cq2 = 0.f;
  if (type == 0) cq2 = C[(size_t)qrow * 8 + h] * LOG2E;
  const bool fexit = (type == 0) && !sample;
  float bqk = 0.f, cnext = 0.f;
  if (fexit) {
    float qs = 0.f;
#pragma unroll
    for (int i = 0; i < 8; ++i) { const float a = bf2f((bfraw)q0[i]), c = bf2f((bfraw)q1[i]); qs += a * a + c * c; }
    qs += __shfl_xor(qs, 16); qs += __shfl_xor(qs, 32);
    const float kmax2 = __uint_as_float(((const unsigned*)(p.ws + WS_CTL))[KMAX_WORD + 64 * layer + b * 6 + h]);
    bqk = sqrtf(qs * kmax2) * (LOG2E * 1.01f) + 1.f;
  }
  const float* kcache = type ? p.csk : p.cfk;
  const float* vcache = type ? p.csv : p.cfv;

  float4 st[8]; float stc = 0.f;
  const int key_l = tid >> 3, dc = tid & 7;
  unsigned char* kd = lds + key_l * 144 + dc * 16;
  unsigned char* vd = kd + 9216;
  float* ckl = (float*)(lds + 18432);

#define ATTN_PREFETCH(t_)                                                                                         \
  do {                                                                                                            \
    const int tt_ = (t_);                                                                                         \
    if (!(sample && tt_ < 32)) {                                                                                  \
      const int krow = sample ? TP + b * DECS : b * SEQ + tt_ * 64;                                               \
      const bfraw* kp = QKV + (size_t)(krow + key_l) * QKVW + hc + dc * 8;                                        \
      st[0] = *(const float4*)(kp + koff); st[1] = *(const float4*)(kp + koff + 32 * QKVW);                       \
      st[2] = *(const float4*)(kp + voff); st[3] = *(const float4*)(kp + voff + 32 * QKVW);                       \
      if (type == 0 && tid < 64) stc = C[(size_t)(krow + tid) * 8 + h];                                           \
    } else {                                                                                                      \
      const size_t off = ((((size_t)layer * DECB + b) * PAST + tt_ * 64 + key_l) * 6 + h) * 64 + dc * 8;          \
      const float* kc = kcache + off; const float* vc = vcache + off;                                             \
      st[0] = *(const float4*)kc; st[1] = *(const float4*)(kc + 4);                                               \
      st[2] = *(const float4*)(kc + 32 * 384); st[3] = *(const float4*)(kc + 32 * 384 + 4);                       \
      st[4] = *(const float4*)vc; st[5] = *(const float4*)(vc + 4);                                               \
      st[6] = *(const float4*)(vc + 32 * 384); st[7] = *(const float4*)(vc + 32 * 384 + 4);                       \
      if (type == 0 && tid < 64) stc = CC[((size_t)b * PAST + tt_ * 64 + tid) * 8 + h];                           \
    }                                                                                                             \
  } while (0)

  f32x4 oacc[4];
#pragma unroll
  for (int i = 0; i < 4; ++i) oacc[i] = (f32x4){0.f, 0.f, 0.f, 0.f};
  float m = -1e30f, lsum = 0.f, R = 0.f;
  const int ql = wid * 16 + l15;
  const int i16 = l15, qq = i16 >> 2, pp = i16 & 3;
  const unsigned char* vtr = lds + 9216 + (4 * g + qq) * 144 + pp * 8;

  ATTN_PREFETCH(ntiles - 1);
  for (int t = ntiles - 1; t >= 0; --t) {
    if (!(sample && t < 32)) {
      *(float4*)kd = st[0]; *(float4*)(kd + 32 * 144) = st[1]; *(float4*)vd = st[2]; *(float4*)(vd + 32 * 144) = st[3];
    } else {
      uint4 a;
      a.x = pack2(st[0].x, st[0].y); a.y = pack2(st[0].z, st[0].w); a.z = pack2(st[1].x, st[1].y); a.w = pack2(st[1].z, st[1].w); *(uint4*)kd = a;
      a.x = pack2(st[2].x, st[2].y); a.y = pack2(st[2].z, st[2].w); a.z = pack2(st[3].x, st[3].y); a.w = pack2(st[3].z, st[3].w); *(uint4*)(kd + 32 * 144) = a;
      a.x = pack2(st[4].x, st[4].y); a.y = pack2(st[4].z, st[4].w); a.z = pack2(st[5].x, st[5].y); a.w = pack2(st[5].z, st[5].w); *(uint4*)vd = a;
      a.x = pack2(st[6].x, st[6].y); a.y = pack2(st[6].z, st[6].w); a.z = pack2(st[7].x, st[7].y); a.w = pack2(st[7].z, st[7].w); *(uint4*)(vd + 32 * 144) = a;
    }
    if (type == 0 && tid < 64) ckl[tid] = stc * LOG2E;
    __syncthreads();
    if (t > 0) ATTN_PREFETCH(t - 1);
    if (fexit && t > 0) cnext = C[(size_t)(b * SEQ + (t - 1) * 64 + 63) * 8 + h];
    const bool diag = (t == ntiles - 1);

    f32x4 s[4];
#pragma unroll
    for (int kb = 0; kb < 4; ++kb) {
      const unsigned char* ka = lds + (kb * 16 + l15) * 144 + g * 16;
      const bf16x8 a0 = *(const bf16x8*)ka, a1 = *(const bf16x8*)(ka + 64);
      f32x4 z = (f32x4){0.f, 0.f, 0.f, 0.f};
      z = __builtin_amdgcn_mfma_f32_16x16x32_bf16(a0, q0, z, 0, 0, 0);
      s[kb] = __builtin_amdgcn_mfma_f32_16x16x32_bf16(a1, q1, z, 0, 0, 0);
    }
    unsigned pk[8];
    if (type == 0) {
      float mx = -1e30f;
#pragma unroll
      for (int kb = 0; kb < 4; ++kb) {
        const f32x4 ck = *(const f32x4*)(ckl + kb * 16 + 4 * g);
#pragma unroll
        for (int j = 0; j < 4; ++j) {
          float x = s[kb][j] * LOG2E + cq2 - ck[j];
          if (diag && (kb * 16 + 4 * g + j > ql)) x = -1e30f;
          s[kb][j] = x; mx = fmaxf(mx, x);
        }
      }
      mx = fmaxf(mx, __shfl_xor(mx, 16)); mx = fmaxf(mx, __shfl_xor(mx, 32));
      const float mnew = fmaxf(m, mx);
      const float alpha = ex2(m - mnew);
      m = mnew;
      float ps = 0.f;
#pragma unroll
      for (int kb = 0; kb < 4; ++kb) {
        const float p0 = ex2(s[kb][0] - mnew), p1 = ex2(s[kb][1] - mnew), p2 = ex2(s[kb][2] - mnew), p3 = ex2(s[kb][3] - mnew);
        ps += (p0 + p1) + (p2 + p3);
        pk[kb * 2] = pack2(p0, p1); pk[kb * 2 + 1] = pack2(p2, p3);
      }
      lsum = lsum * alpha + ps;
#pragma unroll
      for (int db = 0; db < 4; ++db) oacc[db] *= alpha;
    } else {
      float lr[4][4];
#pragma unroll
      for (int kb = 0; kb < 4; ++kb)
#pragma unroll
        for (int j = 0; j < 4; ++j) {
          const float z2 = s[kb][j] * LOG2E;
          const float e = ex2(-fabsf(z2));
          float l = -(fmaxf(z2, 0.f) + lg2(1.f + e));
          if (diag && !(kb * 16 + 4 * g + j < ql)) l = 0.f;
          s[kb][j] = z2; lr[kb][j] = l;
        }
#pragma unroll
      for (int kb = 3; kb >= 0; --kb) {
        const float G = (lr[kb][0] + lr[kb][1]) + (lr[kb][2] + lr[kb][3]);
        const float a = __shfl_xor(G, 16), bb = __shfl_xor(G, 32), c = __shfl_xor(G, 48);
        const float tot = (G + a) + (bb + c);
        const float gt = ((g == 0 || g == 2) ? a : 0.f) + ((g < 2) ? (bb + c) : 0.f);
        const float a3 = R + gt, a2 = a3 + lr[kb][3], a1 = a2 + lr[kb][2], a0 = a1 + lr[kb][1];
        float p0 = ex2(s[kb][0] + lr[kb][0] + a0), p1 = ex2(s[kb][1] + lr[kb][1] + a1);
        float p2 = ex2(s[kb][2] + lr[kb][2] + a2), p3 = ex2(s[kb][3] + lr[kb][3] + a3);
        if (diag) {
          const int k0 = kb * 16 + 4 * g;
          if (!(k0 < ql)) p0 = 0.f;
          if (!(k0 + 1 < ql)) p1 = 0.f;
          if (!(k0 + 2 < ql)) p2 = 0.f;
          if (!(k0 + 3 < ql)) p3 = 0.f;
        }
        pk[kb * 2] = pack2(p0, p1); pk[kb * 2 + 1] = pack2(p2, p3);
        R += tot;
      }
      const int alldone = __all(R < SB_EXIT) ? 1 : 0;
      if (lane == 0) flg[half_id() * 4 + wid] = alldone;
    }
    if (fexit) {
      const int done = (t > 0 && __all(bqk + cq2 - cnext * LOG2E - m < FOX_EXIT)) ? 1 : 0;
      if (lane == 0) flg[half_id() * 4 + wid] = done;
    }
#pragma unroll
    for (int kk = 0; kk < 2; ++kk) {
      const uint4 pu = {pk[kk * 4], pk[kk * 4 + 1], pk[kk * 4 + 2], pk[kk * 4 + 3]};
      const bf16x8 pf = __builtin_bit_cast(bf16x8, pu);
#pragma unroll
      for (int db = 0; db < 4; ++db) {
        const unsigned char* va = vtr + (32 * kk) * 144 + db * 32;
        const s16x4 lo = __builtin_amdgcn_ds_read_tr16_b64_v4i16((LAS s16x4*)(va));
        const s16x4 hi = __builtin_amdgcn_ds_read_tr16_b64_v4i16((LAS s16x4*)(va + 16 * 144));
        const bf16x8 vf = __builtin_shufflevector(lo, hi, 0, 1, 2, 3, 4, 5, 6, 7);
        oacc[db] = __builtin_amdgcn_mfma_f32_16x16x32_bf16(vf, pf, oacc[db], 0, 0, 0);
      }
    }
    __syncthreads();
    if (type == 1 || fexit) { if (flg[0] & flg[1] & flg[2] & flg[3] & flg[4] & flg[5] & flg[6] & flg[7]) break; }
  }
#undef ATTN_PREFETCH
  if (type == 0) {
    lsum += __shfl_xor(lsum, 16); lsum += __shfl_xor(lsum, 32);
    const float inv = 1.f / lsum;
#pragma unroll
    for (int db = 0; db < 4; ++db) oacc[db] *= inv;
  }
  float ss = 0.f;
#pragma unroll
  for (int db = 0; db < 4; ++db)
#pragma unroll
    for (int j = 0; j < 4; ++j) ss += oacc[db][j] * oacc[db][j];
  ss += __shfl_xor(ss, 16); ss += __shfl_xor(ss, 32);
  const float rs = rsqrtf(ss * (1.f / 64.f) + 1e-6f);
  const int hoff = type ? 640 + hc : hc;
#pragma unroll
  for (int db = 0; db < 4; ++db) {
    const int d0 = 16 * db + 4 * g;
    const float4 gm = *(const float4*)(p.g_mix + layer * D + hoff + d0);
    uint2 o;
    o.x = pack2(oacc[db][0] * rs * gm.x, oacc[db][1] * rs * gm.y);
    o.y = pack2(oacc[db][2] * rs * gm.z, oacc[db][3] * rs * gm.w);
    *(uint2*)(O + (size_t)qrow * D + hoff + d0) = o;
  }
}

__device__ void sgu_item(const Params& p, int layer, bool sample, int ci, int g, unsigned char* lds) {
  const float* VG = (const float*)(p.ws + WS_VG);
  const bfraw* U = (const bfraw*)(p.ws + WS_U);
  bfraw* O = (bfraw*)(p.ws + WS_O);
  constexpr int LROW = 272;
  unsigned char* Wl = lds;
  unsigned char* Vt = lds + 128 * LROW;
  const int tid = fresh_tid(), lane = tid & 63, wid = tid >> 6;
  const int r0 = sample ? TP + ci * DECS : ci * 128;
  const int L = sample ? 64 : 128;
  {
    const float4 gv = *(const float4*)(p.g_v + layer * 256 + lane * 4), bv = *(const float4*)(p.b_v + layer * 256 + lane * 4);
    for (int i = wid; i < L; i += 4) {
      float4 v = *(const float4*)(VG + (size_t)(r0 + i) * 256 + lane * 4);
      const float mu = wave_sum(v.x + v.y + v.z + v.w) * (1.f / 256.f);
      v.x -= mu; v.y -= mu; v.z -= mu; v.w -= mu;
      const float rstd = rsqrtf(wave_sum(v.x * v.x + v.y * v.y + v.z * v.z + v.w * v.w) * (1.f / 256.f) + 1e-5f);
      float4 o;
      o.x = v.x * rstd * gv.x + bv.x; o.y = v.y * rstd * gv.y + bv.y; o.z = v.z * rstd * gv.z + bv.z; o.w = v.w * rstd * gv.w + bv.w;
      if ((lane >> 4) == g) {
        const unsigned lo = pack2(o.x, o.y), hi = pack2(o.z, o.w);
        unsigned char* vp = Vt + ((lane & 15) * 4) * LROW + i * 2;
        *(bfraw*)(vp) = (bfraw)(lo & 0xffffu); *(bfraw*)(vp + LROW) = (bfraw)(lo >> 16);
        *(bfraw*)(vp + 2 * LROW) = (bfraw)(hi & 0xffffu); *(bfraw*)(vp + 3 * LROW) = (bfraw)(hi >> 16);
        if (sample) *(float4*)(p.out + O_SGV + ((size_t)layer * TS + (r0 - TP) + i) * 256 + lane * 4) = o;
      }
    }
    const float* wg = p.w_s + ((size_t)layer * 4 + g) * 128 * 128;
#pragma unroll 4
    for (int k = 0; k < 16; ++k) {
      const int idx = tid + 256 * k, row = idx >> 5, c4 = (idx & 31) * 4;
      if (row < L) {
        const float4 w = *(const float4*)(wg + row * 128 + c4);
        uint2 o;
        o.x = pack2(c4 <= row ? w.x : 0.f, c4 + 1 <= row ? w.y : 0.f);
        o.y = pack2(c4 + 2 <= row ? w.z : 0.f, c4 + 3 <= row ? w.w : 0.f);
        *(uint2*)(Wl + row * LROW + c4 * 2) = o;
      }
    }
  }
  __syncthreads();
  if (wid * 32 < L) {
    const int r32 = lane & 31, h = lane >> 5;
    f32x16 acc[2];
#pragma unroll
    for (int ni = 0; ni < 2; ++ni)
#pragma unroll
      for (int i = 0; i < 16; ++i) acc[ni][i] = 0.f;
    const unsigned char* ap = Wl + (wid * 32 + r32) * LROW + h * 16;
    const unsigned char* bp = Vt + r32 * LROW + h * 16;
    const int nks = min(L / 16, 2 * (wid + 1));
    for (int ks = 0; ks < nks; ++ks) {
      const bf16x8 a = *(const bf16x8*)(ap + ks * 32);
      const bf16x8 b0 = *(const bf16x8*)(bp + ks * 32), b1 = *(const bf16x8*)(bp + 32 * LROW + ks * 32);
      acc[0] = __builtin_amdgcn_mfma_f32_32x32x16_bf16(a, b0, acc[0], 0, 0, 0);
      acc[1] = __builtin_amdgcn_mfma_f32_32x32x16_bf16(a, b1, acc[1], 0, 0, 0);
    }
    const float* bsp = p.b_s + ((size_t)layer * 4 + g) * 128 + wid * 32 + 4 * h;
    const float* gm = p.g_mix + layer * D + 384 + g * 64 + r32;
    const float gm0 = gm[0], gm1 = gm[32];
    const size_t rowb = (size_t)(r0 + wid * 32 + 4 * h);
#pragma unroll
    for (int i = 0; i < 16; ++i) {
      const int rl = (i & 3) + 8 * (i >> 2);
      const float bs = bsp[rl];
      const bfraw* up = U + (rowb + rl) * 256 + g * 64 + r32;
      const float o0 = bf2f(up[0]) * (acc[0][i] + bs), o1 = bf2f(up[32]) * (acc[1][i] + bs);
      float ss = o0 * o0 + o1 * o1;
      ss += __shfl_xor(ss, 1); ss += __shfl_xor(ss, 2); ss += __shfl_xor(ss, 4); ss += __shfl_xor(ss, 8); ss += __shfl_xor(ss, 16);
      const float rs = rsqrtf(ss * (1.f / 64.f) + 1e-6f);
      bfraw* op = O + (rowb + rl) * D + 384 + g * 64 + r32;
      op[0] = (bfraw)(pack2(o0 * rs * gm0, 0.f) & 0xffffu);
      op[32] = (bfraw)(pack2(o1 * rs * gm1, 0.f) & 0xffffu);
    }
  }
  __syncthreads();
}

__device__ void phase_mix(const Params& p, int layer, unsigned char* lds, volatile LAS int* slot) {
  unsigned* ctr = (unsigned*)(p.ws + WS_CTL) + QCTR_WORD + 64 * layer;
  volatile LAS int* flg = slot + 4;
  constexpr int N_SAMPLE = 384, N_PROMPT = 3072, N_SGU = 640, N_ALL = N_SAMPLE + N_PROMPT + N_SGU;
  for (;;) {
    if (threadIdx.x == 0) *slot = (int)atomicAdd(ctr, 1u);
    __syncthreads();
    const int item = *slot * 2 + half_id();
    __syncthreads();
    if (item >= N_ALL) break;
    if (item < N_SAMPLE) {
      const int type = item < 192 ? 1 : 0, r = item % 192;
      attn_item(p, layer, type, true, r / 6, r % 6, 0, lds, flg);
    } else if (item < N_SAMPLE + N_SGU) {
      int r = item - N_SAMPLE;
      if (r < 512) sgu_item(p, layer, false, r >> 2, r & 3, lds);
      else { r -= 512; sgu_item(p, layer, true, r >> 2, r & 3, lds); }
    } else {
      const int r = item - N_SAMPLE - N_SGU, type = r < 1536 ? 0 : 1, r2 = r % 1536, qb = 63 - r2 / 24, bh = r2 % 24;
      attn_item(p, layer, type, false, bh / 6, bh % 6, qb, lds, flg);
    }
  }
}

__device__ void run_phase(const Params& p, int ph, unsigned char* lds, unsigned char* ring, volatile LAS int* slot) {
  const bfraw* XB = (const bfraw*)(p.ws + WS_XB);
  if (ph == 0) { phase_prep(p, lds); return; }
  const int layer = (ph - 1) >> 3, sub = (ph - 1) & 7;
  switch (sub) {
    case 0: phase_gemm8<EPI_INPROJ, 9, 1>(p, layer, XB, (const bfraw*)(p.ws + WS_WIN) + (size_t)layer * NIN * D, NIN, D, ring); break;
    case 1: phase_scan(p, layer, lds); break;
    case 2: phase_mix(p, layer, lds, slot); break;
    case 3: if (layer == 0) phase_gemm8<EPI_RESID_IN, 9, 1>(p, layer, (const bfraw*)(p.ws + WS_O), (const bfraw*)(p.ws + WS_WOUT) + (size_t)layer * D * D, D, D, ring);
            else phase_gemm8<EPI_RESID, 9, 1>(p, layer, (const bfraw*)(p.ws + WS_O), (const bfraw*)(p.ws + WS_WOUT) + (size_t)layer * D * D, D, D, ring);
            break;
    case 4: phase_ln(p, p.ln1_g + layer * D, p.ln1_b + layer * D, false); break;
    case 5: phase_gemm8<EPI_UP, 9, 1>(p, layer, XB, (const bfraw*)(p.ws + WS_WUP) + (size_t)layer * DFF * D, DFF, D, ring); break;
    case 6: phase_gemm8<EPI_RESID, 9, 1>(p, layer, (const bfraw*)(p.ws + WS_H), (const bfraw*)(p.ws + WS_WDN) + (size_t)layer * D * DFF, D, DFF, ring); break;
    default: phase_ln(p, p.ln2_g + layer * D, p.ln2_b + layer * D, layer == DEPTH - 1); break;
  }
}

__global__ void __launch_bounds__(512, 2) fwd_kernel(Params p) {
  extern __shared__ __attribute__((aligned(16))) unsigned char smem[];
  unsigned char* lds = smem + LDS_DATA + half_id() * HALF_LDS;
  volatile LAS unsigned* st = (volatile LAS unsigned*)smem;
  volatile LAS int* slot = (volatile LAS int*)(smem + 16);
  if (threadIdx.x == 0) { st[0] = 0u; st[1] = 0u; st[2] = 0u; st[3] = 0u; }
  __syncthreads();
  XcdBarrier xb;
  xb.bar = (unsigned*)(p.ws + WS_CTL); xb.x = 0; xb.st = st;
  if (p.coop) xb = xcd_barrier_post((unsigned*)(p.ws + WS_CTL), st);
  for (int ph = p.ph_lo; ph < p.ph_hi; ++ph) {
    if (ph > p.ph_lo) {
      if (p.pad) cg::this_grid().sync();
      xcd_barrier(xb);
    }
    run_phase(p, ph, lds, smem + LDS_DATA, slot);
  }
}

extern "C" void kernel_launch(void* const* d_in, const int* in_sizes, int n_in, void* d_out, int out_size, void* d_ws, size_t ws_size,
                              hipStream_t stream) {
  static int grid = 0;
  if (grid == 0) {
    if (n_in != 21 || (size_t)out_size != O_END || ws_size < WS_END) {
      fprintf(stderr, "kernel_launch: unexpected shapes: n_in %d out %d (want %zu) ws %zu (want >= %zu)\n", n_in, out_size, (size_t)O_END, ws_size, (size_t)WS_END);
      grid = -1; return;
    }
    int dev = 0, cus = 0, per_cu = 0;
    hipGetDevice(&dev);
    hipDeviceGetAttribute(&cus, hipDeviceAttributeMultiprocessorCount, dev);
    if (hipFuncSetAttribute((const void*)fwd_kernel, hipFuncAttributeMaxDynamicSharedMemorySize, LDS_BYTES) != hipSuccess) {
      fprintf(stderr, "kernel_launch: hipFuncSetAttribute failed\n"); grid = -1; return;
    }
    hipOccupancyMaxActiveBlocksPerMultiprocessor(&per_cu, (const void*)fwd_kernel, 512, LDS_BYTES);
    if (per_cu < 1) { fprintf(stderr, "kernel_launch: occupancy query says %d\n", per_cu); per_cu = 1; }
    if (per_cu > 1) per_cu = 1;
    grid = cus * per_cu;
  }
  if (grid < 0) return;
  hipMemsetAsync((char*)d_ws + WS_CTL, 0, CTL_BYTES, stream);
  Params p{};
  const float** f = (const float**)&p;
  for (int i = 0; i < 21; ++i) f[i] = (const float*)d_in[i];
  p.out = (float*)d_out; p.ws = (unsigned char*)d_ws;
#if MK_MODE == 0
  for (int ph = 0; ph < NPHASE; ++ph) {
    p.ph_lo = ph; p.ph_hi = ph + 1; p.coop = 0; p.pad = 0;
    hipLaunchKernelGGL(fwd_kernel, dim3(grid), dim3(512), LDS_BYTES, stream, p);
  }
#else
  p.ph_lo = 0; p.ph_hi = NPHASE; p.coop = 1; p.pad = 0;
  void* args[] = {&p};
  hipError_t e = hipLaunchCooperativeKernel((const void*)fwd_kernel, dim3(grid), dim3(512), args, LDS_BYTES, stream);
  if (e != hipSuccess) fprintf(stderr, "cooperative launch failed: %s (grid %d)\n", hipGetErrorString(e), grid);
#endif
}
```

```cpp
#include <hip/hip_runtime.h>
#include <hip/hip_cooperative_groups.h>
#include <cstdio>
#include <cstdint>
namespace cg = cooperative_groups;

#ifndef MK_MODE
#define MK_MODE 1
#endif

#define DI __device__ __forceinline__
typedef unsigned short bfraw;
typedef __attribute__((ext_vector_type(8))) short bf16x8;
typedef __attribute__((ext_vector_type(4))) short s16x4;
typedef __attribute__((ext_vector_type(4))) float f32x4;
typedef __attribute__((ext_vector_type(16))) float f32x16;
typedef __attribute__((ext_vector_type(2))) __bf16 bf2_t;
typedef __attribute__((ext_vector_type(2))) float f2_t;
#define LAS __attribute__((address_space(3)))

DI unsigned pack2(float a, float b) { f2_t x = {a, b}; bf2_t y = __builtin_convertvector(x, bf2_t); return __builtin_bit_cast(unsigned, y); }
DI float bf2f(bfraw v) { return __uint_as_float(((unsigned)v) << 16); }
DI int fresh_tid() { int t = threadIdx.x & 255; asm volatile("" : "+v"(t)); return t; }
DI int half_id() { return __builtin_amdgcn_readfirstlane((int)(threadIdx.x >> 8)); }
DI int vblock() { return (int)blockIdx.x * 2 + half_id(); }
DI int vgrid() { return (int)gridDim.x * 2; }
DI float4 ntld4(const float* p) { const f32x4 v = __builtin_nontemporal_load((const f32x4*)p); return make_float4(v[0], v[1], v[2], v[3]); }
#define NTLD(p_) ntld4((const float*)(p_))
DI float ex2(float x) { return __builtin_amdgcn_exp2f(x); }
DI float lg2(float x) { return __builtin_amdgcn_logf(x); }

constexpr int D = 1024, TP = 16384, TS = 2048, TT = TP + TS, SEQ = 4096, DECB = 32, DECS = 64, PAST = 2048;
constexpr int NIN = 3072, DFF = 4096, DEPTH = 2, QKVW = 2304, DIN = 2822;
constexpr float ALPHA = 1.41421356237309515f;
constexpr float LOG2E = 1.44269504088896341f;
constexpr float LN2 = 0.69314718055994531f;
constexpr float SB_EXIT = -160.f;
constexpr float FOX_EXIT = -160.f;
constexpr int KMAX_WORD = 12288;

constexpr size_t O_YP = 0;
constexpr size_t O_YS = O_YP + (size_t)TP * D;
constexpr size_t O_PFK = O_YS + (size_t)TS * D;
constexpr size_t O_PFV = O_PFK + (size_t)DEPTH * TP * 384;
constexpr size_t O_PFL = O_PFV + (size_t)DEPTH * TP * 384;
constexpr size_t O_PSK = O_PFL + (size_t)DEPTH * TP * 6;
constexpr size_t O_PSV = O_PSK + (size_t)DEPTH * TP * 384;
constexpr size_t O_SFK = O_PSV + (size_t)DEPTH * TP * 384;
constexpr size_t O_SFV = O_SFK + (size_t)DEPTH * TS * 384;
constexpr size_t O_SFL = O_SFV + (size_t)DEPTH * TS * 384;
constexpr size_t O_SSK = O_SFL + (size_t)DEPTH * TS * 6;
constexpr size_t O_SSV = O_SSK + (size_t)DEPTH * TS * 384;
constexpr size_t O_SGV = O_SSV + (size_t)DEPTH * TS * 384;
constexpr size_t O_END = O_SGV + (size_t)DEPTH * TS * 256;

constexpr size_t WS_CTL = 0;
constexpr size_t CTL_BYTES = 65536;
constexpr size_t WS_WIN = WS_CTL + CTL_BYTES;
constexpr size_t WS_WOUT = WS_WIN + (size_t)DEPTH * NIN * D * 2;
constexpr size_t WS_WUP = WS_WOUT + (size_t)DEPTH * D * D * 2;
constexpr size_t WS_WDN = WS_WUP + (size_t)DEPTH * DFF * D * 2;
constexpr size_t WS_XB = WS_WDN + (size_t)DEPTH * D * DFF * 2;
constexpr size_t WS_X32 = WS_XB + (size_t)TT * D * 2;
constexpr size_t WS_Y = WS_X32 + (size_t)TT * D * 4;
constexpr size_t WS_QKV = WS_Y + (size_t)TT * D * 4;
constexpr size_t WS_U = WS_QKV + (size_t)TT * QKVW * 2;
constexpr size_t WS_VG = WS_U + (size_t)TT * 256 * 2;
constexpr size_t WS_LOGF = WS_VG + (size_t)TT * 256 * 4;
constexpr size_t WS_C = WS_LOGF + (size_t)TT * 8 * 4;
constexpr size_t WS_CC = WS_C + (size_t)TT * 8 * 4;
constexpr size_t WS_O = WS_CC + (size_t)DECB * PAST * 8 * 4;
constexpr size_t WS_H = WS_O + (size_t)TT * D * 2;
constexpr size_t WS_END = WS_H + (size_t)TT * DFF * 2;

constexpr int LDS_DATA = 64;
constexpr int ABUF = 128 * 144;
constexpr int HALF_LDS = 69632;
constexpr int LDS_BYTES = LDS_DATA + 2 * HALF_LDS;
constexpr int NPHASE = 1 + 8 * DEPTH;
constexpr int QCTR_WORD = 8192;

struct Params {
  const float *x_prompt, *x_sample, *cfk, *cfv, *cfl, *csk, *csv, *w_in, *b_f, *g_v, *b_v, *w_s, *b_s, *g_mix, *w_out,
      *ln1_g, *ln1_b, *w_up, *w_down, *ln2_g, *ln2_b;
  float* out;
  unsigned char* ws;
  int ph_lo, ph_hi, coop, pad;
};

#define XB_TMO      128
#define XB_XCNT(j)  (256  + 64 * (j))
#define XB_XSUB(j)  (1280 + 64 * (j))
#define XB_XGEN(j)  (2304 + 64 * (j))
#define XB_TOP      3328
#define XB_TOPGEN   3392
#define XCD_BAR_WORDS 3456
#define XB_SPIN_CAP (1u << 22)
DI unsigned xb_ld(unsigned* p) { return __hip_atomic_load(p, __ATOMIC_RELAXED, __HIP_MEMORY_SCOPE_AGENT); }
DI unsigned xb_add(unsigned* p, unsigned v) { return __hip_atomic_fetch_add(p, v, __ATOMIC_RELAXED, __HIP_MEMORY_SCOPE_AGENT); }
DI unsigned xb_xcc_id() { return (unsigned)__builtin_amdgcn_s_getreg((3 << 11) | 20) & 0xFu; }
#define XB_SPIN(cond, bar) do { unsigned _sp = 0; while (cond) { __builtin_amdgcn_s_sleep(1); \
    if ((++_sp & 255u) == 0u) { if (xb_ld(&(bar)[XB_TMO])) break; if (_sp > XB_SPIN_CAP) { atomicAdd(&(bar)[XB_TMO], 1u); break; } } } } while (0)
struct XcdBarrier { unsigned* bar; unsigned x; volatile LAS unsigned* st; };
DI XcdBarrier xcd_barrier_post(unsigned* bar, volatile LAS unsigned* st) {
  XcdBarrier b; b.bar = bar; b.x = xb_xcc_id(); b.st = st;
  if (threadIdx.x == 0) (void)xb_add(&bar[XB_XCNT(b.x)], 1u);
  return b;
}
DI void xcd_barrier_complete(unsigned* bar, unsigned x, unsigned& nloc, unsigned& nx) {
  const unsigned G = gridDim.x * gridDim.y * gridDim.z;
  unsigned sum, cnt, mine, sp = 0u;
  for (;;) {
    sum = 0u; cnt = 0u; mine = 0u;
#pragma unroll
    for (unsigned j = 0; j < 16; ++j) { const unsigned c = xb_ld(&bar[XB_XCNT(j)]); sum += c; cnt += (c > 0u) ? 1u : 0u; mine = (j == x) ? c : mine; }
    if (sum == G) break;
    __builtin_amdgcn_s_sleep(1);
    if ((++sp & 255u) == 0u) { if (xb_ld(&bar[XB_TMO])) break; if (sp > XB_SPIN_CAP) { atomicAdd(&bar[XB_TMO], 1u); break; } }
  }
  nloc = mine > 0u ? mine : 1u; nx = cnt > 0u ? cnt : 1u;
}
DI void xcd_barrier(const XcdBarrier& b) {
  asm volatile("s_waitcnt vmcnt(0)" ::: "memory");
  __syncthreads();
  if (threadIdx.x == 0) {
    unsigned* bar = b.bar;
    __builtin_amdgcn_s_waitcnt(0);
    unsigned nloc = b.st[0], nx = b.st[1];
    if (nloc == 0u) { xcd_barrier_complete(bar, b.x, nloc, nx); b.st[0] = nloc; b.st[1] = nx; }
    const unsigned old = xb_add(&bar[XB_XSUB(b.x)], 1u);
    const unsigned gen = old / nloc;
    if (old + 1u == (gen + 1u) * nloc) {
      __builtin_amdgcn_fence(__ATOMIC_RELEASE, "agent");
      asm volatile("s_waitcnt vmcnt(0)" ::: "memory");
      const unsigned og = xb_add(&bar[XB_TOP], 1u);
      const unsigned tg = og / nx;
      if (og + 1u == (tg + 1u) * nx) xb_add(&bar[XB_TOPGEN], 1u);
      else XB_SPIN(xb_ld(&bar[XB_TOPGEN]) == tg, bar);
      __builtin_amdgcn_fence(__ATOMIC_ACQUIRE, "agent");
      xb_add(&bar[XB_XGEN(b.x)], 1u);
      asm volatile("s_waitcnt vmcnt(0)" ::: "memory");
    } else {
      XB_SPIN(xb_ld(&bar[XB_XGEN(b.x)]) == gen, bar);
      __builtin_amdgcn_fence(__ATOMIC_ACQUIRE, "agent");
      asm volatile("s_waitcnt vmcnt(0)" ::: "memory");
    }
  }
  __syncthreads();
}

DI float gelu_tanh(float x) {
  const float y = 0.7978845608028654f * (x + 0.044715f * x * x * x);
  const float t = 1.f - 2.f / (1.f + __expf(2.f * y));
  return 0.5f * x * (1.f + t);
}
DI float log_sigmoid(float x) { return fminf(x, 0.f) - LN2 * lg2(1.f + ex2(-fabsf(x) * LOG2E)); }
DI float wave_sum(float v) {
#pragma unroll
  for (int o = 32; o > 0; o >>= 1) v += __shfl_xor(v, o);
  return v;
}

DI int win_map(int np) { return np < 1152 ? np : (np < 2304 ? np + 518 : (np < 2816 ? np - 1146 : (np < 2822 ? np - 1664 : -1))); }

__device__ void prep_transpose(const float* __restrict__ src, int srcN, int K, int k0, int n0, bfraw* __restrict__ dst, bool winmap, float* lds) {
  const int tid = fresh_tid(), nn = tid & 63, kr = tid >> 6;
  const int np = n0 + nn;
  const int n = winmap ? win_map(np) : np;
#pragma unroll
  for (int it = 0; it < 16; ++it) {
    const int kk = it * 4 + kr;
    const float v = (n >= 0) ? src[(size_t)(k0 + kk) * srcN + n] : 0.f;
    lds[kk * 65 + nn] = v;
  }
  __syncthreads();
#pragma unroll
  for (int j = 0; j < 2; ++j) {
    const int c = tid + 256 * j, n2 = c >> 3, kc = c & 7;
    const float* s = lds + (kc * 8) * 65 + n2;
    uint4 o;
    o.x = pack2(s[0], s[65]); o.y = pack2(s[130], s[195]); o.z = pack2(s[260], s[325]); o.w = pack2(s[390], s[455]);
    *(uint4*)(dst + (size_t)(n0 + n2) * K + k0 + kc * 8) = o;
  }
  __syncthreads();
}

__device__ void phase_prep(const Params& p, unsigned char* lds) {
  bfraw* WinT = (bfraw*)(p.ws + WS_WIN); bfraw* WoutT = (bfraw*)(p.ws + WS_WOUT);
  bfraw* WupT = (bfraw*)(p.ws + WS_WUP); bfraw* WdnT = (bfraw*)(p.ws + WS_WDN);
  bfraw* XB = (bfraw*)(p.ws + WS_XB);
  constexpr int PER_L = 768 + 256 + 1024 + 1024, NW = DEPTH * PER_L, NX = TT / 16;
  for (int it0 = blockIdx.x * 2; it0 < NW + NX; it0 += vgrid()) {
    const int it = min(it0 + half_id(), NW + NX - 1);
    if (it < NW) {
      const int l = it / PER_L; int r = it % PER_L;
      if (r < 768) prep_transpose(p.w_in + (size_t)l * D * DIN, DIN, D, (r & 15) * 64, (r >> 4) * 64, WinT + (size_t)l * NIN * D, true, (float*)lds);
      else if (r < 1024) { r -= 768; prep_transpose(p.w_out + (size_t)l * D * D, D, D, (r & 15) * 64, (r >> 4) * 64, WoutT + (size_t)l * D * D, false, (float*)lds); }
      else if (r < 2048) { r -= 1024; prep_transpose(p.w_up + (size_t)l * D * DFF, DFF, D, (r & 15) * 64, (r >> 4) * 64, WupT + (size_t)l * DFF * D, false, (float*)lds); }
      else { r -= 2048; prep_transpose(p.w_down + (size_t)l * DFF * D, D, DFF, (r & 63) * 64, (r >> 6) * 64, WdnT + (size_t)l * D * DFF, false, (float*)lds); }
    } else {
      const int tid0 = fresh_tid();
      const int row0 = (it - NW) * 16;
      const float* src = row0 < TP ? p.x_prompt + (size_t)row0 * D : p.x_sample + (size_t)(row0 - TP) * D;
      bfraw* dst = XB + (size_t)row0 * D;
#pragma unroll 4
      for (int i = 0; i < 16; ++i) {
        const int idx = (tid0 + 256 * i) * 4;
        const float4 v = *(const float4*)(src + idx);
        uint2 o; o.x = pack2(v.x, v.y); o.y = pack2(v.z, v.w);
        *(uint2*)(dst + idx) = o;
      }
    }
  }
}

enum { EPI_INPROJ = 0, EPI_RESID = 1, EPI_UP = 2, EPI_RESID_IN = 3 };

template <int EPI, int MI, int NI>
DI void gemm_epilogue(const Params& p, int layer, f32x16 (&acc)[MI][NI], int m0, int rbase, int nc0, int r32, int h, bool from_input) {
  if (EPI == EPI_INPROJ) {
    bfraw* QKV = (bfraw*)(p.ws + WS_QKV);
    if (nc0 < QKVW) {
      const int which = nc0 / 384;
      const float scale = (which == 0 || which == 3) ? 0.125f : 1.f;
      const int colin = nc0 - which * 384;
      const size_t offp = which == 1 ? O_PFK : which == 2 ? O_PFV : which == 4 ? O_PSK : O_PSV;
      const size_t offs = which == 1 ? O_SFK : which == 2 ? O_SFV : which == 4 ? O_SSK : O_SSV;
      const bool has_out = (which == 1 || which == 2 || which == 4 || which == 5);
      float* outP = p.out + offp + (size_t)layer * TP * 384 + colin + r32;
      float* outS = p.out + offs + ((size_t)layer * TS * 384 - (size_t)TP * 384) + colin + r32;
#pragma unroll
      for (int mi = 0; mi < MI; ++mi)
#pragma unroll
        for (int ni = 0; ni < NI; ++ni)
#pragma unroll
          for (int i = 0; i < 16; ++i) {
            const int row = m0 + rbase + mi * 32 + (i & 3) + 8 * (i >> 2) + 4 * h;
            const float v = acc[mi][ni][i];
            QKV[(size_t)row * QKVW + nc0 + ni * 32 + r32] = (bfraw)(pack2(v * scale, 0.f) & 0xffffu);
            if (has_out) { float* ob = row < TP ? outP : outS; ob[(size_t)row * 384 + ni * 32] = v; }
          }
    } else if (nc0 < 2560) {
      bfraw* U = (bfraw*)(p.ws + WS_U);
#pragma unroll
      for (int mi = 0; mi < MI; ++mi)
#pragma unroll
        for (int ni = 0; ni < NI; ++ni)
#pragma unroll
          for (int i = 0; i < 16; ++i) {
            const int rl = rbase + mi * 32 + (i & 3) + 8 * (i >> 2) + 4 * h;
            const int col = ni * 32 + r32;
            U[(size_t)(m0 + rl) * 256 + (nc0 - 2304) + col] = (bfraw)(pack2(gelu_tanh(acc[mi][ni][i]), 0.f) & 0xffffu);
          }
    } else if (nc0 < 2816) {
      float* VG = (float*)(p.ws + WS_VG);
#pragma unroll
      for (int mi = 0; mi < MI; ++mi)
#pragma unroll
        for (int ni = 0; ni < NI; ++ni)
#pragma unroll
          for (int i = 0; i < 16; ++i) {
            const int rl = rbase + mi * 32 + (i & 3) + 8 * (i >> 2) + 4 * h;
            const int col = ni * 32 + r32;
            VG[(size_t)(m0 + rl) * 256 + (nc0 - 2560) + col] = gelu_tanh(acc[mi][ni][i]);
          }
    } else if (nc0 == 2816) {
      if (r32 < 6) {
        float* LOGF = (float*)(p.ws + WS_LOGF);
        float* outP = p.out + O_PFL + (size_t)layer * TP * 6 + r32;
        float* outS = p.out + O_SFL + ((size_t)layer * TS * 6 - (size_t)TP * 6) + r32;
        const float bias = p.b_f[layer * 6 + r32];
#pragma unroll
        for (int mi = 0; mi < MI; ++mi)
#pragma unroll
          for (int i = 0; i < 16; ++i) {
            const int row = m0 + rbase + mi * 32 + (i & 3) + 8 * (i >> 2) + 4 * h;
            const float lf = log_sigmoid(acc[mi][0][i] + bias);
            LOGF[(size_t)row * 8 + r32] = lf;
            float* ob = row < TP ? outP : outS;
            ob[(size_t)row * 6] = lf;
          }
      }
    }
  } else if (EPI == EPI_RESID_IN) {
    unsigned char* Yb = p.ws + WS_Y;
    const float* xp = p.x_prompt + nc0 + r32;
    const float* xs = p.x_sample - (size_t)TP * D + nc0 + r32;
    const unsigned o0 = (unsigned)(((m0 + rbase + 4 * h) * D + nc0 + r32) * 4);
#pragma unroll
    for (int mi = 0; mi < MI; ++mi) {
      float xr[NI][16];
#pragma unroll
      for (int ni = 0; ni < NI; ++ni)
#pragma unroll
        for (int i = 0; i < 16; ++i) {
          const int row = m0 + rbase + 4 * h + mi * 32 + (i & 3) + 8 * (i >> 2);
          xr[ni][i] = (row < TP ? xp : xs)[(size_t)row * D + ni * 32];
        }
#pragma unroll
      for (int ni = 0; ni < NI; ++ni)
#pragma unroll
        for (int i = 0; i < 16; ++i)
          *(float*)(Yb + (o0 + (unsigned)(((mi * 32 + (i & 3) + 8 * (i >> 2)) * D + ni * 32) * 4))) = ALPHA * xr[ni][i] + acc[mi][ni][i];
    }
  } else if (EPI == EPI_RESID) {
    unsigned char* Yb = p.ws + WS_Y;
    const unsigned char* Xb = p.ws + WS_X32;
    const unsigned o0 = (unsigned)(((m0 + rbase + 4 * h) * D + nc0 + r32) * 4);
#pragma unroll
    for (int mi = 0; mi < MI; ++mi) {
      float xr[NI][16];
#pragma unroll
      for (int ni = 0; ni < NI; ++ni)
#pragma unroll
        for (int i = 0; i < 16; ++i)
          xr[ni][i] = *(const float*)(Xb + (o0 + (unsigned)(((mi * 32 + (i & 3) + 8 * (i >> 2)) * D + ni * 32) * 4)));
#pragma unroll
      for (int ni = 0; ni < NI; ++ni)
#pragma unroll
        for (int i = 0; i < 16; ++i)
          *(float*)(Yb + (o0 + (unsigned)(((mi * 32 + (i & 3) + 8 * (i >> 2)) * D + ni * 32) * 4))) = ALPHA * xr[ni][i] + acc[mi][ni][i];
    }
  } else {
    bfraw* H = (bfraw*)(p.ws + WS_H);
#pragma unroll
    for (int mi = 0; mi < MI; ++mi)
#pragma unroll
      for (int ni = 0; ni < NI; ++ni)
#pragma unroll
        for (int i = 0; i < 16; ++i) {
          const int rl = rbase + mi * 32 + (i & 3) + 8 * (i >> 2) + 4 * h;
          const int col = nc0 + ni * 32 + r32;
          const float v = fmaxf(acc[mi][ni][i], 0.f);
          H[(size_t)(m0 + rl) * DFF + col] = (bfraw)(pack2(v * v, 0.f) & 0xffffu);
        }
  }
}

template <int EPI, int MI, int NI>
__device__ void gemm_tile8(const Params& p, int layer, const bfraw* __restrict__ A, const bfraw* __restrict__ Bt, int K, int m0, int n0, unsigned char* ring, bool from_input,
                           bool first, bool has_next, int next_m0, int next_n0) {
  constexpr int WGM = NI == 2 ? 2 : 1, WGN = 8 / WGM;
  constexpr int BM = WGM * MI * 32;
  constexpr int STAGE = (BM + 256) * 128;
  constexpr int NAI = BM / 8;
  constexpr int NA = (NAI + 7) / 8;
  int tid = threadIdx.x; asm volatile("" : "+v"(tid));
  const int lane = tid & 63, wid = tid >> 6, wm = wid / WGN, wn = wid % WGN;
  const int r32 = lane & 31, h = lane >> 5;
  f32x16 acc[MI][NI];
#pragma unroll
  for (int a = 0; a < MI; ++a)
#pragma unroll
    for (int b = 0; b < NI; ++b)
#pragma unroll
      for (int i = 0; i < 16; ++i) acc[a][b][i] = 0.f;
  const int dc = (lane & 7) ^ (((wid & 1) * 4 + (lane >> 4)) & 7);
  const unsigned loff = (unsigned)(((wid * 8 + (lane >> 3)) * K + dc * 8) * 2);
  const unsigned char* ab = (const unsigned char*)(A + (size_t)m0 * K);
  const unsigned char* bb = (const unsigned char*)(Bt + (size_t)n0 * K);
  unsigned char* dl = ring + wid * 1024 + lane * 16;
#define ISSUE8A(ab, kt_, st_) do { \
    _Pragma("unroll") for (int j = 0; j < NA; ++j) { \
      if (NAI % 8 == 0 || j < NA - 1 || wid < NAI % 8) \
        __builtin_amdgcn_global_load_lds((const unsigned*)(ab + ((size_t)j * 64 * K + (kt_) * 64) * 2 + loff), (unsigned*)(dl + (st_) * STAGE + j * 8192), 16, 0, 0); } \
  } while (0)
#define ISSUE8B(bb, kt_, st_) do { \
    _Pragma("unroll") for (int j = 0; j < 4; ++j) \
      __builtin_amdgcn_global_load_lds((const unsigned*)(bb + ((size_t)j * 64 * K + (kt_) * 64) * 2 + loff), (unsigned*)(dl + (st_) * STAGE + BM * 128 + j * 8192), 16, 0, 0); \
  } while (0)
#define ISSUE8(ab, bb, kt_, st_) do { ISSUE8A(ab, kt_, st_); ISSUE8B(bb, kt_, st_); } while (0)
  const int key = (r32 >> 1) & 7;
  const unsigned char* afr = ring + (wm * (MI * 32) + r32) * 128;
  const unsigned char* bfr = ring + BM * 128 + (wn * (NI * 32) + r32) * 128;
  const int nk = K >> 6;
  const unsigned char* abn = (const unsigned char*)(A + (size_t)next_m0 * K);
  const unsigned char* bbn = (const unsigned char*)(Bt + (size_t)next_n0 * K);
  if (first) {
    asm volatile("s_waitcnt vmcnt(0)" ::: "memory");
    __builtin_amdgcn_s_barrier();
    asm volatile("" ::: "memory");
    ISSUE8(ab, bb, 0, 0);
  }
  int st = 0;
  for (int kt = 0; kt < nk; ++kt) {
    asm volatile("s_waitcnt vmcnt(0)" ::: "memory");
    __builtin_amdgcn_s_barrier();
    asm volatile("" ::: "memory");
    if (kt + 1 < nk) ISSUE8A(ab, kt + 1, st ^ 1);
    else if (has_next) ISSUE8A(abn, 0, st ^ 1);
    const unsigned char* as = afr + st * STAGE;
    const unsigned char* bs = bfr + st * STAGE;
#pragma unroll
    for (int ks = 0; ks < 4; ++ks) {
      if (ks == 2) { if (kt + 1 < nk) ISSUE8B(bb, kt + 1, st ^ 1); else if (has_next) ISSUE8B(bbn, 0, st ^ 1); }
      const int o = ((ks * 2 + h) ^ key) * 16;
      bf16x8 af[MI], bq[NI];
#pragma unroll
      for (int mi = 0; mi < MI; ++mi) af[mi] = *(const bf16x8*)(as + mi * 4096 + o);
#pragma unroll
      for (int ni = 0; ni < NI; ++ni) bq[ni] = *(const bf16x8*)(bs + ni * 4096 + o);
#pragma unroll
      for (int mi = 0; mi < MI; ++mi)
#pragma unroll
        for (int ni = 0; ni < NI; ++ni)
          acc[mi][ni] = __builtin_amdgcn_mfma_f32_32x32x16_bf16(af[mi], bq[ni], acc[mi][ni], 0, 0, 0);
    }
    st ^= 1;
  }
#undef ISSUE8
#undef ISSUE8A
#undef ISSUE8B
  gemm_epilogue<EPI, MI, NI>(p, layer, acc, m0, wm * (MI * 32), n0 + wn * (NI * 32), r32, h, from_input);
}

template <int EPI, int MI, int NI>
__device__ void phase_gemm8(const Params& p, int layer, const bfraw* A, const bfraw* Bt, int N, int K, unsigned char* ring, bool from_input = false) {
  constexpr int BM = (NI == 2 ? 2 : 1) * MI * 32;
  const int ntn = N / 256, ntiles = (TT / BM) * ntn;
  for (int t = blockIdx.x; t < ntiles; t += gridDim.x) {
    const int tm = t / ntn, tn = t % ntn;
    const int t2 = t + gridDim.x;
    const bool has_next = t2 < ntiles;
    const int tm2 = has_next ? t2 / ntn : tm, tn2 = has_next ? t2 % ntn : tn;
    gemm_tile8<EPI, MI, NI>(p, layer, A, Bt, K, tm * BM, tn * 256, ring, from_input, t == (int)blockIdx.x, has_next, tm2 * BM, tn2 * 256);
  }
  __syncthreads();
}

__device__ void phase_ln(const Params& p, const float* __restrict__ gam, const float* __restrict__ bet, bool last) {
  const float* Y = (const float*)(p.ws + WS_Y);
  float* X32 = (float*)(p.ws + WS_X32);
  bfraw* XB = (bfraw*)(p.ws + WS_XB);
  const int tid_ = fresh_tid(); const int lane = tid_ & 63, wid = tid_ >> 6;
  for (int row = vblock() * 4 + wid; row < TT; row += vgrid() * 4) {
    const float* y = Y + (size_t)row * D;
    float4 v[4];
#pragma unroll
    for (int j = 0; j < 4; ++j) v[j] = *(const float4*)(y + lane * 4 + 256 * j);
    float s = 0.f;
#pragma unroll
    for (int j = 0; j < 4; ++j) s += v[j].x + v[j].y + v[j].z + v[j].w;
    const float mu = wave_sum(s) * (1.f / D);
    float q = 0.f;
#pragma unroll
    for (int j = 0; j < 4; ++j) { v[j].x -= mu; v[j].y -= mu; v[j].z -= mu; v[j].w -= mu; q += v[j].x * v[j].x + v[j].y * v[j].y + v[j].z * v[j].z + v[j].w * v[j].w; }
    const float rstd = rsqrtf(wave_sum(q) * (1.f / D) + 1e-5f);
#pragma unroll
    for (int j = 0; j < 4; ++j) {
      const int c = lane * 4 + 256 * j;
      const float4 g = *(const float4*)(gam + c), b = *(const float4*)(bet + c);
      float4 o;
      o.x = v[j].x * rstd * g.x + b.x; o.y = v[j].y * rstd * g.y + b.y; o.z = v[j].z * rstd * g.z + b.z; o.w = v[j].w * rstd * g.w + b.w;
      if (last) {
        *(float4*)(p.out + (size_t)row * D + c) = o;
      } else {
        *(float4*)(X32 + (size_t)row * D + c) = o;
        uint2 ob; ob.x = pack2(o.x, o.y); ob.y = pack2(o.z, o.w);
        *(uint2*)(XB + (size_t)row * D + c) = ob;
      }
    }
  }
}

DI float wave_incl_scan(float v, int lane) {
#pragma unroll
  for (int o = 1; o < 64; o <<= 1) { const float t = __shfl_up(v, o); if (lane >= o) v += t; }
  return v;
}
__device__ void phase_scan(const Params& p, int layer, unsigned char* lds) {
  const float* LOGF = (const float*)(p.ws + WS_LOGF);
  float* C = (float*)(p.ws + WS_C);
  float* CC = (float*)(p.ws + WS_CC);
  float* red = (float*)lds;
  const int tid = fresh_tid(), lane = tid & 63, wid = tid >> 6;
  {
    const bfraw* QKV = (const bfraw*)(p.ws + WS_QKV);
    unsigned* kmx = (unsigned*)(p.ws + WS_CTL) + KMAX_WORD + 64 * layer;
    for (int it = vblock(); it < 24 * 16; it += vgrid()) {
      const int bh = it >> 4, b = bh / 6, h = bh % 6, pos = (it & 15) * 256 + tid;
      const uint4* kp = (const uint4*)(QKV + (size_t)(b * SEQ + pos) * QKVW + 384 + h * 64);
      float ss = 0.f;
#pragma unroll
      for (int i = 0; i < 8; ++i) {
        const uint4 u = kp[i];
        const unsigned w[4] = {u.x, u.y, u.z, u.w};
#pragma unroll
        for (int k = 0; k < 4; ++k) { const float a = __uint_as_float(w[k] << 16), c = __uint_as_float(w[k] & 0xffff0000u); ss += a * a + c * c; }
      }
#pragma unroll
      for (int o = 32; o > 0; o >>= 1) ss = fmaxf(ss, __shfl_xor(ss, o));
      if (lane == 0) atomicMax(&kmx[bh], __float_as_uint(ss));
    }
  }
  for (int seq0 = blockIdx.x * 2; seq0 < 24 + 192; seq0 += vgrid()) {
    const int seq = min(seq0 + half_id(), 24 + 192 - 1);
    const bool pr = seq < 24;
    const int s = pr ? seq : seq - 24, b = s / 6, h = s % 6;
    float v[16];
    if (pr) {
      const float* base = LOGF + ((size_t)b * SEQ + tid * 16) * 8 + h;
#pragma unroll
      for (int i = 0; i < 16; ++i) v[i] = base[i * 8];
    } else {
      const float* base = p.cfl + (((size_t)layer * DECB + b) * PAST + tid * 8) * 6 + h;
#pragma unroll
      for (int i = 0; i < 8; ++i) v[i] = base[i * 6];
#pragma unroll
      for (int i = 8; i < 16; ++i) v[i] = 0.f;
    }
#pragma unroll
    for (int i = 1; i < 16; ++i) v[i] += v[i - 1];
    const float tot = v[15];
    const float inc = wave_incl_scan(tot, lane);
    if (lane == 63) red[wid] = inc;
    __syncthreads();
    const float r0 = red[0], r1 = red[1], r2 = red[2], r3 = red[3];
    float off = inc - tot;
    off += (wid > 0 ? r0 : 0.f) + (wid > 1 ? r1 : 0.f) + (wid > 2 ? r2 : 0.f);
    if (pr) {
      float* dst = C + ((size_t)b * SEQ + tid * 16) * 8 + h;
#pragma unroll
      for (int i = 0; i < 16; ++i) dst[i * 8] = off + v[i];
    } else {
      float* dst = CC + ((size_t)b * PAST + tid * 8) * 8 + h;
#pragma unroll
      for (int i = 0; i < 8; ++i) dst[i * 8] = off + v[i];
      if (wid == 0) {
        const size_t idx = ((size_t)TP + b * DECS + lane) * 8 + h;
        C[idx] = ((r0 + r1) + (r2 + r3)) + wave_incl_scan(LOGF[idx], lane);
      }
    }
    __syncthreads();
  }
}

__device__ void attn_item(const Params& p, int layer, int type, bool sample, int b, int h, int qb, unsigned char* lds, volatile LAS int* flg) {
  const bfraw* QKV = (const bfraw*)(p.ws + WS_QKV);
  const float* C = (const float*)(p.ws + WS_C);
  const float* CC = (const float*)(p.ws + WS_CC);
  bfraw* O = (bfraw*)(p.ws + WS_O);
  const int tid = fresh_tid(), lane = tid & 63, wid = tid >> 6, l15 = lane & 15, g = lane >> 4;
  const int qrow0 = sample ? TP + b * DECS : b * SEQ + qb * 64;
  const int ntiles = sample ? 33 : qb + 1;
  const int qoff = type ? 1152 : 0, koff = qoff + 384, voff = qoff + 768, hc = h * 64;
  const int qrow = qrow0 + wid * 16 + l15;
  const bfraw* qp = QKV + (size_t)qrow * QKVW + qoff + hc + g * 8;
  const bf16x8 q0 = *(const bf16x8*)qp, q1 = *(const bf16x8*)(qp + 32);
  float cq2 = 0.f;
  if (type == 0) cq2 = C[(size_t)qrow * 8 + h] * LOG2E;
  const bool fexit = (type == 0) && !sample;
  float bqk = 0.f, cnext = 0.f;
  if (fexit) {
    float qs = 0.f;
#pragma unroll
    for (int i = 0; i < 8; ++i) { const float a = bf2f((bfraw)q0[i]), c = bf2f((bfraw)q1[i]); qs += a * a + c * c; }
    qs += __shfl_xor(qs, 16); qs += __shfl_xor(qs, 32);
    const float kmax2 = __uint_as_float(((const unsigned*)(p.ws + WS_CTL))[KMAX_WORD + 64 * layer + b * 6 + h]);
    bqk = sqrtf(qs * kmax2) * (LOG2E * 1.01f) + 1.f;
  }
  const float* kcache = type ? p.csk : p.cfk;
  const float* vcache = type ? p.csv : p.cfv;

  float4 st[8]; float stc = 0.f;
  const int key_l = tid >> 3, dc = tid & 7;
  unsigned char* kd = lds + key_l * 144 + dc * 16;
  unsigned char* vd = kd + 9216;
  float* ckl = (float*)(lds + 18432);

#define ATTN_PREFETCH(t_)                                                                                         \
  do {                                                                                                            \
    const int tt_ = (t_);                                                                                         \
    if (!(sample && tt_ < 32)) {                                                                                  \
      const int krow = sample ? TP + b * DECS : b * SEQ + tt_ * 64;                                               \
      const bfraw* kp = QKV + (size_t)(krow + key_l) * QKVW + hc + dc * 8;                                        \
      st[0] = *(const float4*)(kp + koff); st[1] = *(const float4*)(kp + koff + 32 * QKVW);                       \
      st[2] = *(const float4*)(kp + voff); st[3] = *(const float4*)(kp + voff + 32 * QKVW);                       \
      if (type == 0 && tid < 64) stc = C[(size_t)(krow + tid) * 8 + h];                                           \
    } else {                                                                                                      \
      const size_t off = ((((size_t)layer * DECB + b) * PAST + tt_ * 64 + key_l) * 6 + h) * 64 + dc * 8;          \
      const float* kc = kcache + off; const float* vc = vcache + off;                                             \
      st[0] = NTLD(kc); st[1] = NTLD((kc + 4));                                               \
      st[2] = NTLD((kc + 32 * 384)); st[3] = NTLD((kc + 32 * 384 + 4));                       \
      st[4] = NTLD(vc); st[5] = NTLD((vc + 4));                                               \
      st[6] = NTLD((vc + 32 * 384)); st[7] = NTLD((vc + 32 * 384 + 4));                       \
      if (type == 0 && tid < 64) stc = CC[((size_t)b * PAST + tt_ * 64 + tid) * 8 + h];                           \
    }                                                                                                             \
  } while (0)

  f32x4 oacc[4];
#pragma unroll
  for (int i = 0; i < 4; ++i) oacc[i] = (f32x4){0.f, 0.f, 0.f, 0.f};
  float m = -1e30f, lsum = 0.f, R = 0.f;
  const int ql = wid * 16 + l15;
  const int i16 = l15, qq = i16 >> 2, pp = i16 & 3;
  const unsigned char* vtr = lds + 9216 + (4 * g + qq) * 144 + pp * 8;

  ATTN_PREFETCH(ntiles - 1);
  for (int t = ntiles - 1; t >= 0; --t) {
    if (!(sample && t < 32)) {
      *(float4*)kd = st[0]; *(float4*)(kd + 32 * 144) = st[1]; *(float4*)vd = st[2]; *(float4*)(vd + 32 * 144) = st[3];
    } else {
      uint4 a;
      a.x = pack2(st[0].x, st[0].y); a.y = pack2(st[0].z, st[0].w); a.z = pack2(st[1].x, st[1].y); a.w = pack2(st[1].z, st[1].w); *(uint4*)kd = a;
      a.x = pack2(st[2].x, st[2].y); a.y = pack2(st[2].z, st[2].w); a.z = pack2(st[3].x, st[3].y); a.w = pack2(st[3].z, st[3].w); *(uint4*)(kd + 32 * 144) = a;
      a.x = pack2(st[4].x, st[4].y); a.y = pack2(st[4].z, st[4].w); a.z = pack2(st[5].x, st[5].y); a.w = pack2(st[5].z, st[5].w); *(uint4*)vd = a;
      a.x = pack2(st[6].x, st[6].y); a.y = pack2(st[6].z, st[6].w); a.z = pack2(st[7].x, st[7].y); a.w = pack2(st[7].z, st[7].w); *(uint4*)(vd + 32 * 144) = a;
    }
    if (type == 0 && tid < 64) ckl[tid] = stc * LOG2E;
    __syncthreads();
    if (t > 0) ATTN_PREFETCH(t - 1);
    if (fexit && t > 0) cnext = C[(size_t)(b * SEQ + (t - 1) * 64 + 63) * 8 + h];
    const bool diag = (t == ntiles - 1);

    f32x4 s[4];
#pragma unroll
    for (int kb = 0; kb < 4; ++kb) {
      const unsigned char* ka = lds + (kb * 16 + l15) * 144 + g * 16;
      const bf16x8 a0 = *(const bf16x8*)ka, a1 = *(const bf16x8*)(ka + 64);
      f32x4 z = (f32x4){0.f, 0.f, 0.f, 0.f};
      z = __builtin_amdgcn_mfma_f32_16x16x32_bf16(a0, q0, z, 0, 0, 0);
      s[kb] = __builtin_amdgcn_mfma_f32_16x16x32_bf16(a1, q1, z, 0, 0, 0);
    }
    unsigned pk[8];
    if (type == 0) {
      float mx = -1e30f;
#pragma unroll
      for (int kb = 0; kb < 4; ++kb) {
        const f32x4 ck = *(const f32x4*)(ckl + kb * 16 + 4 * g);
#pragma unroll
        for (int j = 0; j < 4; ++j) {
          float x = s[kb][j] * LOG2E + cq2 - ck[j];
          if (diag && (kb * 16 + 4 * g + j > ql)) x = -1e30f;
          s[kb][j] = x; mx = fmaxf(mx, x);
        }
      }
      mx = fmaxf(mx, __shfl_xor(mx, 16)); mx = fmaxf(mx, __shfl_xor(mx, 32));
      const float mnew = fmaxf(m, mx);
      const float alpha = ex2(m - mnew);
      m = mnew;
      float ps = 0.f;
#pragma unroll
      for (int kb = 0; kb < 4; ++kb) {
        const float p0 = ex2(s[kb][0] - mnew), p1 = ex2(s[kb][1] - mnew), p2 = ex2(s[kb][2] - mnew), p3 = ex2(s[kb][3] - mnew);
        ps += (p0 + p1) + (p2 + p3);
        pk[kb * 2] = pack2(p0, p1); pk[kb * 2 + 1] = pack2(p2, p3);
      }
      lsum = lsum * alpha + ps;
#pragma unroll
      for (int db = 0; db < 4; ++db) oacc[db] *= alpha;
    } else {
      float lr[4][4];
#pragma unroll
      for (int kb = 0; kb < 4; ++kb)
#pragma unroll
        for (int j = 0; j < 4; ++j) {
          const float z2 = s[kb][j] * LOG2E;
          const float e = ex2(-fabsf(z2));
          float l = -(fmaxf(z2, 0.f) + lg2(1.f + e));
          if (diag && !(kb * 16 + 4 * g + j < ql)) l = 0.f;
          s[kb][j] = z2; lr[kb][j] = l;
        }
#pragma unroll
      for (int kb = 3; kb >= 0; --kb) {
        const float G = (lr[kb][0] + lr[kb][1]) + (lr[kb][2] + lr[kb][3]);
        const float a = __shfl_xor(G, 16), bb = __shfl_xor(G, 32), c = __shfl_xor(G, 48);
        const float tot = (G + a) + (bb + c);
        const float gt = ((g == 0 || g == 2) ? a : 0.f) + ((g < 2) ? (bb + c) : 0.f);
        const float a3 = R + gt, a2 = a3 + lr[kb][3], a1 = a2 + lr[kb][2], a0 = a1 + lr[kb][1];
        float p0 = ex2(s[kb][0] + lr[kb][0] + a0), p1 = ex2(s[kb][1] + lr[kb][1] + a1);
        float p2 = ex2(s[kb][2] + lr[kb][2] + a2), p3 = ex2(s[kb][3] + lr[kb][3] + a3);
        if (diag) {
          const int k0 = kb * 16 + 4 * g;
          if (!(k0 < ql)) p0 = 0.f;
          if (!(k0 + 1 < ql)) p1 = 0.f;
          if (!(k0 + 2 < ql)) p2 = 0.f;
          if (!(k0 + 3 < ql)) p3 = 0.f;
        }
        pk[kb * 2] = pack2(p0, p1); pk[kb * 2 + 1] = pack2(p2, p3);
        R += tot;
      }
      const int alldone = __all(R < SB_EXIT) ? 1 : 0;
      if (lane == 0) flg[half_id() * 4 + wid] = alldone;
    }
    if (fexit) {
      const int done = (t > 0 && __all(bqk + cq2 - cnext * LOG2E - m < FOX_EXIT)) ? 1 : 0;
      if (lane == 0) flg[half_id() * 4 + wid] = done;
    }
#pragma unroll
    for (int kk = 0; kk < 2; ++kk) {
      const uint4 pu = {pk[kk * 4], pk[kk * 4 + 1], pk[kk * 4 + 2], pk[kk * 4 + 3]};
      const bf16x8 pf = __builtin_bit_cast(bf16x8, pu);
#pragma unroll
      for (int db = 0; db < 4; ++db) {
        const unsigned char* va = vtr + (32 * kk) * 144 + db * 32;
        const s16x4 lo = __builtin_amdgcn_ds_read_tr16_b64_v4i16((LAS s16x4*)(va));
        const s16x4 hi = __builtin_amdgcn_ds_read_tr16_b64_v4i16((LAS s16x4*)(va + 16 * 144));
        const bf16x8 vf = __builtin_shufflevector(lo, hi, 0, 1, 2, 3, 4, 5, 6, 7);
        oacc[db] = __builtin_amdgcn_mfma_f32_16x16x32_bf16(vf, pf, oacc[db], 0, 0, 0);
      }
    }
    __syncthreads();
    if (type == 1 || fexit) { if (flg[0] & flg[1] & flg[2] & flg[3] & flg[4] & flg[5] & flg[6] & flg[7]) break; }
  }
#undef ATTN_PREFETCH
  if (type == 0) {
    lsum += __shfl_xor(lsum, 16); lsum += __shfl_xor(lsum, 32);
    const float inv = 1.f / lsum;
#pragma unroll
    for (int db = 0; db < 4; ++db) oacc[db] *= inv;
  }
  float ss = 0.f;
#pragma unroll
  for (int db = 0; db < 4; ++db)
#pragma unroll
    for (int j = 0; j < 4; ++j) ss += oacc[db][j] * oacc[db][j];
  ss += __shfl_xor(ss, 16); ss += __shfl_xor(ss, 32);
  const float rs = rsqrtf(ss * (1.f / 64.f) + 1e-6f);
  const int hoff = type ? 640 + hc : hc;
#pragma unroll
  for (int db = 0; db < 4; ++db) {
    const int d0 = 16 * db + 4 * g;
    const float4 gm = *(const float4*)(p.g_mix + layer * D + hoff + d0);
    uint2 o;
    o.x = pack2(oacc[db][0] * rs * gm.x, oacc[db][1] * rs * gm.y);
    o.y = pack2(oacc[db][2] * rs * gm.z, oacc[db][3] * rs * gm.w);
    *(uint2*)(O + (size_t)qrow * D + hoff + d0) = o;
  }
}

__device__ void sgu_item(const Params& p, int layer, bool sample, int ci, int g, unsigned char* lds) {
  const float* VG = (const float*)(p.ws + WS_VG);
  const bfraw* U = (const bfraw*)(p.ws + WS_U);
  bfraw* O = (bfraw*)(p.ws + WS_O);
  constexpr int LROW = 272;
  unsigned char* Wl = lds;
  unsigned char* Vt = lds + 128 * LROW;
  const int tid = fresh_tid(), lane = tid & 63, wid = tid >> 6;
  const int r0 = sample ? TP + ci * DECS : ci * 128;
  const int L = sample ? 64 : 128;
  {
    const float4 gv = *(const float4*)(p.g_v + layer * 256 + lane * 4), bv = *(const float4*)(p.b_v + layer * 256 + lane * 4);
    for (int i = wid; i < L; i += 4) {
      float4 v = *(const float4*)(VG + (size_t)(r0 + i) * 256 + lane * 4);
      const float mu = wave_sum(v.x + v.y + v.z + v.w) * (1.f / 256.f);
      v.x -= mu; v.y -= mu; v.z -= mu; v.w -= mu;
      const float rstd = rsqrtf(wave_sum(v.x * v.x + v.y * v.y + v.z * v.z + v.w * v.w) * (1.f / 256.f) + 1e-5f);
      float4 o;
      o.x = v.x * rstd * gv.x + bv.x; o.y = v.y * rstd * gv.y + bv.y; o.z = v.z * rstd * gv.z + bv.z; o.w = v.w * rstd * gv.w + bv.w;
      if ((lane >> 4) == g) {
        const unsigned lo = pack2(o.x, o.y), hi = pack2(o.z, o.w);
        unsigned char* vp = Vt + ((lane & 15) * 4) * LROW + i * 2;
        *(bfraw*)(vp) = (bfraw)(lo & 0xffffu); *(bfraw*)(vp + LROW) = (bfraw)(lo >> 16);
        *(bfraw*)(vp + 2 * LROW) = (bfraw)(hi & 0xffffu); *(bfraw*)(vp + 3 * LROW) = (bfraw)(hi >> 16);
        if (sample) *(float4*)(p.out + O_SGV + ((size_t)layer * TS + (r0 - TP) + i) * 256 + lane * 4) = o;
      }
    }
    const float* wg = p.w_s + ((size_t)layer * 4 + g) * 128 * 128;
#pragma unroll 4
    for (int k = 0; k < 16; ++k) {
      const int idx = tid + 256 * k, row = idx >> 5, c4 = (idx & 31) * 4;
      if (row < L) {
        const float4 w = *(const float4*)(wg + row * 128 + c4);
        uint2 o;
        o.x = pack2(c4 <= row ? w.x : 0.f, c4 + 1 <= row ? w.y : 0.f);
        o.y = pack2(c4 + 2 <= row ? w.z : 0.f, c4 + 3 <= row ? w.w : 0.f);
        *(uint2*)(Wl + row * LROW + c4 * 2) = o;
      }
    }
  }
  __syncthreads();
  if (wid * 32 < L) {
    const int r32 = lane & 31, h = lane >> 5;
    f32x16 acc[2];
#pragma unroll
    for (int ni = 0; ni < 2; ++ni)
#pragma unroll
      for (int i = 0; i < 16; ++i) acc[ni][i] = 0.f;
    const unsigned char* ap = Wl + (wid * 32 + r32) * LROW + h * 16;
    const unsigned char* bp = Vt + r32 * LROW + h * 16;
    const int nks = min(L / 16, 2 * (wid + 1));
    for (int ks = 0; ks < nks; ++ks) {
      const bf16x8 a = *(const bf16x8*)(ap + ks * 32);
      const bf16x8 b0 = *(const bf16x8*)(bp + ks * 32), b1 = *(const bf16x8*)(bp + 32 * LROW + ks * 32);
      acc[0] = __builtin_amdgcn_mfma_f32_32x32x16_bf16(a, b0, acc[0], 0, 0, 0);
      acc[1] = __builtin_amdgcn_mfma_f32_32x32x16_bf16(a, b1, acc[1], 0, 0, 0);
    }
    const float* bsp = p.b_s + ((size_t)layer * 4 + g) * 128 + wid * 32 + 4 * h;
    const float* gm = p.g_mix + layer * D + 384 + g * 64 + r32;
    const float gm0 = gm[0], gm1 = gm[32];
    const size_t rowb = (size_t)(r0 + wid * 32 + 4 * h);
#pragma unroll
    for (int i = 0; i < 16; ++i) {
      const int rl = (i & 3) + 8 * (i >> 2);
      const float bs = bsp[rl];
      const bfraw* up = U + (rowb + rl) * 256 + g * 64 + r32;
      const float o0 = bf2f(up[0]) * (acc[0][i] + bs), o1 = bf2f(up[32]) * (acc[1][i] + bs);
      float ss = o0 * o0 + o1 * o1;
      ss += __shfl_xor(ss, 1); ss += __shfl_xor(ss, 2); ss += __shfl_xor(ss, 4); ss += __shfl_xor(ss, 8); ss += __shfl_xor(ss, 16);
      const float rs = rsqrtf(ss * (1.f / 64.f) + 1e-6f);
      bfraw* op = O + (rowb + rl) * D + 384 + g * 64 + r32;
      op[0] = (bfraw)(pack2(o0 * rs * gm0, 0.f) & 0xffffu);
      op[32] = (bfraw)(pack2(o1 * rs * gm1, 0.f) & 0xffffu);
    }
  }
  __syncthreads();
}

__device__ void phase_mix(const Params& p, int layer, unsigned char* lds, volatile LAS int* slot) {
  unsigned* ctr = (unsigned*)(p.ws + WS_CTL) + QCTR_WORD + 64 * layer;
  volatile LAS int* flg = slot + 4;
  constexpr int N_SAMPLE = 384, N_PROMPT = 3072, N_SGU = 640, N_ALL = N_SAMPLE + N_PROMPT + N_SGU;
  for (;;) {
    if (threadIdx.x == 0) *slot = (int)atomicAdd(ctr, 1u);
    __syncthreads();
    const int item = *slot * 2 + half_id();
    __syncthreads();
    if (item >= N_ALL) break;
    if (item < N_SAMPLE) {
      const int type = item < 192 ? 1 : 0, r = item % 192;
      attn_item(p, layer, type, true, r / 6, r % 6, 0, lds, flg);
    } else if (item < N_SAMPLE + N_SGU) {
      int r = item - N_SAMPLE;
      if (r < 512) sgu_item(p, layer, false, r >> 2, r & 3, lds);
      else { r -= 512; sgu_item(p, layer, true, r >> 2, r & 3, lds); }
    } else {
      const int r = item - N_SAMPLE - N_SGU, type = r < 1536 ? 0 : 1, r2 = r % 1536, qb = 63 - r2 / 24, bh = r2 % 24;
      attn_item(p, layer, type, false, bh / 6, bh % 6, qb, lds, flg);
    }
  }
}

__device__ void run_phase(const Params& p, int ph, unsigned char* lds, unsigned char* ring, volatile LAS int* slot) {
  const bfraw* XB = (const bfraw*)(p.ws + WS_XB);
  if (ph == 0) { phase_prep(p, lds); return; }
  const int layer = (ph - 1) >> 3, sub = (ph - 1) & 7;
  switch (sub) {
    case 0: phase_gemm8<EPI_INPROJ, 9, 1>(p, layer, XB, (const bfraw*)(p.ws + WS_WIN) + (size_t)layer * NIN * D, NIN, D, ring); break;
    case 1: phase_scan(p, layer, lds); break;
    case 2: phase_mix(p, layer, lds, slot); break;
    case 3: if (layer == 0) phase_gemm8<EPI_RESID_IN, 9, 1>(p, layer, (const bfraw*)(p.ws + WS_O), (const bfraw*)(p.ws + WS_WOUT) + (size_t)layer * D * D, D, D, ring);
            else phase_gemm8<EPI_RESID, 9, 1>(p, layer, (const bfraw*)(p.ws + WS_O), (const bfraw*)(p.ws + WS_WOUT) + (size_t)layer * D * D, D, D, ring);
            break;
    case 4: phase_ln(p, p.ln1_g + layer * D, p.ln1_b + layer * D, false); break;
    case 5: phase_gemm8<EPI_UP, 9, 1>(p, layer, XB, (const bfraw*)(p.ws + WS_WUP) + (size_t)layer * DFF * D, DFF, D, ring); break;
    case 6: phase_gemm8<EPI_RESID, 9, 1>(p, layer, (const bfraw*)(p.ws + WS_H), (const bfraw*)(p.ws + WS_WDN) + (size_t)layer * D * DFF, D, DFF, ring); break;
    default: phase_ln(p, p.ln2_g + layer * D, p.ln2_b + layer * D, layer == DEPTH - 1); break;
  }
}

__global__ void __launch_bounds__(512, 2) fwd_kernel(Params p) {
  extern __shared__ __attribute__((aligned(16))) unsigned char smem[];
  unsigned char* lds = smem + LDS_DATA + half_id() * HALF_LDS;
  volatile LAS unsigned* st = (volatile LAS unsigned*)smem;
  volatile LAS int* slot = (volatile LAS int*)(smem + 16);
  if (threadIdx.x == 0) { st[0] = 0u; st[1] = 0u; st[2] = 0u; st[3] = 0u; }
  __syncthreads();
  XcdBarrier xb;
  xb.bar = (unsigned*)(p.ws + WS_CTL); xb.x = 0; xb.st = st;
  if (p.coop) xb = xcd_barrier_post((unsigned*)(p.ws + WS_CTL), st);
  for (int ph = p.ph_lo; ph < p.ph_hi; ++ph) {
    if (ph > p.ph_lo) {
      if (p.pad) cg::this_grid().sync();
      xcd_barrier(xb);
    }
    run_phase(p, ph, lds, smem + LDS_DATA, slot);
  }
}

extern "C" void kernel_launch(void* const* d_in, const int* in_sizes, int n_in, void* d_out, int out_size, void* d_ws, size_t ws_size,
                              hipStream_t stream) {
  static int grid = 0;
  if (grid == 0) {
    if (n_in != 21 || (size_t)out_size != O_END || ws_size < WS_END) {
      fprintf(stderr, "kernel_launch: unexpected shapes: n_in %d out %d (want %zu) ws %zu (want >= %zu)\n", n_in, out_size, (size_t)O_END, ws_size, (size_t)WS_END);
      grid = -1; return;
    }
    int dev = 0, cus = 0, per_cu = 0;
    hipGetDevice(&dev);
    hipDeviceGetAttribute(&cus, hipDeviceAttributeMultiprocessorCount, dev);
    if (hipFuncSetAttribute((const void*)fwd_kernel, hipFuncAttributeMaxDynamicSharedMemorySize, LDS_BYTES) != hipSuccess) {
      fprintf(stderr, "kernel_launch: hipFuncSetAttribute failed\n"); grid = -1; return;
    }
    hipOccupancyMaxActiveBlocksPerMultiprocessor(&per_cu, (const void*)fwd_kernel, 512, LDS_BYTES);
    if (per_cu < 1) { fprintf(stderr, "kernel_launch: occupancy query says %d\n", per_cu); per_cu = 1; }
    if (per_cu > 1) per_cu = 1;
    grid = cus * per_cu;
  }
  if (grid < 0) return;
  hipMemsetAsync((char*)d_ws + WS_CTL, 0, CTL_BYTES, stream);
  Params p{};
  const float** f = (const float**)&p;
  for (int i = 0; i < 21; ++i) f[i] = (const float*)d_in[i];
  p.out = (float*)d_out; p.ws = (unsigned char*)d_ws;
#if MK_MODE == 0
  for (int ph = 0; ph < NPHASE; ++ph) {
    p.ph_lo = ph; p.ph_hi = ph + 1; p.coop = 0; p.pad = 0;
    hipLaunchKernelGGL(fwd_kernel, dim3(grid), dim3(512), LDS_BYTES, stream, p);
  }
#else
  p.ph_lo = 0; p.ph_hi = NPHASE; p.coop = 1; p.pad = 0;
  void* args[] = {&p};
  hipError_t e = hipLaunchCooperativeKernel((const void*)fwd_kernel, dim3(grid), dim3(512), args, LDS_BYTES, stream);
  if (e != hipSuccess) fprintf(stderr, "cooperative launch failed: %s (grid %d)\n", hipGetErrorString(e), grid);
#endif
}
```

```cpp
#include <hip/hip_runtime.h>
#include <hip/hip_cooperative_groups.h>
#include <cstdio>
#include <cstdint>
namespace cg = cooperative_groups;

#ifndef MK_MODE
#define MK_MODE 1
#endif

#define DI __device__ __forceinline__
typedef unsigned short bfraw;
typedef __attribute__((ext_vector_type(8))) short bf16x8;
typedef __attribute__((ext_vector_type(4))) short s16x4;
typedef __attribute__((ext_vector_type(4))) float f32x4;
typedef __attribute__((ext_vector_type(16))) float f32x16;
typedef __attribute__((ext_vector_type(2))) __bf16 bf2_t;
typedef __attribute__((ext_vector_type(2))) float f2_t;
#define LAS __attribute__((address_space(3)))

DI unsigned pack2(float a, float b) { f2_t x = {a, b}; bf2_t y = __builtin_convertvector(x, bf2_t); return __builtin_bit_cast(unsigned, y); }
DI float bf2f(bfraw v) { return __uint_as_float(((unsigned)v) << 16); }
DI int fresh_tid() { int t = threadIdx.x & 255; asm volatile("" : "+v"(t)); return t; }
DI int half_id() { return __builtin_amdgcn_readfirstlane((int)(threadIdx.x >> 8)); }
DI int vblock() { return (int)blockIdx.x * 2 + half_id(); }
DI int vgrid() { return (int)gridDim.x * 2; }
DI float4 ntld4(const float* p) { const f32x4 v = __builtin_nontemporal_load((const f32x4*)p); return make_float4(v[0], v[1], v[2], v[3]); }
#define NTLD(p_) ntld4((const float*)(p_))
DI float ex2(float x) { return __builtin_amdgcn_exp2f(x); }
DI float lg2(float x) { return __builtin_amdgcn_logf(x); }

constexpr int D = 1024, TP = 16384, TS = 2048, TT = TP + TS, SEQ = 4096, DECB = 32, DECS = 64, PAST = 2048;
constexpr int NIN = 3072, DFF = 4096, DEPTH = 2, QKVW = 2304, DIN = 2822;
constexpr float ALPHA = 1.41421356237309515f;
constexpr float LOG2E = 1.44269504088896341f;
constexpr float LN2 = 0.69314718055994531f;
constexpr float SB_EXIT = -160.f;
constexpr float FOX_EXIT = -160.f;
constexpr int KMAX_WORD = 12288;

constexpr size_t O_YP = 0;
constexpr size_t O_YS = O_YP + (size_t)TP * D;
constexpr size_t O_PFK = O_YS + (size_t)TS * D;
constexpr size_t O_PFV = O_PFK + (size_t)DEPTH * TP * 384;
constexpr size_t O_PFL = O_PFV + (size_t)DEPTH * TP * 384;
constexpr size_t O_PSK = O_PFL + (size_t)DEPTH * TP * 6;
constexpr size_t O_PSV = O_PSK + (size_t)DEPTH * TP * 384;
constexpr size_t O_SFK = O_PSV + (size_t)DEPTH * TP * 384;
constexpr size_t O_SFV = O_SFK + (size_t)DEPTH * TS * 384;
constexpr size_t O_SFL = O_SFV + (size_t)DEPTH * TS * 384;
constexpr size_t O_SSK = O_SFL + (size_t)DEPTH * TS * 6;
constexpr size_t O_SSV = O_SSK + (size_t)DEPTH * TS * 384;
constexpr size_t O_SGV = O_SSV + (size_t)DEPTH * TS * 384;
constexpr size_t O_END = O_SGV + (size_t)DEPTH * TS * 256;

constexpr size_t WS_CTL = 0;
constexpr size_t CTL_BYTES = 65536;
constexpr size_t WS_WIN = WS_CTL + CTL_BYTES;
constexpr size_t WS_WOUT = WS_WIN + (size_t)DEPTH * NIN * D * 2;
constexpr size_t WS_WUP = WS_WOUT + (size_t)DEPTH * D * D * 2;
constexpr size_t WS_WDN = WS_WUP + (size_t)DEPTH * DFF * D * 2;
constexpr size_t WS_XB = WS_WDN + (size_t)DEPTH * D * DFF * 2;
constexpr size_t WS_X32 = WS_XB + (size_t)TT * D * 2;
constexpr size_t WS_Y = WS_X32 + (size_t)TT * D * 4;
constexpr size_t WS_QKV = WS_Y + (size_t)TT * D * 4;
constexpr size_t WS_U = WS_QKV + (size_t)TT * QKVW * 2;
constexpr size_t WS_VG = WS_U + (size_t)TT * 256 * 2;
constexpr size_t WS_LOGF = WS_VG + (size_t)TT * 256 * 4;
constexpr size_t WS_C = WS_LOGF + (size_t)TT * 8 * 4;
constexpr size_t WS_CC = WS_C + (size_t)TT * 8 * 4;
constexpr size_t WS_O = WS_CC + (size_t)DECB * PAST * 8 * 4;
constexpr size_t WS_H = WS_O + (size_t)TT * D * 2;
constexpr size_t WS_END = WS_H + (size_t)TT * DFF * 2;

constexpr int LDS_DATA = 64;
constexpr int ABUF = 128 * 144;
constexpr int HALF_LDS = 69632;
constexpr int LDS_BYTES = LDS_DATA + 2 * HALF_LDS;
constexpr int NPHASE = 1 + 8 * DEPTH;
constexpr int QCTR_WORD = 8192;

struct Params {
  const float *x_prompt, *x_sample, *cfk, *cfv, *cfl, *csk, *csv, *w_in, *b_f, *g_v, *b_v, *w_s, *b_s, *g_mix, *w_out,
      *ln1_g, *ln1_b, *w_up, *w_down, *ln2_g, *ln2_b;
  float* out;
  unsigned char* ws;
  int ph_lo, ph_hi, coop, pad;
};

#define XB_TMO      128
#define XB_XCNT(j)  (256  + 64 * (j))
#define XB_XSUB(j)  (1280 + 64 * (j))
#define XB_XGEN(j)  (2304 + 64 * (j))
#define XB_TOP      3328
#define XB_TOPGEN   3392
#define XCD_BAR_WORDS 3456
#define XB_SPIN_CAP (1u << 22)
DI unsigned xb_ld(unsigned* p) { return __hip_atomic_load(p, __ATOMIC_RELAXED, __HIP_MEMORY_SCOPE_AGENT); }
DI unsigned xb_add(unsigned* p, unsigned v) { return __hip_atomic_fetch_add(p, v, __ATOMIC_RELAXED, __HIP_MEMORY_SCOPE_AGENT); }
DI unsigned xb_xcc_id() { return (unsigned)__builtin_amdgcn_s_getreg((3 << 11) | 20) & 0xFu; }
#define XB_SPIN(cond, bar) do { unsigned _sp = 0; while (cond) { __builtin_amdgcn_s_sleep(1); \
    if ((++_sp & 255u) == 0u) { if (xb_ld(&(bar)[XB_TMO])) break; if (_sp > XB_SPIN_CAP) { atomicAdd(&(bar)[XB_TMO], 1u); break; } } } } while (0)
struct XcdBarrier { unsigned* bar; unsigned x; volatile LAS unsigned* st; };
DI XcdBarrier xcd_barrier_post(unsigned* bar, volatile LAS unsigned* st) {
  XcdBarrier b; b.bar = bar; b.x = xb_xcc_id(); b.st = st;
  if (threadIdx.x == 0) (void)xb_add(&bar[XB_XCNT(b.x)], 1u);
  return b;
}
DI void xcd_barrier_complete(unsigned* bar, unsigned x, unsigned& nloc, unsigned& nx) {
  const unsigned G = gridDim.x * gridDim.y * gridDim.z;
  unsigned sum, cnt, mine, sp = 0u;
  for (;;) {
    sum = 0u; cnt = 0u; mine = 0u;
#pragma unroll
    for (unsigned j = 0; j < 16; ++j) { const unsigned c = xb_ld(&bar[XB_XCNT(j)]); sum += c; cnt += (c > 0u) ? 1u : 0u; mine = (j == x) ? c : mine; }
    if (sum == G) break;
    __builtin_amdgcn_s_sleep(1);
    if ((++sp & 255u) == 0u) { if (xb_ld(&bar[XB_TMO])) break; if (sp > XB_SPIN_CAP) { atomicAdd(&bar[XB_TMO], 1u); break; } }
  }
  nloc = mine > 0u ? mine : 1u; nx = cnt > 0u ? cnt : 1u;
}
DI void xcd_barrier(const XcdBarrier& b) {
  asm volatile("s_waitcnt vmcnt(0)" ::: "memory");
  __syncthreads();
  if (threadIdx.x == 0) {
    unsigned* bar = b.bar;
    __builtin_amdgcn_s_waitcnt(0);
    unsigned nloc = b.st[0], nx = b.st[1];
    if (nloc == 0u) { xcd_barrier_complete(bar, b.x, nloc, nx); b.st[0] = nloc; b.st[1] = nx; }
    const unsigned old = xb_add(&bar[XB_XSUB(b.x)], 1u);
    const unsigned gen = old / nloc;
    if (old + 1u == (gen + 1u) * nloc) {
      __builtin_amdgcn_fence(__ATOMIC_RELEASE, "agent");
      asm volatile("s_waitcnt vmcnt(0)" ::: "memory");
      const unsigned og = xb_add(&bar[XB_TOP], 1u);
      const unsigned tg = og / nx;
      if (og + 1u == (tg + 1u) * nx) xb_add(&bar[XB_TOPGEN], 1u);
      else XB_SPIN(xb_ld(&bar[XB_TOPGEN]) == tg, bar);
      __builtin_amdgcn_fence(__ATOMIC_ACQUIRE, "agent");
      xb_add(&bar[XB_XGEN(b.x)], 1u);
      asm volatile("s_waitcnt vmcnt(0)" ::: "memory");
    } else {
      XB_SPIN(xb_ld(&bar[XB_XGEN(b.x)]) == gen, bar);
      __builtin_amdgcn_fence(__ATOMIC_ACQUIRE, "agent");
      asm volatile("s_waitcnt vmcnt(0)" ::: "memory");
    }
  }
  __syncthreads();
}

DI float gelu_tanh(float x) {
  const float y = 0.7978845608028654f * (x + 0.044715f * x * x * x);
  const float t = 1.f - 2.f / (1.f + __expf(2.f * y));
  return 0.5f * x * (1.f + t);
}
DI float log_sigmoid(float x) { return fminf(x, 0.f) - LN2 * lg2(1.f + ex2(-fabsf(x) * LOG2E)); }
DI float wave_sum(float v) {
#pragma unroll
  for (int o = 32; o > 0; o >>= 1) v += __shfl_xor(v, o);
  return v;
}

DI int win_map(int np) { return np < 1152 ? np : (np < 2304 ? np + 518 : (np < 2816 ? np - 1146 : (np < 2822 ? np - 1664 : -1))); }

__device__ void prep_transpose(const float* __restrict__ src, int srcN, int K, int k0, int n0, bfraw* __restrict__ dst, bool winmap, float* lds) {
  const int tid = fresh_tid(), nn = tid & 63, kr = tid >> 6;
  const int np = n0 + nn;
  const int n = winmap ? win_map(np) : np;
#pragma unroll
  for (int it = 0; it < 16; ++it) {
    const int kk = it * 4 + kr;
    const float v = (n >= 0) ? __builtin_nontemporal_load(&src[(size_t)(k0 + kk) * srcN + n]) : 0.f;
    lds[kk * 65 + nn] = v;
  }
  __syncthreads();
#pragma unroll
  for (int j = 0; j < 2; ++j) {
    const int c = tid + 256 * j, n2 = c >> 3, kc = c & 7;
    const float* s = lds + (kc * 8) * 65 + n2;
    uint4 o;
    o.x = pack2(s[0], s[65]); o.y = pack2(s[130], s[195]); o.z = pack2(s[260], s[325]); o.w = pack2(s[390], s[455]);
    *(uint4*)(dst + (size_t)(n0 + n2) * K + k0 + kc * 8) = o;
  }
  __syncthreads();
}

__device__ void phase_prep(const Params& p, unsigned char* lds) {
  bfraw* WinT = (bfraw*)(p.ws + WS_WIN); bfraw* WoutT = (bfraw*)(p.ws + WS_WOUT);
  bfraw* WupT = (bfraw*)(p.ws + WS_WUP); bfraw* WdnT = (bfraw*)(p.ws + WS_WDN);
  bfraw* XB = (bfraw*)(p.ws + WS_XB);
  constexpr int PER_L = 768 + 256 + 1024 + 1024, NW = DEPTH * PER_L, NX = TT / 16;
  for (int it0 = blockIdx.x * 2; it0 < NW + NX; it0 += vgrid()) {
    const int it = min(it0 + half_id(), NW + NX - 1);
    if (it < NW) {
      const int l = it / PER_L; int r = it % PER_L;
      if (r < 768) prep_transpose(p.w_in + (size_t)l * D * DIN, DIN, D, (r & 15) * 64, (r >> 4) * 64, WinT + (size_t)l * NIN * D, true, (float*)lds);
      else if (r < 1024) { r -= 768; prep_transpose(p.w_out + (size_t)l * D * D, D, D, (r & 15) * 64, (r >> 4) * 64, WoutT + (size_t)l * D * D, false, (float*)lds); }
      else if (r < 2048) { r -= 1024; prep_transpose(p.w_up + (size_t)l * D * DFF, DFF, D, (r & 15) * 64, (r >> 4) * 64, WupT + (size_t)l * DFF * D, false, (float*)lds); }
      else { r -= 2048; prep_transpose(p.w_down + (size_t)l * DFF * D, D, DFF, (r & 63) * 64, (r >> 6) * 64, WdnT + (size_t)l * D * DFF, false, (float*)lds); }
    } else {
      const int tid0 = fresh_tid();
      const int row0 = (it - NW) * 16;
      const float* src = row0 < TP ? p.x_prompt + (size_t)row0 * D : p.x_sample + (size_t)(row0 - TP) * D;
      bfraw* dst = XB + (size_t)row0 * D;
#pragma unroll 4
      for (int i = 0; i < 16; ++i) {
        const int idx = (tid0 + 256 * i) * 4;
        const float4 v = NTLD(src + idx);
        uint2 o; o.x = pack2(v.x, v.y); o.y = pack2(v.z, v.w);
        *(uint2*)(dst + idx) = o;
      }
    }
  }
}

enum { EPI_INPROJ = 0, EPI_RESID = 1, EPI_UP = 2, EPI_RESID_IN = 3 };

template <int EPI, int MI, int NI>
DI void gemm_epilogue(const Params& p, int layer, f32x16 (&acc)[MI][NI], int m0, int rbase, int nc0, int r32, int h, bool from_input) {
  if (EPI == EPI_INPROJ) {
    bfraw* QKV = (bfraw*)(p.ws + WS_QKV);
    if (nc0 < QKVW) {
      const int which = nc0 / 384;
      const float scale = (which == 0 || which == 3) ? 0.125f : 1.f;
      const int colin = nc0 - which * 384;
      const size_t offp = which == 1 ? O_PFK : which == 2 ? O_PFV : which == 4 ? O_PSK : O_PSV;
      const size_t offs = which == 1 ? O_SFK : which == 2 ? O_SFV : which == 4 ? O_SSK : O_SSV;
      const bool has_out = (which == 1 || which == 2 || which == 4 || which == 5);
      float* outP = p.out + offp + (size_t)layer * TP * 384 + colin + r32;
      float* outS = p.out + offs + ((size_t)layer * TS * 384 - (size_t)TP * 384) + colin + r32;
#pragma unroll
      for (int mi = 0; mi < MI; ++mi)
#pragma unroll
        for (int ni = 0; ni < NI; ++ni)
#pragma unroll
          for (int i = 0; i < 16; ++i) {
            const int row = m0 + rbase + mi * 32 + (i & 3) + 8 * (i >> 2) + 4 * h;
            const float v = acc[mi][ni][i];
            QKV[(size_t)row * QKVW + nc0 + ni * 32 + r32] = (bfraw)(pack2(v * scale, 0.f) & 0xffffu);
            if (has_out) { float* ob = row < TP ? outP : outS; ob[(size_t)row * 384 + ni * 32] = v; }
          }
    } else if (nc0 < 2560) {
      bfraw* U = (bfraw*)(p.ws + WS_U);
#pragma unroll
      for (int mi = 0; mi < MI; ++mi)
#pragma unroll
        for (int ni = 0; ni < NI; ++ni)
#pragma unroll
          for (int i = 0; i < 16; ++i) {
            const int rl = rbase + mi * 32 + (i & 3) + 8 * (i >> 2) + 4 * h;
            const int col = ni * 32 + r32;
            U[(size_t)(m0 + rl) * 256 + (nc0 - 2304) + col] = (bfraw)(pack2(gelu_tanh(acc[mi][ni][i]), 0.f) & 0xffffu);
          }
    } else if (nc0 < 2816) {
      float* VG = (float*)(p.ws + WS_VG);
#pragma unroll
      for (int mi = 0; mi < MI; ++mi)
#pragma unroll
        for (int ni = 0; ni < NI; ++ni)
#pragma unroll
          for (int i = 0; i < 16; ++i) {
            const int rl = rbase + mi * 32 + (i & 3) + 8 * (i >> 2) + 4 * h;
            const int col = ni * 32 + r32;
            VG[(size_t)(m0 + rl) * 256 + (nc0 - 2560) + col] = gelu_tanh(acc[mi][ni][i]);
          }
    } else if (nc0 == 2816) {
      if (r32 < 6) {
        float* LOGF = (float*)(p.ws + WS_LOGF);
        float* outP = p.out + O_PFL + (size_t)layer * TP * 6 + r32;
        float* outS = p.out + O_SFL + ((size_t)layer * TS * 6 - (size_t)TP * 6) + r32;
        const float bias = p.b_f[layer * 6 + r32];
#pragma unroll
        for (int mi = 0; mi < MI; ++mi)
#pragma unroll
          for (int i = 0; i < 16; ++i) {
            const int row = m0 + rbase + mi * 32 + (i & 3) + 8 * (i >> 2) + 4 * h;
            const float lf = log_sigmoid(acc[mi][0][i] + bias);
            LOGF[(size_t)row * 8 + r32] = lf;
            float* ob = row < TP ? outP : outS;
            ob[(size_t)row * 6] = lf;
          }
      }
    }
  } else if (EPI == EPI_RESID_IN) {
    unsigned char* Yb = p.ws + WS_Y;
    const float* xp = p.x_prompt + nc0 + r32;
    const float* xs = p.x_sample - (size_t)TP * D + nc0 + r32;
    const unsigned o0 = (unsigned)(((m0 + rbase + 4 * h) * D + nc0 + r32) * 4);
#pragma unroll
    for (int mi = 0; mi < MI; ++mi) {
      float xr[NI][16];
#pragma unroll
      for (int ni = 0; ni < NI; ++ni)
#pragma unroll
        for (int i = 0; i < 16; ++i) {
          const int row = m0 + rbase + 4 * h + mi * 32 + (i & 3) + 8 * (i >> 2);
          xr[ni][i] = (row < TP ? xp : xs)[(size_t)row * D + ni * 32];
        }
#pragma unroll
      for (int ni = 0; ni < NI; ++ni)
#pragma unroll
        for (int i = 0; i < 16; ++i)
          *(float*)(Yb + (o0 + (unsigned)(((mi * 32 + (i & 3) + 8 * (i >> 2)) * D + ni * 32) * 4))) = ALPHA * xr[ni][i] + acc[mi][ni][i];
    }
  } else if (EPI == EPI_RESID) {
    unsigned char* Yb = p.ws + WS_Y;
    const unsigned char* Xb = p.ws + WS_X32;
    const unsigned o0 = (unsigned)(((m0 + rbase + 4 * h) * D + nc0 + r32) * 4);
#pragma unroll
    for (int mi = 0; mi < MI; ++mi) {
      float xr[NI][16];
#pragma unroll
      for (int ni = 0; ni < NI; ++ni)
#pragma unroll
        for (int i = 0; i < 16; ++i)
          xr[ni][i] = *(const float*)(Xb + (o0 + (unsigned)(((mi * 32 + (i & 3) + 8 * (i >> 2)) * D + ni * 32) * 4)));
#pragma unroll
      for (int ni = 0; ni < NI; ++ni)
#pragma unroll
        for (int i = 0; i < 16; ++i)
          *(float*)(Yb + (o0 + (unsigned)(((mi * 32 + (i & 3) + 8 * (i >> 2)) * D + ni * 32) * 4))) = ALPHA * xr[ni][i] + acc[mi][ni][i];
    }
  } else {
    bfraw* H = (bfraw*)(p.ws + WS_H);
#pragma unroll
    for (int mi = 0; mi < MI; ++mi)
#pragma unroll
      for (int ni = 0; ni < NI; ++ni)
#pragma unroll
        for (int i = 0; i < 16; ++i) {
          const int rl = rbase + mi * 32 + (i & 3) + 8 * (i >> 2) + 4 * h;
          const int col = nc0 + ni * 32 + r32;
          const float v = fmaxf(acc[mi][ni][i], 0.f);
          H[(size_t)(m0 + rl) * DFF + col] = (bfraw)(pack2(v * v, 0.f) & 0xffffu);
        }
  }
}

template <int EPI, int MI, int NI>
__device__ void gemm_tile8(const Params& p, int layer, const bfraw* __restrict__ A, const bfraw* __restrict__ Bt, int K, int m0, int n0, unsigned char* ring, bool from_input,
                           bool first, bool has_next, int next_m0, int next_n0) {
  constexpr int WGM = NI == 2 ? 2 : 1, WGN = 8 / WGM;
  constexpr int BM = WGM * MI * 32;
  constexpr int STAGE = (BM + 256) * 128;
  constexpr int NAI = BM / 8;
  constexpr int NA = (NAI + 7) / 8;
  int tid = threadIdx.x; asm volatile("" : "+v"(tid));
  const int lane = tid & 63, wid = tid >> 6, wm = wid / WGN, wn = wid % WGN;
  const int r32 = lane & 31, h = lane >> 5;
  f32x16 acc[MI][NI];
#pragma unroll
  for (int a = 0; a < MI; ++a)
#pragma unroll
    for (int b = 0; b < NI; ++b)
#pragma unroll
      for (int i = 0; i < 16; ++i) acc[a][b][i] = 0.f;
  const int dc = (lane & 7) ^ (((wid & 1) * 4 + (lane >> 4)) & 7);
  const unsigned loff = (unsigned)(((wid * 8 + (lane >> 3)) * K + dc * 8) * 2);
  const unsigned char* ab = (const unsigned char*)(A + (size_t)m0 * K);
  const unsigned char* bb = (const unsigned char*)(Bt + (size_t)n0 * K);
  unsigned char* dl = ring + wid * 1024 + lane * 16;
#define ISSUE8A(ab, kt_, st_) do { \
    _Pragma("unroll") for (int j = 0; j < NA; ++j) { \
      if (NAI % 8 == 0 || j < NA - 1 || wid < NAI % 8) \
        __builtin_amdgcn_global_load_lds((const unsigned*)(ab + ((size_t)j * 64 * K + (kt_) * 64) * 2 + loff), (unsigned*)(dl + (st_) * STAGE + j * 8192), 16, 0, 0); } \
  } while (0)
#define ISSUE8B(bb, kt_, st_) do { \
    _Pragma("unroll") for (int j = 0; j < 4; ++j) \
      __builtin_amdgcn_global_load_lds((const unsigned*)(bb + ((size_t)j * 64 * K + (kt_) * 64) * 2 + loff), (unsigned*)(dl + (st_) * STAGE + BM * 128 + j * 8192), 16, 0, 0); \
  } while (0)
#define ISSUE8(ab, bb, kt_, st_) do { ISSUE8A(ab, kt_, st_); ISSUE8B(bb, kt_, st_); } while (0)
  const int key = (r32 >> 1) & 7;
  const unsigned char* afr = ring + (wm * (MI * 32) + r32) * 128;
  const unsigned char* bfr = ring + BM * 128 + (wn * (NI * 32) + r32) * 128;
  const int nk = K >> 6;
  const unsigned char* abn = (const unsigned char*)(A + (size_t)next_m0 * K);
  const unsigned char* bbn = (const unsigned char*)(Bt + (size_t)next_n0 * K);
  if (first) {
    asm volatile("s_waitcnt vmcnt(0)" ::: "memory");
    __builtin_amdgcn_s_barrier();
    asm volatile("" ::: "memory");
    ISSUE8(ab, bb, 0, 0);
  }
  int st = 0;
  for (int kt = 0; kt < nk; ++kt) {
    asm volatile("s_waitcnt vmcnt(0)" ::: "memory");
    __builtin_amdgcn_s_barrier();
    asm volatile("" ::: "memory");
    if (kt + 1 < nk) ISSUE8A(ab, kt + 1, st ^ 1);
    else if (has_next) ISSUE8A(abn, 0, st ^ 1);
    const unsigned char* as = afr + st * STAGE;
    const unsigned char* bs = bfr + st * STAGE;
#pragma unroll
    for (int ks = 0; ks < 4; ++ks) {
      if (ks == 2) { if (kt + 1 < nk) ISSUE8B(bb, kt + 1, st ^ 1); else if (has_next) ISSUE8B(bbn, 0, st ^ 1); }
      const int o = ((ks * 2 + h) ^ key) * 16;
      bf16x8 af[MI], bq[NI];
#pragma unroll
      for (int mi = 0; mi < MI; ++mi) af[mi] = *(const bf16x8*)(as + mi * 4096 + o);
#pragma unroll
      for (int ni = 0; ni < NI; ++ni) bq[ni] = *(const bf16x8*)(bs + ni * 4096 + o);
#pragma unroll
      for (int mi = 0; mi < MI; ++mi)
#pragma unroll
        for (int ni = 0; ni < NI; ++ni)
          acc[mi][ni] = __builtin_amdgcn_mfma_f32_32x32x16_bf16(af[mi], bq[ni], acc[mi][ni], 0, 0, 0);
    }
    st ^= 1;
  }
#undef ISSUE8
#undef ISSUE8A
#undef ISSUE8B
  gemm_epilogue<EPI, MI, NI>(p, layer, acc, m0, wm * (MI * 32), n0 + wn * (NI * 32), r32, h, from_input);
}

template <int EPI, int MI, int NI>
__device__ void phase_gemm8(const Params& p, int layer, const bfraw* A, const bfraw* Bt, int N, int K, unsigned char* ring, bool from_input = false) {
  constexpr int BM = (NI == 2 ? 2 : 1) * MI * 32;
  const int ntn = N / 256, ntiles = (TT / BM) * ntn;
  for (int t = blockIdx.x; t < ntiles; t += gridDim.x) {
    const int tm = t / ntn, tn = t % ntn;
    const int t2 = t + gridDim.x;
    const bool has_next = t2 < ntiles;
    const int tm2 = has_next ? t2 / ntn : tm, tn2 = has_next ? t2 % ntn : tn;
    gemm_tile8<EPI, MI, NI>(p, layer, A, Bt, K, tm * BM, tn * 256, ring, from_input, t == (int)blockIdx.x, has_next, tm2 * BM, tn2 * 256);
  }
  __syncthreads();
}

__device__ void phase_ln(const Params& p, const float* __restrict__ gam, const float* __restrict__ bet, bool last) {
  const float* Y = (const float*)(p.ws + WS_Y);
  float* X32 = (float*)(p.ws + WS_X32);
  bfraw* XB = (bfraw*)(p.ws + WS_XB);
  const int tid_ = fresh_tid(); const int lane = tid_ & 63, wid = tid_ >> 6;
  for (int row = vblock() * 4 + wid; row < TT; row += vgrid() * 4) {
    const float* y = Y + (size_t)row * D;
    float4 v[4];
#pragma unroll
    for (int j = 0; j < 4; ++j) v[j] = *(const float4*)(y + lane * 4 + 256 * j);
    float s = 0.f;
#pragma unroll
    for (int j = 0; j < 4; ++j) s += v[j].x + v[j].y + v[j].z + v[j].w;
    const float mu = wave_sum(s) * (1.f / D);
    float q = 0.f;
#pragma unroll
    for (int j = 0; j < 4; ++j) { v[j].x -= mu; v[j].y -= mu; v[j].z -= mu; v[j].w -= mu; q += v[j].x * v[j].x + v[j].y * v[j].y + v[j].z * v[j].z + v[j].w * v[j].w; }
    const float rstd = rsqrtf(wave_sum(q) * (1.f / D) + 1e-5f);
#pragma unroll
    for (int j = 0; j < 4; ++j) {
      const int c = lane * 4 + 256 * j;
      const float4 g = *(const float4*)(gam + c), b = *(const float4*)(bet + c);
      float4 o;
      o.x = v[j].x * rstd * g.x + b.x; o.y = v[j].y * rstd * g.y + b.y; o.z = v[j].z * rstd * g.z + b.z; o.w = v[j].w * rstd * g.w + b.w;
      if (last) {
        *(float4*)(p.out + (size_t)row * D + c) = o;
      } else {
        *(float4*)(X32 + (size_t)row * D + c) = o;
        uint2 ob; ob.x = pack2(o.x, o.y); ob.y = pack2(o.z, o.w);
        *(uint2*)(XB + (size_t)row * D + c) = ob;
      }
    }
  }
}

DI float wave_incl_scan(float v, int lane) {
#pragma unroll
  for (int o = 1; o < 64; o <<= 1) { const float t = __shfl_up(v, o); if (lane >= o) v += t; }
  return v;
}
__device__ void phase_scan(const Params& p, int layer, unsigned char* lds) {
  const float* LOGF = (const float*)(p.ws + WS_LOGF);
  float* C = (float*)(p.ws + WS_C);
  float* CC = (float*)(p.ws + WS_CC);
  float* red = (float*)lds;
  const int tid = fresh_tid(), lane = tid & 63, wid = tid >> 6;
  {
    const bfraw* QKV = (const bfraw*)(p.ws + WS_QKV);
    unsigned* kmx = (unsigned*)(p.ws + WS_CTL) + KMAX_WORD + 64 * layer;
    for (int it = vblock(); it < 24 * 16; it += vgrid()) {
      const int bh = it >> 4, b = bh / 6, h = bh % 6, pos = (it & 15) * 256 + tid;
      const uint4* kp = (const uint4*)(QKV + (size_t)(b * SEQ + pos) * QKVW + 384 + h * 64);
      float ss = 0.f;
#pragma unroll
      for (int i = 0; i < 8; ++i) {
        const uint4 u = kp[i];
        const unsigned w[4] = {u.x, u.y, u.z, u.w};
#pragma unroll
        for (int k = 0; k < 4; ++k) { const float a = __uint_as_float(w[k] << 16), c = __uint_as_float(w[k] & 0xffff0000u); ss += a * a + c * c; }
      }
#pragma unroll
      for (int o = 32; o > 0; o >>= 1) ss = fmaxf(ss, __shfl_xor(ss, o));
      if (lane == 0) atomicMax(&kmx[bh], __float_as_uint(ss));
    }
  }
  for (int seq0 = blockIdx.x * 2; seq0 < 24 + 192; seq0 += vgrid()) {
    const int seq = min(seq0 + half_id(), 24 + 192 - 1);
    const bool pr = seq < 24;
    const int s = pr ? seq : seq - 24, b = s / 6, h = s % 6;
    float v[16];
    if (pr) {
      const float* base = LOGF + ((size_t)b * SEQ + tid * 16) * 8 + h;
#pragma unroll
      for (int i = 0; i < 16; ++i) v[i] = base[i * 8];
    } else {
      const float* base = p.cfl + (((size_t)layer * DECB + b) * PAST + tid * 8) * 6 + h;
#pragma unroll
      for (int i = 0; i < 8; ++i) v[i] = base[i * 6];
#pragma unroll
      for (int i = 8; i < 16; ++i) v[i] = 0.f;
    }
#pragma unroll
    for (int i = 1; i < 16; ++i) v[i] += v[i - 1];
    const float tot = v[15];
    const float inc = wave_incl_scan(tot, lane);
    if (lane == 63) red[wid] = inc;
    __syncthreads();
    const float r0 = red[0], r1 = red[1], r2 = red[2], r3 = red[3];
    float off = inc - tot;
    off += (wid > 0 ? r0 : 0.f) + (wid > 1 ? r1 : 0.f) + (wid > 2 ? r2 : 0.f);
    if (pr) {
      float* dst = C + ((size_t)b * SEQ + tid * 16) * 8 + h;
#pragma unroll
      for (int i = 0; i < 16; ++i) dst[i * 8] = off + v[i];
    } else {
      float* dst = CC + ((size_t)b * PAST + tid * 8) * 8 + h;
#pragma unroll
      for (int i = 0; i < 8; ++i) dst[i * 8] = off + v[i];
      if (wid == 0) {
        const size_t idx = ((size_t)TP + b * DECS + lane) * 8 + h;
        C[idx] = ((r0 + r1) + (r2 + r3)) + wave_incl_scan(LOGF[idx], lane);
      }
    }
    __syncthreads();
  }
}

__device__ void attn_item(const Params& p, int layer, int type, bool sample, int b, int h, int qb, unsigned char* lds, volatile LAS int* flg) {
  const bfraw* QKV = (const bfraw*)(p.ws + WS_QKV);
  const float* C = (const float*)(p.ws + WS_C);
  const float* CC = (const float*)(p.ws + WS_CC);
  bfraw* O = (bfraw*)(p.ws + WS_O);
  const int tid = fresh_tid(), lane = tid & 63, wid = tid >> 6, l15 = lane & 15, g = lane >> 4;
  const int qrow0 = sample ? TP + b * DECS : b * SEQ + qb * 64;
  const int ntiles = sample ? 33 : qb + 1;
  const int qoff = type ? 1152 : 0, koff = qoff + 384, voff = qoff + 768, hc = h * 64;
  const int qrow = qrow0 + wid * 16 + l15;
  const bfraw* qp = QKV + (size_t)qrow * QKVW + qoff + hc + g * 8;
  const bf16x8 q0 = *(const bf16x8*)qp, q1 = *(const bf16x8*)(qp + 32);
  float cq2 = 0.f;
  if (type == 0) cq2 = C[(size_t)qrow * 8 + h] * LOG2E;
  const bool fexit = (type == 0) && !sample;
  float bqk = 0.f, cnext = 0.f;
  if (fexit) {
    float qs = 0.f;
#pragma unroll
    for (int i = 0; i < 8; ++i) { const float a = bf2f((bfraw)q0[i]), c = bf2f((bfraw)q1[i]); qs += a * a + c * c; }
    qs += __shfl_xor(qs, 16); qs += __shfl_xor(qs, 32);
    const float kmax2 = __uint_as_float(((const unsigned*)(p.ws + WS_CTL))[KMAX_WORD + 64 * layer + b * 6 + h]);
    bqk = sqrtf(qs * kmax2) * (LOG2E * 1.01f) + 1.f;
  }
  const float* kcache = type ? p.csk : p.cfk;
  const float* vcache = type ? p.csv : p.cfv;

  float4 st[8]; float stc = 0.f;
  const int key_l = tid >> 3, dc = tid & 7;
  unsigned char* kd = lds + key_l * 144 + dc * 16;
  unsigned char* vd = kd + 9216;
  float* ckl = (float*)(lds + 18432);

#define ATTN_PREFETCH(t_)                                                                                         \
  do {                                                                                                            \
    const int tt_ = (t_);                                                                                         \
    if (!(sample && tt_ < 32)) {                                                                                  \
      const int krow = sample ? TP + b * DECS : b * SEQ + tt_ * 64;                                               \
      const bfraw* kp = QKV + (size_t)(krow + key_l) * QKVW + hc + dc * 8;                                        \
      st[0] = *(const float4*)(kp + koff); st[1] = *(const float4*)(kp + koff + 32 * QKVW);                       \
      st[2] = *(const float4*)(kp + voff); st[3] = *(const float4*)(kp + voff + 32 * QKVW);                       \
      if (type == 0 && tid < 64) stc = C[(size_t)(krow + tid) * 8 + h];                                           \
    } else {                                                                                                      \
      const size_t off = ((((size_t)layer * DECB + b) * PAST + tt_ * 64 + key_l) * 6 + h) * 64 + dc * 8;          \
      const float* kc = kcache + off; const float* vc = vcache + off;                                             \
      st[0] = NTLD(kc); st[1] = NTLD((kc + 4));                                               \
      st[2] = NTLD((kc + 32 * 384)); st[3] = NTLD((kc + 32 * 384 + 4));                       \
      st[4] = NTLD(vc); st[5] = NTLD((vc + 4));                                               \
      st[6] = NTLD((vc + 32 * 384)); st[7] = NTLD((vc + 32 * 384 + 4));                       \
      if (type == 0 && tid < 64) stc = CC[((size_t)b * PAST + tt_ * 64 + tid) * 8 + h];                           \
    }                                                                                                             \
  } while (0)

  f32x4 oacc[4];
#pragma unroll
  for (int i = 0; i < 4; ++i) oacc[i] = (f32x4){0.f, 0.f, 0.f, 0.f};
  float m = -1e30f, lsum = 0.f, R = 0.f;
  const int ql = wid * 16 + l15;
  const int i16 = l15, qq = i16 >> 2, pp = i16 & 3;
  const unsigned char* vtr = lds + 9216 + (4 * g + qq) * 144 + pp * 8;

  ATTN_PREFETCH(ntiles - 1);
  for (int t = ntiles - 1; t >= 0; --t) {
    if (!(sample && t < 32)) {
      *(float4*)kd = st[0]; *(float4*)(kd + 32 * 144) = st[1]; *(float4*)vd = st[2]; *(float4*)(vd + 32 * 144) = st[3];
    } else {
      uint4 a;
      a.x = pack2(st[0].x, st[0].y); a.y = pack2(st[0].z, st[0].w); a.z = pack2(st[1].x, st[1].y); a.w = pack2(st[1].z, st[1].w); *(uint4*)kd = a;
      a.x = pack2(st[2].x, st[2].y); a.y = pack2(st[2].z, st[2].w); a.z = pack2(st[3].x, st[3].y); a.w = pack2(st[3].z, st[3].w); *(uint4*)(kd + 32 * 144) = a;
      a.x = pack2(st[4].x, st[4].y); a.y = pack2(st[4].z, st[4].w); a.z = pack2(st[5].x, st[5].y); a.w = pack2(st[5].z, st[5].w); *(uint4*)vd = a;
      a.x = pack2(st[6].x, st[6].y); a.y = pack2(st[6].z, st[6].w); a.z = pack2(st[7].x, st[7].y); a.w = pack2(st[7].z, st[7].w); *(uint4*)(vd + 32 * 144) = a;
    }
    if (type == 0 && tid < 64) ckl[tid] = stc * LOG2E;
    __syncthreads();
    if (t > 0) ATTN_PREFETCH(t - 1);
    if (fexit && t > 0) cnext = C[(size_t)(b * SEQ + (t - 1) * 64 + 63) * 8 + h];
    const bool diag = (t == ntiles - 1);

    f32x4 s[4];
#pragma unroll
    for (int kb = 0; kb < 4; ++kb) {
      const unsigned char* ka = lds + (kb * 16 + l15) * 144 + g * 16;
      const bf16x8 a0 = *(const bf16x8*)ka, a1 = *(const bf16x8*)(ka + 64);
      f32x4 z = (f32x4){0.f, 0.f, 0.f, 0.f};
      z = __builtin_amdgcn_mfma_f32_16x16x32_bf16(a0, q0, z, 0, 0, 0);
      s[kb] = __builtin_amdgcn_mfma_f32_16x16x32_bf16(a1, q1, z, 0, 0, 0);
    }
    unsigned pk[8];
    if (type == 0) {
      float mx = -1e30f;
#pragma unroll
      for (int kb = 0; kb < 4; ++kb) {
        const f32x4 ck = *(const f32x4*)(ckl + kb * 16 + 4 * g);
#pragma unroll
        for (int j = 0; j < 4; ++j) {
          float x = s[kb][j] * LOG2E + cq2 - ck[j];
          if (diag && (kb * 16 + 4 * g + j > ql)) x = -1e30f;
          s[kb][j] = x; mx = fmaxf(mx, x);
        }
      }
      mx = fmaxf(mx, __shfl_xor(mx, 16)); mx = fmaxf(mx, __shfl_xor(mx, 32));
      const float mnew = fmaxf(m, mx);
      const float alpha = ex2(m - mnew);
      m = mnew;
      float ps = 0.f;
#pragma unroll
      for (int kb = 0; kb < 4; ++kb) {
        const float p0 = ex2(s[kb][0] - mnew), p1 = ex2(s[kb][1] - mnew), p2 = ex2(s[kb][2] - mnew), p3 = ex2(s[kb][3] - mnew);
        ps += (p0 + p1) + (p2 + p3);
        pk[kb * 2] = pack2(p0, p1); pk[kb * 2 + 1] = pack2(p2, p3);
      }
      lsum = lsum * alpha + ps;
#pragma unroll
      for (int db = 0; db < 4; ++db) oacc[db] *= alpha;
    } else {
      float lr[4][4];
#pragma unroll
      for (int kb = 0; kb < 4; ++kb)
#pragma unroll
        for (int j = 0; j < 4; ++j) {
          const float z2 = s[kb][j] * LOG2E;
          const float e = ex2(-fabsf(z2));
          float l = -(fmaxf(z2, 0.f) + lg2(1.f + e));
          if (diag && !(kb * 16 + 4 * g + j < ql)) l = 0.f;
          s[kb][j] = z2; lr[kb][j] = l;
        }
#pragma unroll
      for (int kb = 3; kb >= 0; --kb) {
        const float G = (lr[kb][0] + lr[kb][1]) + (lr[kb][2] + lr[kb][3]);
        const float a = __shfl_xor(G, 16), bb = __shfl_xor(G, 32), c = __shfl_xor(G, 48);
        const float tot = (G + a) + (bb + c);
        const float gt = ((g == 0 || g == 2) ? a : 0.f) + ((g < 2) ? (bb + c) : 0.f);
        const float a3 = R + gt, a2 = a3 + lr[kb][3], a1 = a2 + lr[kb][2], a0 = a1 + lr[kb][1];
        float p0 = ex2(s[kb][0] + lr[kb][0] + a0), p1 = ex2(s[kb][1] + lr[kb][1] + a1);
        float p2 = ex2(s[kb][2] + lr[kb][2] + a2), p3 = ex2(s[kb][3] + lr[kb][3] + a3);
        if (diag) {
          const int k0 = kb * 16 + 4 * g;
          if (!(k0 < ql)) p0 = 0.f;
          if (!(k0 + 1 < ql)) p1 = 0.f;
          if (!(k0 + 2 < ql)) p2 = 0.f;
          if (!(k0 + 3 < ql)) p3 = 0.f;
        }
        pk[kb * 2] = pack2(p0, p1); pk[kb * 2 + 1] = pack2(p2, p3);
        R += tot;
      }
      const int alldone = __all(R < SB_EXIT) ? 1 : 0;
      if (lane == 0) flg[half_id() * 4 + wid] = alldone;
    }
    if (fexit) {
      const int done = (t > 0 && __all(bqk + cq2 - cnext * LOG2E - m < FOX_EXIT)) ? 1 : 0;
      if (lane == 0) flg[half_id() * 4 + wid] = done;
    }
#pragma unroll
    for (int kk = 0; kk < 2; ++kk) {
      const uint4 pu = {pk[kk * 4], pk[kk * 4 + 1], pk[kk * 4 + 2], pk[kk * 4 + 3]};
      const bf16x8 pf = __builtin_bit_cast(bf16x8, pu);
#pragma unroll
      for (int db = 0; db < 4; ++db) {
        const unsigned char* va = vtr + (32 * kk) * 144 + db * 32;
        const s16x4 lo = __builtin_amdgcn_ds_read_tr16_b64_v4i16((LAS s16x4*)(va));
        const s16x4 hi = __builtin_amdgcn_ds_read_tr16_b64_v4i16((LAS s16x4*)(va + 16 * 144));
        const bf16x8 vf = __builtin_shufflevector(lo, hi, 0, 1, 2, 3, 4, 5, 6, 7);
        oacc[db] = __builtin_amdgcn_mfma_f32_16x16x32_bf16(vf, pf, oacc[db], 0, 0, 0);
      }
    }
    __syncthreads();
    if (type == 1 || fexit) { if (flg[0] & flg[1] & flg[2] & flg[3] & flg[4] & flg[5] & flg[6] & flg[7]) break; }
  }
#undef ATTN_PREFETCH
  if (type == 0) {
    lsum += __shfl_xor(lsum, 16); lsum += __shfl_xor(lsum, 32);
    const float inv = 1.f / lsum;
#pragma unroll
    for (int db = 0; db < 4; ++db) oacc[db] *= inv;
  }
  float ss = 0.f;
#pragma unroll
  for (int db = 0; db < 4; ++db)
#pragma unroll
    for (int j = 0; j < 4; ++j) ss += oacc[db][j] * oacc[db][j];
  ss += __shfl_xor(ss, 16); ss += __shfl_xor(ss, 32);
  const float rs = rsqrtf(ss * (1.f / 64.f) + 1e-6f);
  const int hoff = type ? 640 + hc : hc;
#pragma unroll
  for (int db = 0; db < 4; ++db) {
    const int d0 = 16 * db + 4 * g;
    const float4 gm = *(const float4*)(p.g_mix + layer * D + hoff + d0);
    uint2 o;
    o.x = pack2(oacc[db][0] * rs * gm.x, oacc[db][1] * rs * gm.y);
    o.y = pack2(oacc[db][2] * rs * gm.z, oacc[db][3] * rs * gm.w);
    *(uint2*)(O + (size_t)qrow * D + hoff + d0) = o;
  }
}

__device__ void sgu_item(const Params& p, int layer, bool sample, int ci, int g, unsigned char* lds) {
  const float* VG = (const float*)(p.ws + WS_VG);
  const bfraw* U = (const bfraw*)(p.ws + WS_U);
  bfraw* O = (bfraw*)(p.ws + WS_O);
  constexpr int LROW = 272;
  unsigned char* Wl = lds;
  unsigned char* Vt = lds + 128 * LROW;
  const int tid = fresh_tid(), lane = tid & 63, wid = tid >> 6;
  const int r0 = sample ? TP + ci * DECS : ci * 128;
  const int L = sample ? 64 : 128;
  {
    const float4 gv = *(const float4*)(p.g_v + layer * 256 + lane * 4), bv = *(const float4*)(p.b_v + layer * 256 + lane * 4);
    for (int i = wid; i < L; i += 4) {
      float4 v = *(const float4*)(VG + (size_t)(r0 + i) * 256 + lane * 4);
      const float mu = wave_sum(v.x + v.y + v.z + v.w) * (1.f / 256.f);
      v.x -= mu; v.y -= mu; v.z -= mu; v.w -= mu;
      const float rstd = rsqrtf(wave_sum(v.x * v.x + v.y * v.y + v.z * v.z + v.w * v.w) * (1.f / 256.f) + 1e-5f);
      float4 o;
      o.x = v.x * rstd * gv.x + bv.x; o.y = v.y * rstd * gv.y + bv.y; o.z = v.z * rstd * gv.z + bv.z; o.w = v.w * rstd * gv.w + bv.w;
      if ((lane >> 4) == g) {
        const unsigned lo = pack2(o.x, o.y), hi = pack2(o.z, o.w);
        unsigned char* vp = Vt + ((lane & 15) * 4) * LROW + i * 2;
        *(bfraw*)(vp) = (bfraw)(lo & 0xffffu); *(bfraw*)(vp + LROW) = (bfraw)(lo >> 16);
        *(bfraw*)(vp + 2 * LROW) = (bfraw)(hi & 0xffffu); *(bfraw*)(vp + 3 * LROW) = (bfraw)(hi >> 16);
        if (sample) *(float4*)(p.out + O_SGV + ((size_t)layer * TS + (r0 - TP) + i) * 256 + lane * 4) = o;
      }
    }
    const float* wg = p.w_s + ((size_t)layer * 4 + g) * 128 * 128;
#pragma unroll 4
    for (int k = 0; k < 16; ++k) {
      const int idx = tid + 256 * k, row = idx >> 5, c4 = (idx & 31) * 4;
      if (row < L) {
        const float4 w = *(const float4*)(wg + row * 128 + c4);
        uint2 o;
        o.x = pack2(c4 <= row ? w.x : 0.f, c4 + 1 <= row ? w.y : 0.f);
        o.y = pack2(c4 + 2 <= row ? w.z : 0.f, c4 + 3 <= row ? w.w : 0.f);
        *(uint2*)(Wl + row * LROW + c4 * 2) = o;
      }
    }
  }
  __syncthreads();
  if (wid * 32 < L) {
    const int r32 = lane & 31, h = lane >> 5;
    f32x16 acc[2];
#pragma unroll
    for (int ni = 0; ni < 2; ++ni)
#pragma unroll
      for (int i = 0; i < 16; ++i) acc[ni][i] = 0.f;
    const unsigned char* ap = Wl + (wid * 32 + r32) * LROW + h * 16;
    const unsigned char* bp = Vt + r32 * LROW + h * 16;
    const int nks = min(L / 16, 2 * (wid + 1));
    for (int ks = 0; ks < nks; ++ks) {
      const bf16x8 a = *(const bf16x8*)(ap + ks * 32);
      const bf16x8 b0 = *(const bf16x8*)(bp + ks * 32), b1 = *(const bf16x8*)(bp + 32 * LROW + ks * 32);
      acc[0] = __builtin_amdgcn_mfma_f32_32x32x16_bf16(a, b0, acc[0], 0, 0, 0);
      acc[1] = __builtin_amdgcn_mfma_f32_32x32x16_bf16(a, b1, acc[1], 0, 0, 0);
    }
    const float* bsp = p.b_s + ((size_t)layer * 4 + g) * 128 + wid * 32 + 4 * h;
    const float* gm = p.g_mix + layer * D + 384 + g * 64 + r32;
    const float gm0 = gm[0], gm1 = gm[32];
    const size_t rowb = (size_t)(r0 + wid * 32 + 4 * h);
#pragma unroll
    for (int i = 0; i < 16; ++i) {
      const int rl = (i & 3) + 8 * (i >> 2);
      const float bs = bsp[rl];
      const bfraw* up = U + (rowb + rl) * 256 + g * 64 + r32;
      const float o0 = bf2f(up[0]) * (acc[0][i] + bs), o1 = bf2f(up[32]) * (acc[1][i] + bs);
      float ss = o0 * o0 + o1 * o1;
      ss += __shfl_xor(ss, 1); ss += __shfl_xor(ss, 2); ss += __shfl_xor(ss, 4); ss += __shfl_xor(ss, 8); ss += __shfl_xor(ss, 16);
      const float rs = rsqrtf(ss * (1.f / 64.f) + 1e-6f);
      bfraw* op = O + (rowb + rl) * D + 384 + g * 64 + r32;
      op[0] = (bfraw)(pack2(o0 * rs * gm0, 0.f) & 0xffffu);
      op[32] = (bfraw)(pack2(o1 * rs * gm1, 0.f) & 0xffffu);
    }
  }
  __syncthreads();
}

__device__ void phase_mix(const Params& p, int layer, unsigned char* lds, volatile LAS int* slot) {
  unsigned* ctr = (unsigned*)(p.ws + WS_CTL) + QCTR_WORD + 64 * layer;
  volatile LAS int* flg = slot + 4;
  constexpr int N_SAMPLE = 384, N_PROMPT = 3072, N_SGU = 640, N_ALL = N_SAMPLE + N_PROMPT + N_SGU;
  for (;;) {
    if (threadIdx.x == 0) *slot = (int)atomicAdd(ctr, 1u);
    __syncthreads();
    const int item = *slot * 2 + half_id();
    __syncthreads();
    if (item >= N_ALL) break;
    if (item < N_SAMPLE) {
      const int type = item < 192 ? 1 : 0, r = item % 192;
      attn_item(p, layer, type, true, r / 6, r % 6, 0, lds, flg);
    } else if (item < N_SAMPLE + N_SGU) {
      int r = item - N_SAMPLE;
      if (r < 512) sgu_item(p, layer, false, r >> 2, r & 3, lds);
      else { r -= 512; sgu_item(p, layer, true, r >> 2, r & 3, lds); }
    } else {
      const int r = item - N_SAMPLE - N_SGU, type = r < 1536 ? 0 : 1, r2 = r % 1536, qb = 63 - r2 / 24, bh = r2 % 24;
      attn_item(p, layer, type, false, bh / 6, bh % 6, qb, lds, flg);
    }
  }
}

__device__ void run_phase(const Params& p, int ph, unsigned char* lds, unsigned char* ring, volatile LAS int* slot) {
  const bfraw* XB = (const bfraw*)(p.ws + WS_XB);
  if (ph == 0) { phase_prep(p, lds); return; }
  const int layer = (ph - 1) >> 3, sub = (ph - 1) & 7;
  switch (sub) {
    case 0: phase_gemm8<EPI_INPROJ, 9, 1>(p, layer, XB, (const bfraw*)(p.ws + WS_WIN) + (size_t)layer * NIN * D, NIN, D, ring); break;
    case 1: phase_scan(p, layer, lds); break;
    case 2: phase_mix(p, layer, lds, slot); break;
    case 3: if (layer == 0) phase_gemm8<EPI_RESID_IN, 9, 1>(p, layer, (const bfraw*)(p.ws + WS_O), (const bfraw*)(p.ws + WS_WOUT) + (size_t)layer * D * D, D, D, ring);
            else phase_gemm8<EPI_RESID, 9, 1>(p, layer, (const bfraw*)(p.ws + WS_O), (const bfraw*)(p.ws + WS_WOUT) + (size_t)layer * D * D, D, D, ring);
            break;
    case 4: phase_ln(p, p.ln1_g + layer * D, p.ln1_b + layer * D, false); break;
    case 5: phase_gemm8<EPI_UP, 9, 1>(p, layer, XB, (const bfraw*)(p.ws + WS_WUP) + (size_t)layer * DFF * D, DFF, D, ring); break;
    case 6: phase_gemm8<EPI_RESID, 9, 1>(p, layer, (const bfraw*)(p.ws + WS_H), (const bfraw*)(p.ws + WS_WDN) + (size_t)layer * D * DFF, D, DFF, ring); break;
    default: phase_ln(p, p.ln2_g + layer * D, p.ln2_b + layer * D, layer == DEPTH - 1); break;
  }
}

__global__ void __launch_bounds__(512, 2) fwd_kernel(Params p) {
  extern __shared__ __attribute__((aligned(16))) unsigned char smem[];
  unsigned char* lds = smem + LDS_DATA + half_id() * HALF_LDS;
  volatile LAS unsigned* st = (volatile LAS unsigned*)smem;
  volatile LAS int* slot = (volatile LAS int*)(smem + 16);
  if (threadIdx.x == 0) { st[0] = 0u; st[1] = 0u; st[2] = 0u; st[3] = 0u; }
  __syncthreads();
  XcdBarrier xb;
  xb.bar = (unsigned*)(p.ws + WS_CTL); xb.x = 0; xb.st = st;
  if (p.coop) xb = xcd_barrier_post((unsigned*)(p.ws + WS_CTL), st);
  for (int ph = p.ph_lo; ph < p.ph_hi; ++ph) {
    if (ph > p.ph_lo) {
      if (p.pad) cg::this_grid().sync();
      xcd_barrier(xb);
    }
    run_phase(p, ph, lds, smem + LDS_DATA, slot);
  }
}

extern "C" void kernel_launch(void* const* d_in, const int* in_sizes, int n_in, void* d_out, int out_size, void* d_ws, size_t ws_size,
                              hipStream_t stream) {
  static int grid = 0;
  if (grid == 0) {
    if (n_in != 21 || (size_t)out_size != O_END || ws_size < WS_END) {
      fprintf(stderr, "kernel_launch: unexpected shapes: n_in %d out %d (want %zu) ws %zu (want >= %zu)\n", n_in, out_size, (size_t)O_END, ws_size, (size_t)WS_END);
      grid = -1; return;
    }
    int dev = 0, cus = 0, per_cu = 0;
    hipGetDevice(&dev);
    hipDeviceGetAttribute(&cus, hipDeviceAttributeMultiprocessorCount, dev);
    if (hipFuncSetAttribute((const void*)fwd_kernel, hipFuncAttributeMaxDynamicSharedMemorySize, LDS_BYTES) != hipSuccess) {
      fprintf(stderr, "kernel_launch: hipFuncSetAttribute failed\n"); grid = -1; return;
    }
    hipOccupancyMaxActiveBlocksPerMultiprocessor(&per_cu, (const void*)fwd_kernel, 512, LDS_BYTES);
    if (per_cu < 1) { fprintf(stderr, "kernel_launch: occupancy query says %d\n", per_cu); per_cu = 1; }
    if (per_cu > 1) per_cu = 1;
    grid = cus * per_cu;
  }
  if (grid < 0) return;
  hipMemsetAsync((char*)d_ws + WS_CTL, 0, CTL_BYTES, stream);
  Params p{};
  const float** f = (const float**)&p;
  for (int i = 0; i < 21; ++i) f[i] = (const float*)d_in[i];
  p.out = (float*)d_out; p.ws = (unsigned char*)d_ws;
#if MK_MODE == 0
  for (int ph = 0; ph < NPHASE; ++ph) {
    p.ph_lo = ph; p.ph_hi = ph + 1; p.coop = 0; p.pad = 0;
    hipLaunchKernelGGL(fwd_kernel, dim3(grid), dim3(512), LDS_BYTES, stream, p);
  }
#else
  p.ph_lo = 0; p.ph_hi = NPHASE; p.coop = 1; p.pad = 0;
  void* args[] = {&p};
  hipError_t e = hipLaunchCooperativeKernel((const void*)fwd_kernel, dim3(grid), dim3(512), args, LDS_BYTES, stream);
  if (e != hipSuccess) fprintf(stderr, "cooperative launch failed: %s (grid %d)\n", hipGetErrorString(e), grid);
#endif
}
```

```cpp
#include <hip/hip_runtime.h>
#include <hip/hip_cooperative_groups.h>
#include <cstdio>
#include <cstdint>
namespace cg = cooperative_groups;

#ifndef MK_MODE
#define MK_MODE 1
#endif

#define DI __device__ __forceinline__
typedef unsigned short bfraw;
typedef __attribute__((ext_vector_type(8))) short bf16x8;
typedef __attribute__((ext_vector_type(4))) short s16x4;
typedef __attribute__((ext_vector_type(4))) float f32x4;
typedef __attribute__((ext_vector_type(16))) float f32x16;
typedef __attribute__((ext_vector_type(2))) __bf16 bf2_t;
typedef __attribute__((ext_vector_type(2))) float f2_t;
#define LAS __attribute__((address_space(3)))

DI unsigned pack2(float a, float b) { f2_t x = {a, b}; bf2_t y = __builtin_convertvector(x, bf2_t); return __builtin_bit_cast(unsigned, y); }
DI float bf2f(bfraw v) { return __uint_as_float(((unsigned)v) << 16); }
DI int fresh_tid() { int t = threadIdx.x & 255; asm volatile("" : "+v"(t)); return t; }
DI int half_id() { return __builtin_amdgcn_readfirstlane((int)(threadIdx.x >> 8)); }
DI int vblock() { return (int)blockIdx.x * 2 + half_id(); }
DI int vgrid() { return (int)gridDim.x * 2; }
DI float4 ntld4(const float* p) { const f32x4 v = __builtin_nontemporal_load((const f32x4*)p); return make_float4(v[0], v[1], v[2], v[3]); }
#define NTLD(p_) ntld4((const float*)(p_))
DI float ex2(float x) { return __builtin_amdgcn_exp2f(x); }
DI float lg2(float x) { return __builtin_amdgcn_logf(x); }

constexpr int D = 1024, TP = 16384, TS = 2048, TT = TP + TS, SEQ = 4096, DECB = 32, DECS = 64, PAST = 2048;
constexpr int NIN = 3072, DFF = 4096, DEPTH = 2, QKVW = 2304, DIN = 2822;
constexpr float ALPHA = 1.41421356237309515f;
constexpr float LOG2E = 1.44269504088896341f;
constexpr float LN2 = 0.69314718055994531f;
constexpr float SB_EXIT = -160.f;
constexpr float FOX_EXIT = -160.f;
constexpr int KMAX_WORD = 12288;

constexpr size_t O_YP = 0;
constexpr size_t O_YS = O_YP + (size_t)TP * D;
constexpr size_t O_PFK = O_YS + (size_t)TS * D;
constexpr size_t O_PFV = O_PFK + (size_t)DEPTH * TP * 384;
constexpr size_t O_PFL = O_PFV + (size_t)DEPTH * TP * 384;
constexpr size_t O_PSK = O_PFL + (size_t)DEPTH * TP * 6;
constexpr size_t O_PSV = O_PSK + (size_t)DEPTH * TP * 384;
constexpr size_t O_SFK = O_PSV + (size_t)DEPTH * TP * 384;
constexpr size_t O_SFV = O_SFK + (size_t)DEPTH * TS * 384;
constexpr size_t O_SFL = O_SFV + (size_t)DEPTH * TS * 384;
constexpr size_t O_SSK = O_SFL + (size_t)DEPTH * TS * 6;
constexpr size_t O_SSV = O_SSK + (size_t)DEPTH * TS * 384;
constexpr size_t O_SGV = O_SSV + (size_t)DEPTH * TS * 384;
constexpr size_t O_END = O_SGV + (size_t)DEPTH * TS * 256;

constexpr size_t WS_CTL = 0;
constexpr size_t CTL_BYTES = 65536;
constexpr size_t WS_WIN = WS_CTL + CTL_BYTES;
constexpr size_t WS_WOUT = WS_WIN + (size_t)DEPTH * NIN * D * 2;
constexpr size_t WS_WUP = WS_WOUT + (size_t)DEPTH * D * D * 2;
constexpr size_t WS_WDN = WS_WUP + (size_t)DEPTH * DFF * D * 2;
constexpr size_t WS_XB = WS_WDN + (size_t)DEPTH * D * DFF * 2;
constexpr size_t WS_X32 = WS_XB + (size_t)TT * D * 2;
constexpr size_t WS_Y = WS_X32 + (size_t)TT * D * 4;
constexpr size_t WS_QKV = WS_Y + (size_t)TT * D * 4;
constexpr size_t WS_U = WS_QKV + (size_t)TT * QKVW * 2;
constexpr size_t WS_VG = WS_U + (size_t)TT * 256 * 2;
constexpr size_t WS_LOGF = WS_VG + (size_t)TT * 256 * 4;
constexpr size_t WS_C = WS_LOGF + (size_t)TT * 8 * 4;
constexpr size_t WS_CC = WS_C + (size_t)TT * 8 * 4;
constexpr size_t WS_O = WS_CC + (size_t)DECB * PAST * 8 * 4;
constexpr size_t WS_H = WS_O + (size_t)TT * D * 2;
constexpr size_t WS_END = WS_H + (size_t)TT * DFF * 2;

constexpr int LDS_DATA = 64;
constexpr int ABUF = 128 * 144;
constexpr int HALF_LDS = 69632;
constexpr int LDS_BYTES = LDS_DATA + 2 * HALF_LDS;
constexpr int NPHASE = 1 + 8 * DEPTH;
constexpr int QCTR_WORD = 8192;

struct Params {
  const float *x_prompt, *x_sample, *cfk, *cfv, *cfl, *csk, *csv, *w_in, *b_f, *g_v, *b_v, *w_s, *b_s, *g_mix, *w_out,
      *ln1_g, *ln1_b, *w_up, *w_down, *ln2_g, *ln2_b;
  float* out;
  unsigned char* ws;
  int ph_lo, ph_hi, coop, pad;
};

#define XB_TMO      128
#define XB_XCNT(j)  (256  + 64 * (j))
#define XB_XSUB(j)  (1280 + 64 * (j))
#define XB_XGEN(j)  (2304 + 64 * (j))
#define XB_TOP      3328
#define XB_TOPGEN   3392
#define XCD_BAR_WORDS 3456
#define XB_SPIN_CAP (1u << 22)
DI unsigned xb_ld(unsigned* p) { return __hip_atomic_load(p, __ATOMIC_RELAXED, __HIP_MEMORY_SCOPE_AGENT); }
DI unsigned xb_add(unsigned* p, unsigned v) { return __hip_atomic_fetch_add(p, v, __ATOMIC_RELAXED, __HIP_MEMORY_SCOPE_AGENT); }
DI unsigned xb_xcc_id() { return (unsigned)__builtin_amdgcn_s_getreg((3 << 11) | 20) & 0xFu; }
#define XB_SPIN(cond, bar) do { unsigned _sp = 0; while (cond) { __builtin_amdgcn_s_sleep(1); \
    if ((++_sp & 255u) == 0u) { if (xb_ld(&(bar)[XB_TMO])) break; if (_sp > XB_SPIN_CAP) { atomicAdd(&(bar)[XB_TMO], 1u); break; } } } } while (0)
struct XcdBarrier { unsigned* bar; unsigned x; volatile LAS unsigned* st; };
DI XcdBarrier xcd_barrier_post(unsigned* bar, volatile LAS unsigned* st) {
  XcdBarrier b; b.bar = bar; b.x = xb_xcc_id(); b.st = st;
  if (threadIdx.x == 0) (void)xb_add(&bar[XB_XCNT(b.x)], 1u);
  return b;
}
DI void xcd_barrier_complete(unsigned* bar, unsigned x, unsigned& nloc, unsigned& nx) {
  const unsigned G = gridDim.x * gridDim.y * gridDim.z;
  unsigned sum, cnt, mine, sp = 0u;
  for (;;) {
    sum = 0u; cnt = 0u; mine = 0u;
#pragma unroll
    for (unsigned j = 0; j < 16; ++j) { const unsigned c = xb_ld(&bar[XB_XCNT(j)]); sum += c; cnt += (c > 0u) ? 1u : 0u; mine = (j == x) ? c : mine; }
    if (sum == G) break;
    __builtin_amdgcn_s_sleep(1);
    if ((++sp & 255u) == 0u) { if (xb_ld(&bar[XB_TMO])) break; if (sp > XB_SPIN_CAP) { atomicAdd(&bar[XB_TMO], 1u); break; } }
  }
  nloc = mine > 0u ? mine : 1u; nx = cnt > 0u ? cnt : 1u;
}
DI void xcd_barrier(const XcdBarrier& b) {
  asm volatile("s_waitcnt vmcnt(0)" ::: "memory");
  __syncthreads();
  if (threadIdx.x == 0) {
    unsigned* bar = b.bar;
    __builtin_amdgcn_s_waitcnt(0);
    unsigned nloc = b.st[0], nx = b.st[1];
    if (nloc == 0u) { xcd_barrier_complete(bar, b.x, nloc, nx); b.st[0] = nloc; b.st[1] = nx; }
    const unsigned old = xb_add(&bar[XB_XSUB(b.x)], 1u);
    const unsigned gen = old / nloc;
    if (old + 1u == (gen + 1u) * nloc) {
      __builtin_amdgcn_fence(__ATOMIC_RELEASE, "agent");
      asm volatile("s_waitcnt vmcnt(0)" ::: "memory");
      const unsigned og = xb_add(&bar[XB_TOP], 1u);
      const unsigned tg = og / nx;
      if (og + 1u == (tg + 1u) * nx) xb_add(&bar[XB_TOPGEN], 1u);
      else XB_SPIN(xb_ld(&bar[XB_TOPGEN]) == tg, bar);
      __builtin_amdgcn_fence(__ATOMIC_ACQUIRE, "agent");
      xb_add(&bar[XB_XGEN(b.x)], 1u);
      asm volatile("s_waitcnt vmcnt(0)" ::: "memory");
    } else {
      XB_SPIN(xb_ld(&bar[XB_XGEN(b.x)]) == gen, bar);
      __builtin_amdgcn_fence(__ATOMIC_ACQUIRE, "agent");
      asm volatile("s_waitcnt vmcnt(0)" ::: "memory");
    }
  }
  __syncthreads();
}

DI float gelu_tanh(float x) {
  const float y = 0.7978845608028654f * (x + 0.044715f * x * x * x);
  const float t = 1.f - 2.f / (1.f + __expf(2.f * y));
  return 0.5f * x * (1.f + t);
}
DI float log_sigmoid(float x) { return fminf(x, 0.f) - LN2 * lg2(1.f + ex2(-fabsf(x) * LOG2E)); }
DI float wave_sum(float v) {
#pragma unroll
  for (int o = 32; o > 0; o >>= 1) v += __shfl_xor(v, o);
  return v;
}

DI int win_map(int np) { return np < 1152 ? np : (np < 2304 ? np + 518 : (np < 2816 ? np - 1146 : (np < 2822 ? np - 1664 : -1))); }

__device__ void prep_transpose(const float* __restrict__ src, int srcN, int K, int k0, int n0, bfraw* __restrict__ dst, bool winmap, float* lds) {
  const int tid = fresh_tid(), nn = tid & 63, kr = tid >> 6;
  const int np = n0 + nn;
  const int n = winmap ? win_map(np) : np;
#pragma unroll
  for (int it = 0; it < 16; ++it) {
    const int kk = it * 4 + kr;
    const float v = (n >= 0) ? __builtin_nontemporal_load(&src[(size_t)(k0 + kk) * srcN + n]) : 0.f;
    lds[kk * 65 + nn] = v;
  }
  __syncthreads();
#pragma unroll
  for (int j = 0; j < 2; ++j) {
    const int c = tid + 256 * j, n2 = c >> 3, kc = c & 7;
    const float* s = lds + (kc * 8) * 65 + n2;
    uint4 o;
    o.x = pack2(s[0], s[65]); o.y = pack2(s[130], s[195]); o.z = pack2(s[260], s[325]); o.w = pack2(s[390], s[455]);
    *(uint4*)(dst + (size_t)(n0 + n2) * K + k0 + kc * 8) = o;
  }
  __syncthreads();
}

__device__ void phase_prep(const Params& p, unsigned char* lds) {
  bfraw* WinT = (bfraw*)(p.ws + WS_WIN); bfraw* WoutT = (bfraw*)(p.ws + WS_WOUT);
  bfraw* WupT = (bfraw*)(p.ws + WS_WUP); bfraw* WdnT = (bfraw*)(p.ws + WS_WDN);
  bfraw* XB = (bfraw*)(p.ws + WS_XB);
  constexpr int PER_L = 768 + 256 + 1024 + 1024, NW = DEPTH * PER_L, NX = TT / 16;
  for (int it0 = blockIdx.x * 2; it0 < NW + NX; it0 += vgrid()) {
    const int it = min(it0 + half_id(), NW + NX - 1);
    if (it < NW) {
      const int l = it / PER_L; int r = it % PER_L;
      if (r < 768) prep_transpose(p.w_in + (size_t)l * D * DIN, DIN, D, (r & 15) * 64, (r >> 4) * 64, WinT + (size_t)l * NIN * D, true, (float*)lds);
      else if (r < 1024) { r -= 768; prep_transpose(p.w_out + (size_t)l * D * D, D, D, (r & 15) * 64, (r >> 4) * 64, WoutT + (size_t)l * D * D, false, (float*)lds); }
      else if (r < 2048) { r -= 1024; prep_transpose(p.w_up + (size_t)l * D * DFF, DFF, D, (r & 15) * 64, (r >> 4) * 64, WupT + (size_t)l * DFF * D, false, (float*)lds); }
      else { r -= 2048; prep_transpose(p.w_down + (size_t)l * DFF * D, D, DFF, (r & 63) * 64, (r >> 6) * 64, WdnT + (size_t)l * D * DFF, false, (float*)lds); }
    } else {
      const int tid0 = fresh_tid();
      const int row0 = (it - NW) * 16;
      const float* src = row0 < TP ? p.x_prompt + (size_t)row0 * D : p.x_sample + (size_t)(row0 - TP) * D;
      bfraw* dst = XB + (size_t)row0 * D;
#pragma unroll 4
      for (int i = 0; i < 16; ++i) {
        const int idx = (tid0 + 256 * i) * 4;
        const float4 v = NTLD(src + idx);
        uint2 o; o.x = pack2(v.x, v.y); o.y = pack2(v.z, v.w);
        *(uint2*)(dst + idx) = o;
      }
    }
  }
}

enum { EPI_INPROJ = 0, EPI_RESID = 1, EPI_UP = 2, EPI_RESID_IN = 3 };

template <int EPI, int MI, int NI>
DI void gemm_epilogue(const Params& p, int layer, f32x16 (&acc)[MI][NI], int m0, int rbase, int nc0, int r32, int h, bool from_input) {
  if (EPI == EPI_INPROJ) {
    bfraw* QKV = (bfraw*)(p.ws + WS_QKV);
    if (nc0 < QKVW) {
      const int which = nc0 / 384;
      const float scale = (which == 0 || which == 3) ? 0.125f : 1.f;
      const int colin = nc0 - which * 384;
      const size_t offp = which == 1 ? O_PFK : which == 2 ? O_PFV : which == 4 ? O_PSK : O_PSV;
      const size_t offs = which == 1 ? O_SFK : which == 2 ? O_SFV : which == 4 ? O_SSK : O_SSV;
      const bool has_out = (which == 1 || which == 2 || which == 4 || which == 5);
      float* outP = p.out + offp + (size_t)layer * TP * 384 + colin + r32;
      float* outS = p.out + offs + ((size_t)layer * TS * 384 - (size_t)TP * 384) + colin + r32;
#pragma unroll
      for (int mi = 0; mi < MI; ++mi)
#pragma unroll
        for (int ni = 0; ni < NI; ++ni)
#pragma unroll
          for (int i = 0; i < 16; ++i) {
            const int row = m0 + rbase + mi * 32 + (i & 3) + 8 * (i >> 2) + 4 * h;
            const float v = acc[mi][ni][i];
            QKV[(size_t)row * QKVW + nc0 + ni * 32 + r32] = (bfraw)(pack2(v * scale, 0.f) & 0xffffu);
            if (has_out) { float* ob = row < TP ? outP : outS; ob[(size_t)row * 384 + ni * 32] = v; }
          }
    } else if (nc0 < 2560) {
      bfraw* U = (bfraw*)(p.ws + WS_U);
#pragma unroll
      for (int mi = 0; mi < MI; ++mi)
#pragma unroll
        for (int ni = 0; ni < NI; ++ni)
#pragma unroll
          for (int i = 0; i < 16; ++i) {
            const int rl = rbase + mi * 32 + (i & 3) + 8 * (i >> 2) + 4 * h;
            const int col = ni * 32 + r32;
            U[(size_t)(m0 + rl) * 256 + (nc0 - 2304) + col] = (bfraw)(pack2(gelu_tanh(acc[mi][ni][i]), 0.f) & 0xffffu);
          }
    } else if (nc0 < 2816) {
      float* VG = (float*)(p.ws + WS_VG);
#pragma unroll
      for (int mi = 0; mi < MI; ++mi)
#pragma unroll
        for (int ni = 0; ni < NI; ++ni)
#pragma unroll
          for (int i = 0; i < 16; ++i) {
            const int rl = rbase + mi * 32 + (i & 3) + 8 * (i >> 2) + 4 * h;
            const int col = ni * 32 + r32;
            VG[(size_t)(m0 + rl) * 256 + (nc0 - 2560) + col] = gelu_tanh(acc[mi][ni][i]);
          }
    } else if (nc0 == 2816) {
      if (r32 < 6) {
        float* LOGF = (float*)(p.ws + WS_LOGF);
        float* outP = p.out + O_PFL + (size_t)layer * TP * 6 + r32;
        float* outS = p.out + O_SFL + ((size_t)layer * TS * 6 - (size_t)TP * 6) + r32;
        const float bias = p.b_f[layer * 6 + r32];
#pragma unroll
        for (int mi = 0; mi < MI; ++mi)
#pragma unroll
          for (int i = 0; i < 16; ++i) {
            const int row = m0 + rbase + mi * 32 + (i & 3) + 8 * (i >> 2) + 4 * h;
            const float lf = log_sigmoid(acc[mi][0][i] + bias);
            LOGF[(size_t)row * 8 + r32] = lf;
            float* ob = row < TP ? outP : outS;
            ob[(size_t)row * 6] = lf;
          }
      }
    }
  } else if (EPI == EPI_RESID_IN) {
    unsigned char* Yb = p.ws + WS_Y;
    const float* xp = p.x_prompt + nc0 + r32;
    const float* xs = p.x_sample - (size_t)TP * D + nc0 + r32;
    const unsigned o0 = (unsigned)(((m0 + rbase + 4 * h) * D + nc0 + r32) * 4);
#pragma unroll
    for (int mi = 0; mi < MI; ++mi) {
      float xr[NI][16];
#pragma unroll
      for (int ni = 0; ni < NI; ++ni)
#pragma unroll
        for (int i = 0; i < 16; ++i) {
          const int row = m0 + rbase + 4 * h + mi * 32 + (i & 3) + 8 * (i >> 2);
          xr[ni][i] = __builtin_nontemporal_load(&(row < TP ? xp : xs)[(size_t)row * D + ni * 32]);
        }
#pragma unroll
      for (int ni = 0; ni < NI; ++ni)
#pragma unroll
        for (int i = 0; i < 16; ++i)
          *(float*)(Yb + (o0 + (unsigned)(((mi * 32 + (i & 3) + 8 * (i >> 2)) * D + ni * 32) * 4))) = ALPHA * xr[ni][i] + acc[mi][ni][i];
    }
  } else if (EPI == EPI_RESID) {
    unsigned char* Yb = p.ws + WS_Y;
    const unsigned char* Xb = p.ws + WS_X32;
    const unsigned o0 = (unsigned)(((m0 + rbase + 4 * h) * D + nc0 + r32) * 4);
#pragma unroll
    for (int mi = 0; mi < MI; ++mi) {
      float xr[NI][16];
#pragma unroll
      for (int ni = 0; ni < NI; ++ni)
#pragma unroll
        for (int i = 0; i < 16; ++i)
          xr[ni][i] = __builtin_nontemporal_load((const float*)(Xb + (o0 + (unsigned)(((mi * 32 + (i & 3) + 8 * (i >> 2)) * D + ni * 32) * 4))));
#pragma unroll
      for (int ni = 0; ni < NI; ++ni)
#pragma unroll
        for (int i = 0; i < 16; ++i)
          *(float*)(Yb + (o0 + (unsigned)(((mi * 32 + (i & 3) + 8 * (i >> 2)) * D + ni * 32) * 4))) = ALPHA * xr[ni][i] + acc[mi][ni][i];
    }
  } else {
    bfraw* H = (bfraw*)(p.ws + WS_H);
#pragma unroll
    for (int mi = 0; mi < MI; ++mi)
#pragma unroll
      for (int ni = 0; ni < NI; ++ni)
#pragma unroll
        for (int i = 0; i < 16; ++i) {
          const int rl = rbase + mi * 32 + (i & 3) + 8 * (i >> 2) + 4 * h;
          const int col = nc0 + ni * 32 + r32;
          const float v = fmaxf(acc[mi][ni][i], 0.f);
          H[(size_t)(m0 + rl) * DFF + col] = (bfraw)(pack2(v * v, 0.f) & 0xffffu);
        }
  }
}

template <int EPI, int MI, int NI>
__device__ void gemm_tile8(const Params& p, int layer, const bfraw* __restrict__ A, const bfraw* __restrict__ Bt, int K, int m0, int n0, unsigned char* ring, bool from_input,
                           bool first, bool has_next, int next_m0, int next_n0) {
  constexpr int WGM = NI == 2 ? 2 : 1, WGN = 8 / WGM;
  constexpr int BM = WGM * MI * 32;
  constexpr int STAGE = (BM + 256) * 128;
  constexpr int NAI = BM / 8;
  constexpr int NA = (NAI + 7) / 8;
  int tid = threadIdx.x; asm volatile("" : "+v"(tid));
  const int lane = tid & 63, wid = tid >> 6, wm = wid / WGN, wn = wid % WGN;
  const int r32 = lane & 31, h = lane >> 5;
  f32x16 acc[MI][NI];
#pragma unroll
  for (int a = 0; a < MI; ++a)
#pragma unroll
    for (int b = 0; b < NI; ++b)
#pragma unroll
      for (int i = 0; i < 16; ++i) acc[a][b][i] = 0.f;
  const int dc = (lane & 7) ^ (((wid & 1) * 4 + (lane >> 4)) & 7);
  const unsigned loff = (unsigned)(((wid * 8 + (lane >> 3)) * K + dc * 8) * 2);
  const unsigned char* ab = (const unsigned char*)(A + (size_t)m0 * K);
  const unsigned char* bb = (const unsigned char*)(Bt + (size_t)n0 * K);
  unsigned char* dl = ring + wid * 1024 + lane * 16;
#define ISSUE8A(ab, kt_, st_) do { \
    _Pragma("unroll") for (int j = 0; j < NA; ++j) { \
      if (NAI % 8 == 0 || j < NA - 1 || wid < NAI % 8) \
        __builtin_amdgcn_global_load_lds((const unsigned*)(ab + ((size_t)j * 64 * K + (kt_) * 64) * 2 + loff), (unsigned*)(dl + (st_) * STAGE + j * 8192), 16, 0, 0); } \
  } while (0)
#define ISSUE8B(bb, kt_, st_) do { \
    _Pragma("unroll") for (int j = 0; j < 4; ++j) \
      __builtin_amdgcn_global_load_lds((const unsigned*)(bb + ((size_t)j * 64 * K + (kt_) * 64) * 2 + loff), (unsigned*)(dl + (st_) * STAGE + BM * 128 + j * 8192), 16, 0, 0); \
  } while (0)
#define ISSUE8(ab, bb, kt_, st_) do { ISSUE8A(ab, kt_, st_); ISSUE8B(bb, kt_, st_); } while (0)
  const int key = (r32 >> 1) & 7;
  const unsigned char* afr = ring + (wm * (MI * 32) + r32) * 128;
  const unsigned char* bfr = ring + BM * 128 + (wn * (NI * 32) + r32) * 128;
  const int nk = K >> 6;
  const unsigned char* abn = (const unsigned char*)(A + (size_t)next_m0 * K);
  const unsigned char* bbn = (const unsigned char*)(Bt + (size_t)next_n0 * K);
  if (first) {
    asm volatile("s_waitcnt vmcnt(0)" ::: "memory");
    __builtin_amdgcn_s_barrier();
    asm volatile("" ::: "memory");
    ISSUE8(ab, bb, 0, 0);
  }
  int st = 0;
  for (int kt = 0; kt < nk; ++kt) {
    asm volatile("s_waitcnt vmcnt(0)" ::: "memory");
    __builtin_amdgcn_s_barrier();
    asm volatile("" ::: "memory");
    if (kt + 1 < nk) ISSUE8A(ab, kt + 1, st ^ 1);
    else if (has_next) ISSUE8A(abn, 0, st ^ 1);
    const unsigned char* as = afr + st * STAGE;
    const unsigned char* bs = bfr + st * STAGE;
#pragma unroll
    for (int ks = 0; ks < 4; ++ks) {
      if (ks == 2) { if (kt + 1 < nk) ISSUE8B(bb, kt + 1, st ^ 1); else if (has_next) ISSUE8B(bbn, 0, st ^ 1); }
      const int o = ((ks * 2 + h) ^ key) * 16;
      bf16x8 af[MI], bq[NI];
#pragma unroll
      for (int mi = 0; mi < MI; ++mi) af[mi] = *(const bf16x8*)(as + mi * 4096 + o);
#pragma unroll
      for (int ni = 0; ni < NI; ++ni) bq[ni] = *(const bf16x8*)(bs + ni * 4096 + o);
#pragma unroll
      for (int mi = 0; mi < MI; ++mi)
#pragma unroll
        for (int ni = 0; ni < NI; ++ni)
          acc[mi][ni] = __builtin_amdgcn_mfma_f32_32x32x16_bf16(af[mi], bq[ni], acc[mi][ni], 0, 0, 0);
    }
    st ^= 1;
  }
#undef ISSUE8
#undef ISSUE8A
#undef ISSUE8B
  gemm_epilogue<EPI, MI, NI>(p, layer, acc, m0, wm * (MI * 32), n0 + wn * (NI * 32), r32, h, from_input);
}

template <int EPI, int MI, int NI>
__device__ void phase_gemm8(const Params& p, int layer, const bfraw* A, const bfraw* Bt, int N, int K, unsigned char* ring, bool from_input = false) {
  constexpr int BM = (NI == 2 ? 2 : 1) * MI * 32;
  const int ntn = N / 256, ntiles = (TT / BM) * ntn;
  for (int t = blockIdx.x; t < ntiles; t += gridDim.x) {
    const int tm = t / ntn, tn = t % ntn;
    const int t2 = t + gridDim.x;
    const bool has_next = t2 < ntiles;
    const int tm2 = has_next ? t2 / ntn : tm, tn2 = has_next ? t2 % ntn : tn;
    gemm_tile8<EPI, MI, NI>(p, layer, A, Bt, K, tm * BM, tn * 256, ring, from_input, t == (int)blockIdx.x, has_next, tm2 * BM, tn2 * 256);
  }
  __syncthreads();
}

__device__ void phase_ln(const Params& p, const float* __restrict__ gam, const float* __restrict__ bet, bool last) {
  const float* Y = (const float*)(p.ws + WS_Y);
  float* X32 = (float*)(p.ws + WS_X32);
  bfraw* XB = (bfraw*)(p.ws + WS_XB);
  const int tid_ = fresh_tid(); const int lane = tid_ & 63, wid = tid_ >> 6;
  for (int row = vblock() * 4 + wid; row < TT; row += vgrid() * 4) {
    const float* y = Y + (size_t)row * D;
    float4 v[4];
#pragma unroll
    for (int j = 0; j < 4; ++j) v[j] = NTLD(y + lane * 4 + 256 * j);
    float s = 0.f;
#pragma unroll
    for (int j = 0; j < 4; ++j) s += v[j].x + v[j].y + v[j].z + v[j].w;
    const float mu = wave_sum(s) * (1.f / D);
    float q = 0.f;
#pragma unroll
    for (int j = 0; j < 4; ++j) { v[j].x -= mu; v[j].y -= mu; v[j].z -= mu; v[j].w -= mu; q += v[j].x * v[j].x + v[j].y * v[j].y + v[j].z * v[j].z + v[j].w * v[j].w; }
    const float rstd = rsqrtf(wave_sum(q) * (1.f / D) + 1e-5f);
#pragma unroll
    for (int j = 0; j < 4; ++j) {
      const int c = lane * 4 + 256 * j;
      const float4 g = *(const float4*)(gam + c), b = *(const float4*)(bet + c);
      float4 o;
      o.x = v[j].x * rstd * g.x + b.x; o.y = v[j].y * rstd * g.y + b.y; o.z = v[j].z * rstd * g.z + b.z; o.w = v[j].w * rstd * g.w + b.w;
      if (last) {
        *(float4*)(p.out + (size_t)row * D + c) = o;
      } else {
        *(float4*)(X32 + (size_t)row * D + c) = o;
        uint2 ob; ob.x = pack2(o.x, o.y); ob.y = pack2(o.z, o.w);
        *(uint2*)(XB + (size_t)row * D + c) = ob;
      }
    }
  }
}

DI float wave_incl_scan(float v, int lane) {
#pragma unroll
  for (int o = 1; o < 64; o <<= 1) { const float t = __shfl_up(v, o); if (lane >= o) v += t; }
  return v;
}
__device__ void phase_scan(const Params& p, int layer, unsigned char* lds) {
  const float* LOGF = (const float*)(p.ws + WS_LOGF);
  float* C = (float*)(p.ws + WS_C);
  float* CC = (float*)(p.ws + WS_CC);
  float* red = (float*)lds;
  const int tid = fresh_tid(), lane = tid & 63, wid = tid >> 6;
  {
    const bfraw* QKV = (const bfraw*)(p.ws + WS_QKV);
    unsigned* kmx = (unsigned*)(p.ws + WS_CTL) + KMAX_WORD + 64 * layer;
    for (int it = vblock(); it < 24 * 16; it += vgrid()) {
      const int bh = it >> 4, b = bh / 6, h = bh % 6, pos = (it & 15) * 256 + tid;
      const uint4* kp = (const uint4*)(QKV + (size_t)(b * SEQ + pos) * QKVW + 384 + h * 64);
      float ss = 0.f;
#pragma unroll
      for (int i = 0; i < 8; ++i) {
        const uint4 u = kp[i];
        const unsigned w[4] = {u.x, u.y, u.z, u.w};
#pragma unroll
        for (int k = 0; k < 4; ++k) { const float a = __uint_as_float(w[k] << 16), c = __uint_as_float(w[k] & 0xffff0000u); ss += a * a + c * c; }
      }
#pragma unroll
      for (int o = 32; o > 0; o >>= 1) ss = fmaxf(ss, __shfl_xor(ss, o));
      if (lane == 0) atomicMax(&kmx[bh], __float_as_uint(ss));
    }
  }
  for (int seq0 = blockIdx.x * 2; seq0 < 24 + 192; seq0 += vgrid()) {
    const int seq = min(seq0 + half_id(), 24 + 192 - 1);
    const bool pr = seq < 24;
    const int s = pr ? seq : seq - 24, b = s / 6, h = s % 6;
    float v[16];
    if (pr) {
      const float* base = LOGF + ((size_t)b * SEQ + tid * 16) * 8 + h;
#pragma unroll
      for (int i = 0; i < 16; ++i) v[i] = base[i * 8];
    } else {
      const float* base = p.cfl + (((size_t)layer * DECB + b) * PAST + tid * 8) * 6 + h;
#pragma unroll
      for (int i = 0; i < 8; ++i) v[i] = base[i * 6];
#pragma unroll
      for (int i = 8; i < 16; ++i) v[i] = 0.f;
    }
#pragma unroll
    for (int i = 1; i < 16; ++i) v[i] += v[i - 1];
    const float tot = v[15];
    const float inc = wave_incl_scan(tot, lane);
    if (lane == 63) red[wid] = inc;
    __syncthreads();
    const float r0 = red[0], r1 = red[1], r2 = red[2], r3 = red[3];
    float off = inc - tot;
    off += (wid > 0 ? r0 : 0.f) + (wid > 1 ? r1 : 0.f) + (wid > 2 ? r2 : 0.f);
    if (pr) {
      float* dst = C + ((size_t)b * SEQ + tid * 16) * 8 + h;
#pragma unroll
      for (int i = 0; i < 16; ++i) dst[i * 8] = off + v[i];
    } else {
      float* dst = CC + ((size_t)b * PAST + tid * 8) * 8 + h;
#pragma unroll
      for (int i = 0; i < 8; ++i) dst[i * 8] = off + v[i];
      if (wid == 0) {
        const size_t idx = ((size_t)TP + b * DECS + lane) * 8 + h;
        C[idx] = ((r0 + r1) + (r2 + r3)) + wave_incl_scan(LOGF[idx], lane);
      }
    }
    __syncthreads();
  }
}

__device__ void attn_item(const Params& p, int layer, int type, bool sample, int b, int h, int qb, unsigned char* lds, volatile LAS int* flg) {
  const bfraw* QKV = (const bfraw*)(p.ws + WS_QKV);
  const float* C = (const float*)(p.ws + WS_C);
  const float* CC = (const float*)(p.ws + WS_CC);
  bfraw* O = (bfraw*)(p.ws + WS_O);
  const int tid = fresh_tid(), lane = tid & 63, wid = tid >> 6, l15 = lane & 15, g = lane >> 4;
  const int qrow0 = sample ? TP + b * DECS : b * SEQ + qb * 64;
  const int ntiles = sample ? 33 : qb + 1;
  const int qoff = type ? 1152 : 0, koff = qoff + 384, voff = qoff + 768, hc = h * 64;
  const int qrow = qrow0 + wid * 16 + l15;
  const bfraw* qp = QKV + (size_t)qrow * QKVW + qoff + hc + g * 8;
  const bf16x8 q0 = *(const bf16x8*)qp, q1 = *(const bf16x8*)(qp + 32);
  float cq2 = 0.f;
  if (type == 0) cq2 = C[(size_t)qrow * 8 + h] * LOG2E;
  const bool fexit = (type == 0) && !sample;
  float bqk = 0.f, cnext = 0.f;
  if (fexit) {
    float qs = 0.f;
#pragma unroll
    for (int i = 0; i < 8; ++i) { const float a = bf2f((bfraw)q0[i]), c = bf2f((bfraw)q1[i]); qs += a * a + c * c; }
    qs += __shfl_xor(qs, 16); qs += __shfl_xor(qs, 32);
    const float kmax2 = __uint_as_float(((const unsigned*)(p.ws + WS_CTL))[KMAX_WORD + 64 * layer + b * 6 + h]);
    bqk = sqrtf(qs * kmax2) * (LOG2E * 1.01f) + 1.f;
  }
  const float* kcache = type ? p.csk : p.cfk;
  const float* vcache = type ? p.csv : p.cfv;

  float4 st[8]; float stc = 0.f;
  const int key_l = tid >> 3, dc = tid & 7;
  unsigned char* kd = lds + key_l * 144 + dc * 16;
  unsigned char* vd = kd + 9216;
  float* ckl = (float*)(lds + 18432);

#define ATTN_PREFETCH(t_)                                                                                         \
  do {                                                                                                            \
    const int tt_ = (t_);                                                                                         \
    if (!(sample && tt_ < 32)) {                                                                                  \
      const int krow = sample ? TP + b * DECS : b * SEQ + tt_ * 64;                                               \
      const bfraw* kp = QKV + (size_t)(krow + key_l) * QKVW + hc + dc * 8;                                        \
      st[0] = *(const float4*)(kp + koff); st[1] = *(const float4*)(kp + koff + 32 * QKVW);                       \
      st[2] = *(const float4*)(kp + voff); st[3] = *(const float4*)(kp + voff + 32 * QKVW);                       \
      if (type == 0 && tid < 64) stc = C[(size_t)(krow + tid) * 8 + h];                                           \
    } else {                                                                                                      \
      const size_t off = ((((size_t)layer * DECB + b) * PAST + tt_ * 64 + key_l) * 6 + h) * 64 + dc * 8;          \
      const float* kc = kcache + off; const float* vc = vcache + off;                                             \
      st[0] = NTLD(kc); st[1] = NTLD((kc + 4));                                               \
      st[2] = NTLD((kc + 32 * 384)); st[3] = NTLD((kc + 32 * 384 + 4));                       \
      st[4] = NTLD(vc); st[5] = NTLD((vc + 4));                                               \
      st[6] = NTLD((vc + 32 * 384)); st[7] = NTLD((vc + 32 * 384 + 4));                       \
      if (type == 0 && tid < 64) stc = CC[((size_t)b * PAST + tt_ * 64 + tid) * 8 + h];                           \
    }                                                                                                             \
  } while (0)

  f32x4 oacc[4];
#pragma unroll
  for (int i = 0; i < 4; ++i) oacc[i] = (f32x4){0.f, 0.f, 0.f, 0.f};
  float m = -1e30f, lsum = 0.f, R = 0.f;
  const int ql = wid * 16 + l15;
  const int i16 = l15, qq = i16 >> 2, pp = i16 & 3;
  const unsigned char* vtr = lds + 9216 + (4 * g + qq) * 144 + pp * 8;

  ATTN_PREFETCH(ntiles - 1);
  for (int t = ntiles - 1; t >= 0; --t) {
    if (!(sample && t < 32)) {
      *(float4*)kd = st[0]; *(float4*)(kd + 32 * 144) = st[1]; *(float4*)vd = st[2]; *(float4*)(vd + 32 * 144) = st[3];
    } else {
      uint4 a;
      a.x = pack2(st[0].x, st[0].y); a.y = pack2(st[0].z, st[0].w); a.z = pack2(st[1].x, st[1].y); a.w = pack2(st[1].z, st[1].w); *(uint4*)kd = a;
      a.x = pack2(st[2].x, st[2].y); a.y = pack2(st[2].z, st[2].w); a.z = pack2(st[3].x, st[3].y); a.w = pack2(st[3].z, st[3].w); *(uint4*)(kd + 32 * 144) = a;
      a.x = pack2(st[4].x, st[4].y); a.y = pack2(st[4].z, st[4].w); a.z = pack2(st[5].x, st[5].y); a.w = pack2(st[5].z, st[5].w); *(uint4*)vd = a;
      a.x = pack2(st[6].x, st[6].y); a.y = pack2(st[6].z, st[6].w); a.z = pack2(st[7].x, st[7].y); a.w = pack2(st[7].z, st[7].w); *(uint4*)(vd + 32 * 144) = a;
    }
    if (type == 0 && tid < 64) ckl[tid] = stc * LOG2E;
    __syncthreads();
    if (t > 0) ATTN_PREFETCH(t - 1);
    if (fexit && t > 0) cnext = C[(size_t)(b * SEQ + (t - 1) * 64 + 63) * 8 + h];
    const bool diag = (t == ntiles - 1);

    f32x4 s[4];
#pragma unroll
    for (int kb = 0; kb < 4; ++kb) {
      const unsigned char* ka = lds + (kb * 16 + l15) * 144 + g * 16;
      const bf16x8 a0 = *(const bf16x8*)ka, a1 = *(const bf16x8*)(ka + 64);
      f32x4 z = (f32x4){0.f, 0.f, 0.f, 0.f};
      z = __builtin_amdgcn_mfma_f32_16x16x32_bf16(a0, q0, z, 0, 0, 0);
      s[kb] = __builtin_amdgcn_mfma_f32_16x16x32_bf16(a1, q1, z, 0, 0, 0);
    }
    unsigned pk[8];
    if (type == 0) {
      float mx = -1e30f;
#pragma unroll
      for (int kb = 0; kb < 4; ++kb) {
        const f32x4 ck = *(const f32x4*)(ckl + kb * 16 + 4 * g);
#pragma unroll
        for (int j = 0; j < 4; ++j) {
          float x = s[kb][j] * LOG2E + cq2 - ck[j];
          if (diag && (kb * 16 + 4 * g + j > ql)) x = -1e30f;
          s[kb][j] = x; mx = fmaxf(mx, x);
        }
      }
      mx = fmaxf(mx, __shfl_xor(mx, 16)); mx = fmaxf(mx, __shfl_xor(mx, 32));
      const float mnew = fmaxf(m, mx);
      const float alpha = ex2(m - mnew);
      m = mnew;
      float ps = 0.f;
#pragma unroll
      for (int kb = 0; kb < 4; ++kb) {
        const float p0 = ex2(s[kb][0] - mnew), p1 = ex2(s[kb][1] - mnew), p2 = ex2(s[kb][2] - mnew), p3 = ex2(s[kb][3] - mnew);
        ps += (p0 + p1) + (p2 + p3);
        pk[kb * 2] = pack2(p0, p1); pk[kb * 2 + 1] = pack2(p2, p3);
      }
      lsum = lsum * alpha + ps;
#pragma unroll
      for (int db = 0; db < 4; ++db) oacc[db] *= alpha;
    } else {
      float lr[4][4];
#pragma unroll
      for (int kb = 0; kb < 4; ++kb)
#pragma unroll
        for (int j = 0; j < 4; ++j) {
          const float z2 = s[kb][j] * LOG2E;
          const float e = ex2(-fabsf(z2));
          float l = -(fmaxf(z2, 0.f) + lg2(1.f + e));
          if (diag && !(kb * 16 + 4 * g + j < ql)) l = 0.f;
          s[kb][j] = z2; lr[kb][j] = l;
        }
#pragma unroll
      for (int kb = 3; kb >= 0; --kb) {
        const float G = (lr[kb][0] + lr[kb][1]) + (lr[kb][2] + lr[kb][3]);
        const float a = __shfl_xor(G, 16), bb = __shfl_xor(G, 32), c = __shfl_xor(G, 48);
        const float tot = (G + a) + (bb + c);
        const float gt = ((g == 0 || g == 2) ? a : 0.f) + ((g < 2) ? (bb + c) : 0.f);
        const float a3 = R + gt, a2 = a3 + lr[kb][3], a1 = a2 + lr[kb][2], a0 = a1 + lr[kb][1];
        float p0 = ex2(s[kb][0] + lr[kb][0] + a0), p1 = ex2(s[kb][1] + lr[kb][1] + a1);
        float p2 = ex2(s[kb][2] + lr[kb][2] + a2), p3 = ex2(s[kb][3] + lr[kb][3] + a3);
        if (diag) {
          const int k0 = kb * 16 + 4 * g;
          if (!(k0 < ql)) p0 = 0.f;
          if (!(k0 + 1 < ql)) p1 = 0.f;
          if (!(k0 + 2 < ql)) p2 = 0.f;
          if (!(k0 + 3 < ql)) p3 = 0.f;
        }
        pk[kb * 2] = pack2(p0, p1); pk[kb * 2 + 1] = pack2(p2, p3);
        R += tot;
      }
      const int alldone = __all(R < SB_EXIT) ? 1 : 0;
      if (lane == 0) flg[half_id() * 4 + wid] = alldone;
    }
    if (fexit) {
      const int done = (t > 0 && __all(bqk + cq2 - cnext * LOG2E - m < FOX_EXIT)) ? 1 : 0;
      if (lane == 0) flg[half_id() * 4 + wid] = done;
    }
#pragma unroll
    for (int kk = 0; kk < 2; ++kk) {
      const uint4 pu = {pk[kk * 4], pk[kk * 4 + 1], pk[kk * 4 + 2], pk[kk * 4 + 3]};
      const bf16x8 pf = __builtin_bit_cast(bf16x8, pu);
#pragma unroll
      for (int db = 0; db < 4; ++db) {
        const unsigned char* va = vtr + (32 * kk) * 144 + db * 32;
        const s16x4 lo = __builtin_amdgcn_ds_read_tr16_b64_v4i16((LAS s16x4*)(va));
        const s16x4 hi = __builtin_amdgcn_ds_read_tr16_b64_v4i16((LAS s16x4*)(va + 16 * 144));
        const bf16x8 vf = __builtin_shufflevector(lo, hi, 0, 1, 2, 3, 4, 5, 6, 7);
        oacc[db] = __builtin_amdgcn_mfma_f32_16x16x32_bf16(vf, pf, oacc[db], 0, 0, 0);
      }
    }
    __syncthreads();
    if (type == 1 || fexit) { if (flg[0] & flg[1] & flg[2] & flg[3] & flg[4] & flg[5] & flg[6] & flg[7]) break; }
  }
#undef ATTN_PREFETCH
  if (type == 0) {
    lsum += __shfl_xor(lsum, 16); lsum += __shfl_xor(lsum, 32);
    const float inv = 1.f / lsum;
#pragma unroll
    for (int db = 0; db < 4; ++db) oacc[db] *= inv;
  }
  float ss = 0.f;
#pragma unroll
  for (int db = 0; db < 4; ++db)
#pragma unroll
    for (int j = 0; j < 4; ++j) ss += oacc[db][j] * oacc[db][j];
  ss += __shfl_xor(ss, 16); ss += __shfl_xor(ss, 32);
  const float rs = rsqrtf(ss * (1.f / 64.f) + 1e-6f);
  const int hoff = type ? 640 + hc : hc;
#pragma unroll
  for (int db = 0; db < 4; ++db) {
    const int d0 = 16 * db + 4 * g;
    const float4 gm = *(const float4*)(p.g_mix + layer * D + hoff + d0);
    uint2 o;
    o.x = pack2(oacc[db][0] * rs * gm.x, oacc[db][1] * rs * gm.y);
    o.y = pack2(oacc[db][2] * rs * gm.z, oacc[db][3] * rs * gm.w);
    *(uint2*)(O + (size_t)qrow * D + hoff + d0) = o;
  }
}

__device__ void sgu_item(const Params& p, int layer, bool sample, int ci, int g, unsigned char* lds) {
  const float* VG = (const float*)(p.ws + WS_VG);
  const bfraw* U = (const bfraw*)(p.ws + WS_U);
  bfraw* O = (bfraw*)(p.ws + WS_O);
  constexpr int LROW = 272;
  unsigned char* Wl = lds;
  unsigned char* Vt = lds + 128 * LROW;
  const int tid = fresh_tid(), lane = tid & 63, wid = tid >> 6;
  const int r0 = sample ? TP + ci * DECS : ci * 128;
  const int L = sample ? 64 : 128;
  {
    const float4 gv = *(const float4*)(p.g_v + layer * 256 + lane * 4), bv = *(const float4*)(p.b_v + layer * 256 + lane * 4);
    for (int i = wid; i < L; i += 4) {
      float4 v = *(const float4*)(VG + (size_t)(r0 + i) * 256 + lane * 4);
      const float mu = wave_sum(v.x + v.y + v.z + v.w) * (1.f / 256.f);
      v.x -= mu; v.y -= mu; v.z -= mu; v.w -= mu;
      const float rstd = rsqrtf(wave_sum(v.x * v.x + v.y * v.y + v.z * v.z + v.w * v.w) * (1.f / 256.f) + 1e-5f);
      float4 o;
      o.x = v.x * rstd * gv.x + bv.x; o.y = v.y * rstd * gv.y + bv.y; o.z = v.z * rstd * gv.z + bv.z; o.w = v.w * rstd * gv.w + bv.w;
      if ((lane >> 4) == g) {
        const unsigned lo = pack2(o.x, o.y), hi = pack2(o.z, o.w);
        unsigned char* vp = Vt + ((lane & 15) * 4) * LROW + i * 2;
        *(bfraw*)(vp) = (bfraw)(lo & 0xffffu); *(bfraw*)(vp + LROW) = (bfraw)(lo >> 16);
        *(bfraw*)(vp + 2 * LROW) = (bfraw)(hi & 0xffffu); *(bfraw*)(vp + 3 * LROW) = (bfraw)(hi >> 16);
        if (sample) *(float4*)(p.out + O_SGV + ((size_t)layer * TS + (r0 - TP) + i) * 256 + lane * 4) = o;
      }
    }
    const float* wg = p.w_s + ((size_t)layer * 4 + g) * 128 * 128;
#pragma unroll 4
    for (int k = 0; k < 16; ++k) {
      const int idx = tid + 256 * k, row = idx >> 5, c4 = (idx & 31) * 4;
      if (row < L) {
        const float4 w = *(const float4*)(wg + row * 128 + c4);
        uint2 o;
        o.x = pack2(c4 <= row ? w.x : 0.f, c4 + 1 <= row ? w.y : 0.f);
        o.y = pack2(c4 + 2 <= row ? w.z : 0.f, c4 + 3 <= row ? w.w : 0.f);
        *(uint2*)(Wl + row * LROW + c4 * 2) = o;
      }
    }
  }
  __syncthreads();
  if (wid * 32 < L) {
    const int r32 = lane & 31, h = lane >> 5;
    f32x16 acc[2];
#pragma unroll
    for (int ni = 0; ni < 2; ++ni)
#pragma unroll
      for (int i = 0; i < 16; ++i) acc[ni][i] = 0.f;
    const unsigned char* ap = Wl + (wid * 32 + r32) * LROW + h * 16;
    const unsigned char* bp = Vt + r32 * LROW + h * 16;
    const int nks = min(L / 16, 2 * (wid + 1));
    for (int ks = 0; ks < nks; ++ks) {
      const bf16x8 a = *(const bf16x8*)(ap + ks * 32);
      const bf16x8 b0 = *(const bf16x8*)(bp + ks * 32), b1 = *(const bf16x8*)(bp + 32 * LROW + ks * 32);
      acc[0] = __builtin_amdgcn_mfma_f32_32x32x16_bf16(a, b0, acc[0], 0, 0, 0);
      acc[1] = __builtin_amdgcn_mfma_f32_32x32x16_bf16(a, b1, acc[1], 0, 0, 0);
    }
    const float* bsp = p.b_s + ((size_t)layer * 4 + g) * 128 + wid * 32 + 4 * h;
    const float* gm = p.g_mix + layer * D + 384 + g * 64 + r32;
    const float gm0 = gm[0], gm1 = gm[32];
    const size_t rowb = (size_t)(r0 + wid * 32 + 4 * h);
#pragma unroll
    for (int i = 0; i < 16; ++i) {
      const int rl = (i & 3) + 8 * (i >> 2);
      const float bs = bsp[rl];
      const bfraw* up = U + (rowb + rl) * 256 + g * 64 + r32;
      const float o0 = bf2f(up[0]) * (acc[0][i] + bs), o1 = bf2f(up[32]) * (acc[1][i] + bs);
      float ss = o0 * o0 + o1 * o1;
      ss += __shfl_xor(ss, 1); ss += __shfl_xor(ss, 2); ss += __shfl_xor(ss, 4); ss += __shfl_xor(ss, 8); ss += __shfl_xor(ss, 16);
      const float rs = rsqrtf(ss * (1.f / 64.f) + 1e-6f);
      bfraw* op = O + (rowb + rl) * D + 384 + g * 64 + r32;
      op[0] = (bfraw)(pack2(o0 * rs * gm0, 0.f) & 0xffffu);
      op[32] = (bfraw)(pack2(o1 * rs * gm1, 0.f) & 0xffffu);
    }
  }
  __syncthreads();
}

__device__ void phase_mix(const Params& p, int layer, unsigned char* lds, volatile LAS int* slot) {
  unsigned* ctr = (unsigned*)(p.ws + WS_CTL) + QCTR_WORD + 64 * layer;
  volatile LAS int* flg = slot + 4;
  constexpr int N_SAMPLE = 384, N_PROMPT = 3072, N_SGU = 640, N_ALL = N_SAMPLE + N_PROMPT + N_SGU;
  for (;;) {
    if (threadIdx.x == 0) *slot = (int)atomicAdd(ctr, 1u);
    __syncthreads();
    const int item = *slot * 2 + half_id();
    __syncthreads();
    if (item >= N_ALL) break;
    if (item < N_SAMPLE) {
      const int type = item < 192 ? 1 : 0, r = item % 192;
      attn_item(p, layer, type, true, r / 6, r % 6, 0, lds, flg);
    } else if (item < N_SAMPLE + N_SGU) {
      int r = item - N_SAMPLE;
      if (r < 512) sgu_item(p, layer, false, r >> 2, r & 3, lds);
      else { r -= 512; sgu_item(p, layer, true, r >> 2, r & 3, lds); }
    } else {
      const int r = item - N_SAMPLE - N_SGU, type = r < 1536 ? 0 : 1, r2 = r % 1536, qb = 63 - r2 / 24, bh = r2 % 24;
      attn_item(p, layer, type, false, bh / 6, bh % 6, qb, lds, flg);
    }
  }
}

__device__ void run_phase(const Params& p, int ph, unsigned char* lds, unsigned char* ring, volatile LAS int* slot) {
  const bfraw* XB = (const bfraw*)(p.ws + WS_XB);
  if (ph == 0) { phase_prep(p, lds); return; }
  const int layer = (ph - 1) >> 3, sub = (ph - 1) & 7;
  switch (sub) {
    case 0: phase_gemm8<EPI_INPROJ, 9, 1>(p, layer, XB, (const bfraw*)(p.ws + WS_WIN) + (size_t)layer * NIN * D, NIN, D, ring); break;
    case 1: phase_scan(p, layer, lds); break;
    case 2: phase_mix(p, layer, lds, slot); break;
    case 3: if (layer == 0) phase_gemm8<EPI_RESID_IN, 9, 1>(p, layer, (const bfraw*)(p.ws + WS_O), (const bfraw*)(p.ws + WS_WOUT) + (size_t)layer * D * D, D, D, ring);
            else phase_gemm8<EPI_RESID, 9, 1>(p, layer, (const bfraw*)(p.ws + WS_O), (const bfraw*)(p.ws + WS_WOUT) + (size_t)layer * D * D, D, D, ring);
            break;
    case 4: phase_ln(p, p.ln1_g + layer * D, p.ln1_b + layer * D, false); break;
    case 5: phase_gemm8<EPI_UP, 9, 1>(p, layer, XB, (const bfraw*)(p.ws + WS_WUP) + (size_t)layer * DFF * D, DFF, D, ring); break;
    case 6: phase_gemm8<EPI_RESID, 9, 1>(p, layer, (const bfraw*)(p.ws + WS_H), (const bfraw*)(p.ws + WS_WDN) + (size_t)layer * D * DFF, D, DFF, ring); break;
    default: phase_ln(p, p.ln2_g + layer * D, p.ln2_b + layer * D, layer == DEPTH - 1); break;
  }
}

__global__ void __launch_bounds__(512, 2) fwd_kernel(Params p) {
  extern __shared__ __attribute__((aligned(16))) unsigned char smem[];
  unsigned char* lds = smem + LDS_DATA + half_id() * HALF_LDS;
  volatile LAS unsigned* st = (volatile LAS unsigned*)smem;
  volatile LAS int* slot = (volatile LAS int*)(smem + 16);
  if (threadIdx.x == 0) { st[0] = 0u; st[1] = 0u; st[2] = 0u; st[3] = 0u; }
  __syncthreads();
  XcdBarrier xb;
  xb.bar = (unsigned*)(p.ws + WS_CTL); xb.x = 0; xb.st = st;
  if (p.coop) xb = xcd_barrier_post((unsigned*)(p.ws + WS_CTL), st);
  for (int ph = p.ph_lo; ph < p.ph_hi; ++ph) {
    if (ph > p.ph_lo) {
      if (p.pad) cg::this_grid().sync();
      xcd_barrier(xb);
    }
    run_phase(p, ph, lds, smem + LDS_DATA, slot);
  }
}

extern "C" void kernel_launch(void* const* d_in, const int* in_sizes, int n_in, void* d_out, int out_size, void* d_ws, size_t ws_size,
                              hipStream_t stream) {
  static int grid = 0;
  if (grid == 0) {
    if (n_in != 21 || (size_t)out_size != O_END || ws_size < WS_END) {
      fprintf(stderr, "kernel_launch: unexpected shapes: n_in %d out %d (want %zu) ws %zu (want >= %zu)\n", n_in, out_size, (size_t)O_END, ws_size, (size_t)WS_END);
      grid = -1; return;
    }
    int dev = 0, cus = 0, per_cu = 0;
    hipGetDevice(&dev);
    hipDeviceGetAttribute(&cus, hipDeviceAttributeMultiprocessorCount, dev);
    if (hipFuncSetAttribute((const void*)fwd_kernel, hipFuncAttributeMaxDynamicSharedMemorySize, LDS_BYTES) != hipSuccess) {
      fprintf(stderr, "kernel_launch: hipFuncSetAttribute failed\n"); grid = -1; return;
    }
    hipOccupancyMaxActiveBlocksPerMultiprocessor(&per_cu, (const void*)fwd_kernel, 512, LDS_BYTES);
    if (per_cu < 1) { fprintf(stderr, "kernel_launch: occupancy query says %d\n", per_cu); per_cu = 1; }
    if (per_cu > 1) per_cu = 1;
    grid = cus * per_cu;
  }
  if (grid < 0) return;
  hipMemsetAsync((char*)d_ws + WS_CTL, 0, CTL_BYTES, stream);
  Params p{};
  const float** f = (const float**)&p;
  for (int i = 0; i < 21; ++i) f[i] = (const float*)d_in[i];
  p.out = (float*)d_out; p.ws = (unsigned char*)d_ws;
#if MK_MODE == 0
  for (int ph = 0; ph < NPHASE; ++ph) {
    p.ph_lo = ph; p.ph_hi = ph + 1; p.coop = 0; p.pad = 0;
    hipLaunchKernelGGL(fwd_kernel, dim3(grid), dim3(512), LDS_BYTES, stream, p);
  }
#else
  p.ph_lo = 0; p.ph_hi = NPHASE; p.coop = 1; p.pad = 0;
  void* args[] = {&p};
  hipError_t e = hipLaunchCooperativeKernel((const void*)fwd_kernel, dim3(grid), dim3(512), args, LDS_BYTES, stream);
  if (e != hipSuccess) fprintf(stderr, "cooperative launch failed: %s (grid %d)\n", hipGetErrorString(e), grid);
#endif
}
```
